# Optimizing an MI355X kernel written in HIP

```python
import math
import jax
import jax.numpy as jnp
from jax import lax
import numpy as np

D_MODEL = 1024
BATCH = 8
SEQ = 2048
DEPTH = 4

CTX_LEN = 256
GRID_W = 64

N_MOD = 6
EPS = 1e-6

N_HEADS = 8
N_KV_HEADS = 2
HEAD_DIM = 64
Q_REP = N_HEADS // N_KV_HEADS
ATTN_W = N_HEADS * HEAD_DIM
KV_W = N_KV_HEADS * HEAD_DIM
WINDOW = 128
ATTN_BLOCK = 128
ATTN_HALO = WINDOW // ATTN_BLOCK
ATTN_SCALE = HEAD_DIM ** -0.5
ROPE_BASE = 10000.0
ROPE_AXIS_DIM = HEAD_DIM // 2

SSM_W = D_MODEL // 4
SSM_GROUP = 16
SSM_GROUPS = SSM_W // SSM_GROUP
SSM_STATE = 64
DT_MIN = 1e-3
DT_MAX = 1e-1

POOL_W = D_MODEL // 4
POOL_WINDOWS = (2, 4, 8, 16)
POOL_GROUP = POOL_W // len(POOL_WINDOWS)

Q_END = ATTN_W
K_END = Q_END + KV_W
V_END = K_END + KV_W
U_END = V_END + SSM_W
P_END = U_END + POOL_W
IN_W = P_END
MIX_W = ATTN_W + SSM_W + POOL_W

N_EXPERTS = 32
TOP_K = 4
D_FF_EXPERT = D_MODEL
SWIGLU_LIMIT = 7.0
SWIGLU_ALPHA = 1.702
MOE_BLOCK = 128

kernel_name = 'hybrid_diffusion_trunk'


def _rmsnorm(x, w):
    xf = x.astype(jnp.float32)
    y = xf * lax.rsqrt(jnp.mean(xf * xf, axis=-1, keepdims=True) + EPS)
    return (y * w.astype(jnp.float32)).astype(x.dtype)


def _modulate(h, shift, scale):
    return h * (1 + scale) + shift


def _cols(p, lo, a, b):
    return p[..., a - lo:b - lo]


def _axial_rope_tables(length):
    rows = length // GRID_W
    row = jnp.repeat(jnp.arange(rows), GRID_W).astype(jnp.float32)
    col = jnp.tile(jnp.arange(GRID_W), rows).astype(jnp.float32)
    inv = ROPE_BASE ** (-jnp.arange(0, ROPE_AXIS_DIM, 2, dtype=jnp.float32) / ROPE_AXIS_DIM)
    ang_r = row[:, None] * inv
    ang_c = col[:, None] * inv
    ang = jnp.concatenate([ang_r, ang_r, ang_c, ang_c], axis=-1)
    return jnp.cos(ang), jnp.sin(ang)


def _apply_rope(t, cos, sin):
    tf = t.astype(jnp.float32)
    s = tf.reshape(tf.shape[:-1] + (2, 2, ROPE_AXIS_DIM // 2))
    rot = jnp.stack([-s[..., 1, :], s[..., 0, :]], axis=-2).reshape(tf.shape)
    return (tf * cos[None, :, None, :] + rot * sin[None, :, None, :]).astype(t.dtype)


def _window_attention(q, k, v, kc, vc, sink):
    B, L = q.shape[:2]
    Lc = kc.shape[1]
    nb = L // ATTN_BLOCK
    span = (2 * ATTN_HALO + 1) * ATTN_BLOCK
    qb = q.reshape(B, nb, ATTN_BLOCK, N_KV_HEADS, Q_REP, HEAD_DIM)
    pad = ((0, 0), (ATTN_HALO * ATTN_BLOCK, ATTN_HALO * ATTN_BLOCK), (0, 0), (0, 0))
    kpb = jnp.pad(k, pad).reshape(B, nb + 2 * ATTN_HALO, ATTN_BLOCK, N_KV_HEADS, HEAD_DIM)
    vpb = jnp.pad(v, pad).reshape(B, nb + 2 * ATTN_HALO, ATTN_BLOCK, N_KV_HEADS, HEAD_DIM)
    kband = jnp.concatenate([kpb[:, j:j + nb] for j in range(2 * ATTN_HALO + 1)], axis=2)
    vband = jnp.concatenate([vpb[:, j:j + nb] for j in range(2 * ATTN_HALO + 1)], axis=2)
    qpos = jnp.arange(L).reshape(nb, ATTN_BLOCK)
    kpos = (jnp.arange(nb)[:, None] - ATTN_HALO) * ATTN_BLOCK + jnp.arange(span)[None, :]
    valid = ((jnp.abs(qpos[:, :, None] - kpos[:, None, :]) <= WINDOW)
             & (kpos[:, None, :] >= 0) & (kpos[:, None, :] < L))
    s_loc = jnp.einsum('bnqgrd,bnkgd->bngrqk', qb, kband, preferred_element_type=jnp.float32) * ATTN_SCALE
    s_loc = jnp.where(valid[None, :, None, None], s_loc, -jnp.inf)
    s_ctx = jnp.einsum('bnqgrd,bcgd->bngrqc', qb, kc, preferred_element_type=jnp.float32) * ATTN_SCALE
    s_sink = jnp.broadcast_to(sink.astype(jnp.float32).reshape(1, 1, N_KV_HEADS, Q_REP, 1, 1),
                              s_ctx.shape[:-1] + (1,))
    p = jax.nn.softmax(jnp.concatenate([s_loc, s_ctx, s_sink], axis=-1), axis=-1)
    o = (jnp.einsum('bngrqk,bnkgd->bnqgrd', p[..., :span], vband.astype(jnp.float32))
         + jnp.einsum('bngrqc,bcgd->bnqgrd', p[..., span:span + Lc], vc.astype(jnp.float32)))
    return o.reshape(B, L, ATTN_W).astype(q.dtype)


def _ctx_attention(qc, kc, vc, sink):
    B, Lc = qc.shape[:2]
    qg = qc.reshape(B, Lc, N_KV_HEADS, Q_REP, HEAD_DIM)
    s = jnp.einsum('bqgrd,bkgd->bgrqk', qg, kc, preferred_element_type=jnp.float32) * ATTN_SCALE
    s_sink = jnp.broadcast_to(sink.astype(jnp.float32).reshape(1, N_KV_HEADS, Q_REP, 1, 1), s.shape[:-1] + (1,))
    p = jax.nn.softmax(jnp.concatenate([s, s_sink], axis=-1), axis=-1)[..., :Lc]
    o = jnp.einsum('bgrqk,bkgd->bqgrd', p, vc.astype(jnp.float32))
    return o.reshape(B, Lc, ATTN_W).astype(qc.dtype)


def _s5_discretize(a_re, a_im, log_dt, b_re, b_im):
    a_re = a_re.astype(jnp.float32)
    a_im = a_im.astype(jnp.float32)
    dt = jnp.exp(log_dt.astype(jnp.float32))[:, None]
    mag = jnp.exp(a_re * dt)
    ar = mag * jnp.cos(a_im * dt)
    ai = mag * jnp.sin(a_im * dt)
    den = a_re * a_re + a_im * a_im
    qr = ((ar - 1) * a_re + ai * a_im) / den
    qi = (ai * a_re - (ar - 1) * a_im) / den
    br = b_re.astype(jnp.float32)
    bi = b_im.astype(jnp.float32)
    bbr = qr[..., None] * br - qi[..., None] * bi
    bbi = qr[..., None] * bi + qi[..., None] * br
    return ar, ai, bbr, bbi


def _complex_affine_combine(e1, e2):
    a1r, a1i, b1r, b1i = e1
    a2r, a2i, b2r, b2i = e2
    return (a2r * a1r - a2i * a1i,
            a2r * a1i + a2i * a1r,
            a2r * b1r - a2i * b1i + b2r,
            a2r * b1i + a2i * b1r + b2i)


def _s5_scan(u, disc, s0, reverse):
    ar, ai, bbr, bbi = disc
    xr = jnp.einsum('blgp,gnp->blgn', u, bbr)
    xi = jnp.einsum('blgp,gnp->blgn', u, bbi)
    if s0 is not None:
        s0r, s0i = s0
        edge = -1 if reverse else 0
        xr = xr.at[:, edge].add(ar * s0r - ai * s0i)
        xi = xi.at[:, edge].add(ar * s0i + ai * s0r)
    a_r = jnp.broadcast_to(ar, xr.shape)
    a_i = jnp.broadcast_to(ai, xi.shape)
    _, _, sr, si = lax.associative_scan(_complex_affine_combine, (a_r, a_i, xr, xi), reverse=reverse, axis=1)
    return sr, si


def _s5_readout(s, c_re, c_im):
    sr, si = s
    return (jnp.einsum('blgn,gpn->blgp', sr, c_re.astype(jnp.float32))
            - jnp.einsum('blgn,gpn->blgp', si, c_im.astype(jnp.float32)))


def _s5_output(s_fwd, s_bwd, u, c_re, c_im, d, glu_w, glu_b):
    Bu, Lu = u.shape[:2]
    y = _s5_readout(s_fwd, c_re[0], c_im[0]) + _s5_readout(s_bwd, c_re[1], c_im[1])
    y = y.reshape(Bu, Lu, SSM_W) + d.astype(jnp.float32) * u.reshape(Bu, Lu, SSM_W)
    g = jax.nn.gelu(y)
    return g * jax.nn.sigmoid(g @ glu_w.astype(jnp.float32) + glu_b.astype(jnp.float32))


def _multiscale_pool(p, pool_w, pool_scale):
    Bp, Lp = p.shape[:2]
    pf = p.astype(jnp.float32)
    cs = jnp.pad(jnp.cumsum(pf, axis=1), ((0, 0), (1, 0), (0, 0)))
    t = jnp.arange(Lp)
    diffs = []
    for g, w in enumerate(POOL_WINDOWS):
        lo = jnp.clip(t - w // 2, 0, Lp)
        hi = jnp.clip(t + w // 2, 0, Lp)
        sl = slice(g * POOL_GROUP, (g + 1) * POOL_GROUP)
        cg = cs[..., sl]
        mean = (cg[:, hi] - cg[:, lo]) / (hi - lo).astype(jnp.float32)[None, :, None]
        diffs.append(mean - pf[..., sl])
    dlt = jnp.stack(diffs, axis=2)
    y = jnp.einsum('blgc,gcd->blgd', dlt, pool_w.astype(jnp.float32)).reshape(Bp, Lp, POOL_W)
    return (y * pool_scale.astype(jnp.float32)).astype(p.dtype)


def _merge_groups(attn, ssm, pool, out_norm_w):
    return jnp.concatenate([_rmsnorm(attn, out_norm_w[:ATTN_W]),
                            _rmsnorm(ssm, out_norm_w[ATTN_W:]),
                            pool], axis=-1)


def _moe(h, router_w, router_b, w_gu, b_gu, w_down, b_down):
    N, D = h.shape
    logits = (h @ router_w + router_b).astype(jnp.float32)
    top_v, top_i = lax.top_k(logits, TOP_K)
    gates = jax.nn.softmax(top_v, axis=-1)
    flat_e = top_i.reshape(-1)
    order = jnp.argsort(flat_e)
    sorted_e = flat_e[order]
    sorted_tok = order // TOP_K
    counts = jnp.bincount(flat_e, length=N_EXPERTS)
    start = jnp.cumsum(counts) - counts
    padded = (counts + MOE_BLOCK - 1) // MOE_BLOCK * MOE_BLOCK
    pend = jnp.cumsum(padded)
    pstart = pend - padded
    n_assign = N * TOP_K
    dest_sorted = pstart[sorted_e] + jnp.arange(n_assign) - start[sorted_e]
    n_blocks = -(-n_assign // MOE_BLOCK) + N_EXPERTS
    rows = n_blocks * MOE_BLOCK
    row_tok = jnp.full((rows,), N, jnp.int32).at[dest_sorted].set(sorted_tok.astype(jnp.int32))
    block_e = jnp.minimum(jnp.searchsorted(pend, jnp.arange(n_blocks) * MOE_BLOCK, side='right'), N_EXPERTS - 1)
    h_pad = jnp.concatenate([h, jnp.zeros((1, D), h.dtype)], axis=0)
    xb = h_pad[row_tok].reshape(n_blocks, MOE_BLOCK, D)

    def expert_block(args):
        xblk, e = args
        gu = xblk @ w_gu[e] + b_gu[e]
        gate, up = jnp.split(gu, 2, axis=-1)
        gate = jnp.minimum(gate, SWIGLU_LIMIT)
        up = jnp.clip(up, -SWIGLU_LIMIT, SWIGLU_LIMIT)
        act = (up + 1) * (gate * jax.nn.sigmoid(SWIGLU_ALPHA * gate))
        return act @ w_down[e] + b_down[e]

    yb = lax.map(expert_block, (xb, block_e)).reshape(rows, D)
    dest = jnp.zeros((n_assign,), dest_sorted.dtype).at[order].set(dest_sorted)
    y = yb[dest].reshape(N, TOP_K, D)
    return jnp.einsum('nkd,nk->nd', y, gates.astype(y.dtype))


def setup_inputs(seed: int = 0) -> dict:
    key = jax.random.key(seed)
    ks = iter(jax.random.split(key, 40))
    f32 = jnp.float32
    D = D_MODEL

    def nrm(shape, scale):
        return jax.random.normal(next(ks), shape, f32) * scale

    x = nrm((BATCH, SEQ, D), 1.0)
    c = nrm((BATCH, D), 1.0)
    ctx = nrm((BATCH, CTX_LEN, D), 1.0)
    c_ctx = nrm((D,), 1.0)
    w_mod = nrm((DEPTH, D, N_MOD * D), 0.5 * D ** -0.5)
    b_mod = nrm((DEPTH, N_MOD * D), 0.02)
    norm1_w = 1.0 + nrm((DEPTH, D), 0.02)
    norm2_w = 1.0 + nrm((DEPTH, D), 0.02)
    w_in = nrm((DEPTH, D, IN_W), D ** -0.5)
    q_norm_w = 1.0 + nrm((DEPTH, HEAD_DIM), 0.02)
    k_norm_w = 1.0 + nrm((DEPTH, HEAD_DIM), 0.02)
    attn_sink = nrm((DEPTH, N_HEADS), 0.5)
    n_idx = jnp.arange(SSM_STATE, dtype=f32)
    ssm_a_re = -0.5 + nrm((DEPTH, 2, SSM_GROUPS, SSM_STATE), 0.01)
    ssm_a_im = math.pi * n_idx + nrm((DEPTH, 2, SSM_GROUPS, SSM_STATE), 0.01)
    ssm_log_dt = jax.random.uniform(next(ks), (DEPTH, 2, SSM_GROUPS), f32, math.log(DT_MIN), math.log(DT_MAX))
    ssm_b_re = nrm((DEPTH, 2, SSM_GROUPS, SSM_STATE, SSM_GROUP), (2 * SSM_GROUP) ** -0.5)
    ssm_b_im = nrm((DEPTH, 2, SSM_GROUPS, SSM_STATE, SSM_GROUP), (2 * SSM_GROUP) ** -0.5)
    ssm_c_re = nrm((DEPTH, 2, SSM_GROUPS, SSM_GROUP, SSM_STATE), SSM_STATE ** -0.5)
    ssm_c_im = nrm((DEPTH, 2, SSM_GROUPS, SSM_GROUP, SSM_STATE), SSM_STATE ** -0.5)
    ssm_d = nrm((DEPTH, SSM_W), 1.0)
    glu_w = nrm((DEPTH, SSM_W, SSM_W), SSM_W ** -0.5)
    glu_b = nrm((DEPTH, SSM_W), 0.02)
    pool_w = nrm((DEPTH, len(POOL_WINDOWS), POOL_GROUP, POOL_GROUP), POOL_GROUP ** -0.5)
    pool_scale = 1.0 + nrm((DEPTH, POOL_W), 0.02)
    out_norm_w = 1.0 + nrm((DEPTH, ATTN_W + SSM_W), 0.02)
    w_out = nrm((DEPTH, MIX_W, D), MIX_W ** -0.5)
    router_w = nrm((DEPTH, D, N_EXPERTS), D ** -0.5)
    router_b = nrm((DEPTH, N_EXPERTS), 0.01)
    exp_w_gu = nrm((DEPTH, N_EXPERTS, D, 2 * D_FF_EXPERT), D ** -0.5)
    exp_b_gu = nrm((DEPTH, N_EXPERTS, 2 * D_FF_EXPERT), 0.02)
    exp_w_down = nrm((DEPTH, N_EXPERTS, D_FF_EXPERT, D), D_FF_EXPERT ** -0.5)
    exp_b_down = nrm((DEPTH, N_EXPERTS, D), 0.02)
    return {'x': x, 'c': c, 'ctx': ctx, 'c_ctx': c_ctx, 'w_mod': w_mod, 'b_mod': b_mod,
            'norm1_w': norm1_w, 'norm2_w': norm2_w, 'w_in': w_in, 'q_norm_w': q_norm_w,
            'k_norm_w': k_norm_w, 'attn_sink': attn_sink, 'ssm_a_re': ssm_a_re, 'ssm_a_im': ssm_a_im,
            'ssm_log_dt': ssm_log_dt, 'ssm_b_re': ssm_b_re, 'ssm_b_im': ssm_b_im, 'ssm_c_re': ssm_c_re,
            'ssm_c_im': ssm_c_im, 'ssm_d': ssm_d, 'glu_w': glu_w, 'glu_b': glu_b, 'pool_w': pool_w,
            'pool_scale': pool_scale, 'out_norm_w': out_norm_w, 'w_out': w_out, 'router_w': router_w,
            'router_b': router_b, 'exp_w_gu': exp_w_gu, 'exp_b_gu': exp_b_gu, 'exp_w_down': exp_w_down,
            'exp_b_down': exp_b_down}


def reference(x, c, ctx, c_ctx, w_mod, b_mod, norm1_w, norm2_w, w_in, q_norm_w, k_norm_w, attn_sink,
              ssm_a_re, ssm_a_im, ssm_log_dt, ssm_b_re, ssm_b_im, ssm_c_re, ssm_c_im, ssm_d, glu_w, glu_b,
              pool_w, pool_scale, out_norm_w, w_out, router_w, router_b, exp_w_gu, exp_b_gu, exp_w_down,
              exp_b_down):
    B, L, D = x.shape
    Lc = ctx.shape[1]
    cos, sin = _axial_rope_tables(L)
    silu_c = jax.nn.silu(c)
    silu_cc = jax.nn.silu(c_ctx)
    for l in range(DEPTH):
        last = l == DEPTH - 1
        mod = jnp.split((silu_c @ w_mod[l] + b_mod[l])[:, None, :], N_MOD, axis=-1)
        n_cm = 2 if last else N_MOD
        mod_c = jnp.split(silu_cc @ w_mod[l][:, :n_cm * D] + b_mod[l][:n_cm * D], n_cm)

        hx = _modulate(_rmsnorm(x, norm1_w[l]), mod[0], mod[1])
        hc = _modulate(_rmsnorm(ctx, norm1_w[l]), mod_c[0], mod_c[1])
        px = hx @ w_in[l]
        c_lo, c_hi = (Q_END, U_END) if last else (0, P_END)
        pc = hc @ w_in[l][:, c_lo:c_hi]

        q = _apply_rope(_rmsnorm(px[..., :Q_END].reshape(B, L, N_HEADS, HEAD_DIM), q_norm_w[l]), cos, sin)
        k = _apply_rope(_rmsnorm(px[..., Q_END:K_END].reshape(B, L, N_KV_HEADS, HEAD_DIM), k_norm_w[l]), cos, sin)
        v = px[..., K_END:V_END].reshape(B, L, N_KV_HEADS, HEAD_DIM)
        kc = _rmsnorm(_cols(pc, c_lo, Q_END, K_END).reshape(B, Lc, N_KV_HEADS, HEAD_DIM), k_norm_w[l])
        vc = _cols(pc, c_lo, K_END, V_END).reshape(B, Lc, N_KV_HEADS, HEAD_DIM)
        attn_x = _window_attention(q, k, v, kc, vc, attn_sink[l])

        disc_f = _s5_discretize(ssm_a_re[l, 0], ssm_a_im[l, 0], ssm_log_dt[l, 0], ssm_b_re[l, 0], ssm_b_im[l, 0])
        disc_b = _s5_discretize(ssm_a_re[l, 1], ssm_a_im[l, 1], ssm_log_dt[l, 1], ssm_b_re[l, 1], ssm_b_im[l, 1])
        u_x = px[..., V_END:U_END].reshape(B, L, SSM_GROUPS, SSM_GROUP).astype(jnp.float32)
        u_c = _cols(pc, c_lo, V_END, U_END).reshape(B, Lc, SSM_GROUPS, SSM_GROUP).astype(jnp.float32)
        sc_f = _s5_scan(u_c, disc_f, None, reverse=False)
        sc_b = _s5_scan(u_c, disc_b, None, reverse=True)
        sx_f = _s5_scan(u_x, disc_f, (sc_f[0][:, -1], sc_f[1][:, -1]), reverse=False)
        sx_b = _s5_scan(u_x, disc_b, (sc_b[0][:, 0], sc_b[1][:, 0]), reverse=True)
        ssm_x = _s5_output(sx_f, sx_b, u_x, ssm_c_re[l], ssm_c_im[l], ssm_d[l], glu_w[l], glu_b[l]).astype(x.dtype)

        pool_x = _multiscale_pool(px[..., U_END:P_END], pool_w[l], pool_scale[l])

        x = x + mod[2] * (_merge_groups(attn_x, ssm_x, pool_x, out_norm_w[l]) @ w_out[l])
        if not last:
            qc = _rmsnorm(_cols(pc, c_lo, 0, Q_END).reshape(B, Lc, N_HEADS, HEAD_DIM), q_norm_w[l])
            attn_c = _ctx_attention(qc, kc, vc, attn_sink[l])
            ssm_c = _s5_output(sc_f, sc_b, u_c, ssm_c_re[l], ssm_c_im[l], ssm_d[l], glu_w[l], glu_b[l]).astype(ctx.dtype)
            pool_c = _multiscale_pool(_cols(pc, c_lo, U_END, P_END), pool_w[l], pool_scale[l])
            ctx = ctx + mod_c[2] * (_merge_groups(attn_c, ssm_c, pool_c, out_norm_w[l]) @ w_out[l])

        h2x = _modulate(_rmsnorm(x, norm2_w[l]), mod[3], mod[4]).reshape(B * L, D)
        if last:
            y2 = _moe(h2x, router_w[l], router_b[l], exp_w_gu[l], exp_b_gu[l], exp_w_down[l], exp_b_down[l])
            x = x + mod[5] * y2.reshape(B, L, D)
        else:
            h2c = _modulate(_rmsnorm(ctx, norm2_w[l]), mod_c[3], mod_c[4]).reshape(B * Lc, D)
            y2 = _moe(jnp.concatenate([h2x, h2c], axis=0), router_w[l], router_b[l], exp_w_gu[l],
                      exp_b_gu[l], exp_w_down[l], exp_b_down[l])
            x = x + mod[5] * y2[:B * L].reshape(B, L, D)
            ctx = ctx + mod_c[5] * y2[B * L:].reshape(B, Lc, D)
    return x
```

```cpp
#include <hip/hip_runtime.h>
#include <cstdio>
#include <cstdint>

constexpr int D = 1024, NBATCH = 8, SEQ = 2048, CTXL = 256, DEPTH = 4;
constexpr int TL = NBATCH * SEQ, TC = NBATCH * CTXL, TA = TL + TC;
constexpr int INW = 1280, NE = 32, TOPK = 4, NMOD = 6;
constexpr int NT = 512;
constexpr float EPS = 1e-6f;
constexpr int LISTCAP = TA * TOPK;
constexpr int ACT_ROWS = TA * TOPK + NE * 128;

constexpr size_t al256(size_t x) { return (x + 255) & ~(size_t)255; }
constexpr size_t WS_CTL = 0;
constexpr size_t CTL_BYTES = 65536;
constexpr size_t CW_BAR = 0;
constexpr size_t CW_CNT = 4096;
constexpr size_t WS_MOD = WS_CTL + CTL_BYTES;
constexpr size_t WS_ROPE = al256(WS_MOD + (size_t)DEPTH * 9 * 6144 * 4);
constexpr size_t WS_DISC = al256(WS_ROPE + (size_t)2 * 2048 * 64 * 4);
constexpr size_t WS_XS = al256(WS_DISC + (size_t)(4096 + 65536) * 4);
constexpr size_t WS_H = al256(WS_XS + (size_t)TA * D * 4);
constexpr size_t WS_PX = al256(WS_H + (size_t)TA * D * 4);
constexpr size_t WS_QN = al256(WS_PX + (size_t)TA * INW * 4);
constexpr size_t WS_KN = al256(WS_QN + (size_t)TA * 512 * 4);
constexpr size_t WS_ATT = al256(WS_KN + (size_t)TA * 128 * 4);
constexpr size_t WS_DLT = al256(WS_ATT + (size_t)TA * 512 * 4);
constexpr size_t WS_G = al256(WS_DLT + (size_t)TA * 256 * 4);
constexpr size_t WS_SO = al256(WS_G + (size_t)TA * 256 * 4);
constexpr size_t WS_MRG = al256(WS_SO + (size_t)TA * 256 * 4);
constexpr size_t WS_ST = al256(WS_MRG + (size_t)TA * D * 4);
constexpr size_t WS_TOPI = al256(WS_ST + (size_t)2 * TA * 16 * 64 * 8);
constexpr size_t WS_GATE = al256(WS_TOPI + (size_t)TA * 4 * 4);
constexpr size_t WS_LIST = al256(WS_GATE + (size_t)TA * 4 * 4);
constexpr size_t WS_ACT = al256(WS_LIST + (size_t)NE * LISTCAP * 4);
constexpr size_t WS_YB = al256(WS_ACT + (size_t)ACT_ROWS * D * 4);
constexpr size_t WS_END = al256(WS_YB + (size_t)TA * TOPK * D * 4);

#define XB_TMO      128
#define XB_XCNT(j)  (256  + 64 * (j))
#define XB_XSUB(j)  (1280 + 64 * (j))
#define XB_XGEN(j)  (2304 + 64 * (j))
#define XB_TOP      3328
#define XB_TOPGEN   3392
#define XCD_BAR_WORDS 3456
#define XB_SPIN_CAP (1u << 25)
#define LAS __attribute__((address_space(3)))

__device__ __forceinline__ unsigned xb_ld(unsigned* p)              { return __hip_atomic_load(p, __ATOMIC_RELAXED, __HIP_MEMORY_SCOPE_AGENT); }
__device__ __forceinline__ unsigned xb_add(unsigned* p, unsigned v) { return __hip_atomic_fetch_add(p, v, __ATOMIC_RELAXED, __HIP_MEMORY_SCOPE_AGENT); }
__device__ __forceinline__ unsigned xb_xcc_id() { return (unsigned)__builtin_amdgcn_s_getreg((3 << 11) | 20) & 0xFu; }
#define XB_SPIN(cond, bar) do { unsigned _sp = 0; while (cond) { __builtin_amdgcn_s_sleep(1); \
    if ((++_sp & 255u) == 0u) { if (xb_ld(&(bar)[XB_TMO])) break; if (_sp > XB_SPIN_CAP) { atomicAdd(&(bar)[XB_TMO], 1u); break; } } } } while (0)

struct XcdBarrier { unsigned* bar; unsigned x; volatile LAS unsigned* st; };

__device__ __forceinline__ XcdBarrier xcd_barrier_post(unsigned* bar, volatile LAS unsigned* st) {
    XcdBarrier b; b.bar = bar; b.x = xb_xcc_id(); b.st = st;
    if (threadIdx.x == 0) (void)xb_add(&bar[XB_XCNT(b.x)], 1u);
    return b;
}
__device__ __forceinline__ void xcd_barrier_complete(unsigned* bar, unsigned x, unsigned& nloc, unsigned& nx) {
    const unsigned G = gridDim.x * gridDim.y * gridDim.z;
    unsigned sum, cnt, mine, sp = 0u;
    for (;;) {
        sum = 0u; cnt = 0u; mine = 0u;
#pragma unroll
        for (unsigned j = 0; j < 16; ++j) { const unsigned c = xb_ld(&bar[XB_XCNT(j)]); sum += c; cnt += (c > 0u) ? 1u : 0u; mine = (j == x) ? c : mine; }
        if (sum == G) break;
        __builtin_amdgcn_s_sleep(1);
        if ((++sp & 255u) == 0u) { if (xb_ld(&bar[XB_TMO])) break; if (sp > XB_SPIN_CAP) { atomicAdd(&bar[XB_TMO], 1u); break; } }
    }
    nloc = mine > 0u ? mine : 1u; nx = cnt > 0u ? cnt : 1u;
}
__device__ __forceinline__ void xcd_barrier(const XcdBarrier& b) {
    asm volatile("s_waitcnt vmcnt(0)" ::: "memory");
    __syncthreads();
    if (threadIdx.x == 0) {
        unsigned* bar = b.bar;
        __builtin_amdgcn_s_waitcnt(0);
        unsigned nloc = b.st[0], nx = b.st[1];
        if (nloc == 0u) { xcd_barrier_complete(bar, b.x, nloc, nx); b.st[0] = nloc; b.st[1] = nx; }
        const unsigned old = xb_add(&bar[XB_XSUB(b.x)], 1u);
        const unsigned gen = old / nloc;
        if (old + 1u == (gen + 1u) * nloc) {
            __builtin_amdgcn_fence(__ATOMIC_RELEASE, "agent");
            asm volatile("s_waitcnt vmcnt(0)" ::: "memory");
            const unsigned og = xb_add(&bar[XB_TOP], 1u);
            const unsigned tg = og / nx;
            if (og + 1u == (tg + 1u) * nx) xb_add(&bar[XB_TOPGEN], 1u);
            else XB_SPIN(xb_ld(&bar[XB_TOPGEN]) == tg, bar);
            __builtin_amdgcn_fence(__ATOMIC_ACQUIRE, "agent");
            xb_add(&bar[XB_XGEN(b.x)], 1u);
            asm volatile("s_waitcnt vmcnt(0)" ::: "memory");
        } else {
            XB_SPIN(xb_ld(&bar[XB_XGEN(b.x)]) == gen, bar);
            __builtin_amdgcn_fence(__ATOMIC_ACQUIRE, "agent");
            asm volatile("s_waitcnt vmcnt(0)" ::: "memory");
        }
    }
    __syncthreads();
}

struct Args { const float* in[32]; float* out; unsigned char* ws; int ph_lo, ph_hi; };

enum { I_X = 0, I_C, I_CTX, I_CCTX, I_WMOD, I_BMOD, I_N1W, I_N2W, I_WIN, I_QNW, I_KNW, I_SINK, I_ARE, I_AIM, I_LOGDT, I_BRE, I_BIM,
       I_CRE, I_CIM, I_SSMD, I_GLUW, I_GLUB, I_POOLW, I_POOLS, I_ONW, I_WOUT, I_RW, I_RB, I_WGU, I_BGU, I_WDN, I_BDN };

__device__ __forceinline__ float wave_sum(float v) {
#pragma unroll
    for (int o = 32; o > 0; o >>= 1) v += __shfl_xor(v, o);
    return v;
}
__device__ __forceinline__ float silu_f(float x) { return x / (1.f + __expf(-x)); }
__device__ __forceinline__ float sigmoid_f(float x) { return 1.f / (1.f + __expf(-x)); }
__device__ __forceinline__ float gelu_tanh_f(float x) { const float u = 0.7978845608028654f * (x + 0.044715f * x * x * x); return 0.5f * x * (1.f + tanhf(u)); }
__device__ __forceinline__ int mrow_of(int row) { return row < TL ? (row >> 11) : 8; }

template <class BF, class EF>
__device__ __forceinline__ void ngemm_tile(float* sm, const int tid, const float* arow, int K, BF bf, EF ef) {
    float (*As)[132] = (float (*)[132])sm;
    float (*Bs)[68] = (float (*)[68])(sm + 16 * 132);
    const int am = tid >> 2, ak = (tid & 3) * 4, bk = tid >> 5, bn = (tid & 31) * 2, ty = tid >> 4, tx = tid & 15;
    float acc[4][4];
#pragma unroll
    for (int i = 0; i < 4; ++i)
#pragma unroll
        for (int j = 0; j < 4; ++j) acc[i][j] = 0.f;
    for (int k0 = 0; k0 < K; k0 += 16) {
        float4 av = make_float4(0.f, 0.f, 0.f, 0.f);
        if (arow) av = *(const float4*)(arow + k0 + ak);
        const float b0 = bf(k0 + bk, bn), b1 = bf(k0 + bk, bn + 1);
        __syncthreads();
        As[ak + 0][am] = av.x; As[ak + 1][am] = av.y; As[ak + 2][am] = av.z; As[ak + 3][am] = av.w;
        Bs[bk][bn] = b0; Bs[bk][bn + 1] = b1;
        __syncthreads();
#pragma unroll
        for (int kk = 0; kk < 16; ++kk) {
            const float4 a4 = *(const float4*)&As[kk][ty * 4];
            const float4 b4 = *(const float4*)&Bs[kk][tx * 4];
            const float aa[4] = {a4.x, a4.y, a4.z, a4.w}, bb[4] = {b4.x, b4.y, b4.z, b4.w};
#pragma unroll
            for (int i = 0; i < 4; ++i)
#pragma unroll
                for (int j = 0; j < 4; ++j) acc[i][j] += aa[i] * bb[j];
        }
    }
#pragma unroll
    for (int i = 0; i < 4; ++i) ef(ty * 4 + i, tx * 4, acc[i]);
}

__global__ void __launch_bounds__(NT, 2) fwd(Args args) {
    __shared__ __attribute__((aligned(16))) float smem[9 * 1024 + 8 * 9 * 64];
    __shared__ uint4 xb_words;
    const int bid = blockIdx.x, nb = gridDim.x;
    const int nwaves = nb * (NT / 64), gthreads = nb * NT;
#define PH_IDS int tid = threadIdx.x; asm volatile("" : "+v"(tid)); const int lane = tid & 63, wave = tid >> 6, gw = wave * nb + bid, gtid = bid * NT + tid; (void)lane; (void)wave; (void)gw; (void)gtid
    unsigned char* ws = args.ws;
    unsigned* ctl = (unsigned*)(ws + WS_CTL);
    float* MOD = (float*)(ws + WS_MOD);
    float* ROPEC = (float*)(ws + WS_ROPE); float* ROPES = ROPEC + 2048 * 64;
    float* DISC = (float*)(ws + WS_DISC);
    float* XS = (float*)(ws + WS_XS); float* H = (float*)(ws + WS_H); float* PX = (float*)(ws + WS_PX);
    float* QN = (float*)(ws + WS_QN); float* KN = (float*)(ws + WS_KN); float* ATT = (float*)(ws + WS_ATT);
    float* DLT = (float*)(ws + WS_DLT); float* G = (float*)(ws + WS_G); float* SO = (float*)(ws + WS_SO); float* MRG = (float*)(ws + WS_MRG);
    float2* ST = (float2*)(ws + WS_ST);
    int* TOPI = (int*)(ws + WS_TOPI); float* GATE = (float*)(ws + WS_GATE); int* LIST = (int*)(ws + WS_LIST);
    float* ACT = (float*)(ws + WS_ACT); float* YB = (float*)(ws + WS_YB);

    if (threadIdx.x == 0) xb_words = make_uint4(0u, 0u, 0u, 0u);
    __syncthreads();
    XcdBarrier bar = xcd_barrier_post(ctl + CW_BAR, (volatile LAS unsigned*)&xb_words);
    const int lo = args.ph_lo, hi = args.ph_hi;
    int ph = 0;
#define IN_PH() (lo <= ph && ph < hi)
#define SEAM() do { if (lo <= ph && ph + 1 < hi) xcd_barrier(bar); ++ph; } while (0)

    if (IN_PH()) { PH_IDS;
        {   const float4* x4 = (const float4*)args.in[I_X]; const float4* c4 = (const float4*)args.in[I_CTX]; float4* xs4 = (float4*)XS;
            for (size_t i = gtid; i < (size_t)TA * 256; i += gthreads) xs4[i] = i < (size_t)TL * 256 ? x4[i] : c4[i - (size_t)TL * 256]; }
        for (int i = gtid; i < 2048 * 64; i += gthreads) {
            const int t = i >> 6, d = i & 63, f = d & 15, axis = d >> 5;
            const float pos = axis == 0 ? (float)(t >> 6) : (float)(t & 63);
            const float inv = powf(10000.f, -(float)(2 * f) / 32.f);
            const float ang = pos * inv;
            ROPEC[i] = cosf(ang); ROPES[i] = sinf(ang);
        }
        for (int i = tid; i < 9 * 1024; i += NT) { const float v = i < 8192 ? args.in[I_C][i] : args.in[I_CCTX][i - 8192]; smem[i] = silu_f(v); }
        __syncthreads();
        for (int it = bid; it < DEPTH * 96; it += nb) {
            const int l = it / 96, j = (it % 96) * 64 + lane;
            const float* w = args.in[I_WMOD] + (size_t)l * D * 6144 + j;
            float acc[9];
#pragma unroll
            for (int m = 0; m < 9; ++m) acc[m] = 0.f;
            for (int k = wave * 128; k < wave * 128 + 128; ++k) {
                const float wv = w[(size_t)k * 6144];
#pragma unroll
                for (int m = 0; m < 9; ++m) acc[m] += smem[m * 1024 + k] * wv;
            }
            float* pb = smem + 9 * 1024;
#pragma unroll
            for (int m = 0; m < 9; ++m) pb[(wave * 9 + m) * 64 + lane] = acc[m];
            __syncthreads();
            if (wave == 0) {
                const float bias = args.in[I_BMOD][(size_t)l * 6144 + j];
#pragma unroll
                for (int m = 0; m < 9; ++m) { float s = 0.f;
#pragma unroll
                    for (int w8 = 0; w8 < 8; ++w8) s += pb[(w8 * 9 + m) * 64 + lane];
                    MOD[((size_t)l * 9 + m) * 6144 + j] = s + bias; }
            }
            __syncthreads();
        }
    }
    SEAM();

    for (int l = 0; l < DEPTH; ++l) {
        const float* modl = MOD + (size_t)l * 9 * 6144;
        const int nrows_moe = (l == DEPTH - 1) ? TL : TA;
        unsigned* counts = ctl + CW_CNT + l * NE;

        if (IN_PH()) { PH_IDS;
            const float* n1w = args.in[I_N1W] + l * D;
            for (int row = gw; row < TA; row += nwaves) {
                const int mr = mrow_of(row);
                float4* xr = (float4*)(XS + (size_t)row * D);
                float4 v[4];
#pragma unroll
                for (int i = 0; i < 4; ++i) v[i] = xr[lane + i * 64];
                if (l > 0) {
                    const float* g2 = MOD + ((size_t)(l - 1) * 9 + mr) * 6144 + 5 * D;
                    float gk[4];
#pragma unroll
                    for (int k = 0; k < 4; ++k) gk[k] = GATE[row * 4 + k];
#pragma unroll
                    for (int i = 0; i < 4; ++i) {
                        float4 s = make_float4(0.f, 0.f, 0.f, 0.f);
#pragma unroll
                        for (int k = 0; k < 4; ++k) { const float4 y = ((const float4*)(YB + ((size_t)row * 4 + k) * D))[lane + i * 64];
                            s.x += gk[k] * y.x; s.y += gk[k] * y.y; s.z += gk[k] * y.z; s.w += gk[k] * y.w; }
                        const float4 gg = ((const float4*)g2)[lane + i * 64];
                        v[i].x += gg.x * s.x; v[i].y += gg.y * s.y; v[i].z += gg.z * s.z; v[i].w += gg.w * s.w;
                        xr[lane + i * 64] = v[i];
                    }
                }
                float ss = 0.f;
#pragma unroll
                for (int i = 0; i < 4; ++i) ss += v[i].x * v[i].x + v[i].y * v[i].y + v[i].z * v[i].z + v[i].w * v[i].w;
                ss = wave_sum(ss);
                const float rstd = rsqrtf(ss * (1.f / D) + EPS);
                const float4* sh = (const float4*)(modl + (size_t)mr * 6144), *sc = (const float4*)(modl + (size_t)mr * 6144 + D);
                float4* hr = (float4*)(H + (size_t)row * D);
#pragma unroll
                for (int i = 0; i < 4; ++i) {
                    const float4 w4 = ((const float4*)n1w)[lane + i * 64], s4 = sh[lane + i * 64], c4 = sc[lane + i * 64];
                    float4 o;
                    o.x = v[i].x * rstd * w4.x * (1.f + c4.x) + s4.x; o.y = v[i].y * rstd * w4.y * (1.f + c4.y) + s4.y;
                    o.z = v[i].z * rstd * w4.z * (1.f + c4.z) + s4.z; o.w = v[i].w * rstd * w4.w * (1.f + c4.w) + s4.w;
                    hr[lane + i * 64] = o;
                }
            }
            for (int i = gtid; i < 2048; i += gthreads) {
                const int dg = i >> 6;
                const size_t pbase = (size_t)l * 2048 + i;
                const double are = args.in[I_ARE][pbase], aim = args.in[I_AIM][pbase];
                const double dt = exp((double)args.in[I_LOGDT][l * 32 + dg]);
                const double mag = exp(are * dt), ar = mag * cos(aim * dt), ai = mag * sin(aim * dt);
                const double den = are * are + aim * aim;
                const double qr = ((ar - 1.0) * are + ai * aim) / den, qi = (ai * are - (ar - 1.0) * aim) / den;
                DISC[i] = (float)ar; DISC[2048 + i] = (float)ai;
                const float* br = args.in[I_BRE] + pbase * 16; const float* bi = args.in[I_BIM] + pbase * 16;
                for (int p = 0; p < 16; ++p) {
                    DISC[4096 + i * 16 + p] = (float)(qr * br[p] - qi * bi[p]);
                    DISC[4096 + 32768 + i * 16 + p] = (float)(qr * bi[p] + qi * br[p]);
                }
            }
        }
        SEAM();

        if (IN_PH()) { PH_IDS;
            const float* W = args.in[I_WIN] + (size_t)l * D * INW;
            for (int u = bid; u < (TA / 128) * (INW / 64); u += nb) {
                const int mt = u / (INW / 64), ntl = u % (INW / 64), m0 = mt * 128, n0 = ntl * 64;
                ngemm_tile(smem, tid, H + (size_t)(m0 + (tid >> 2)) * D, D,
                    [&](int k, int n) { return W[(size_t)k * INW + n0 + n]; },
                    [&](int m, int n, const float (&a)[4]) { *(float4*)(PX + (size_t)(m0 + m) * INW + n0 + n) = make_float4(a[0], a[1], a[2], a[3]); });
            }
        }
        SEAM();

        if (IN_PH()) { PH_IDS;
            const int n_scan = 256, n_qk = TA * 10, n_dl = TA * 4;
            for (int it = gw; it < n_scan + n_qk + n_dl; it += nwaves) {
                if (it < n_scan) {
                    const int b = it >> 5, dir = (it >> 4) & 1, g = it & 15, n = lane;
                    const int di = (dir * 16 + g) * 64 + n;
                    const float ar = DISC[di], ai = DISC[2048 + di];
                    float bbr[16], bbi[16];
#pragma unroll
                    for (int p = 0; p < 16; ++p) { bbr[p] = DISC[4096 + di * 16 + p]; bbi[p] = DISC[4096 + 32768 + di * 16 + p]; }
                    float sr = 0.f, si = 0.f;
                    for (int step = 0; step < CTXL + SEQ; ++step) {
                        int row;
                        if (step < CTXL) row = TL + b * CTXL + (dir == 0 ? step : CTXL - 1 - step);
                        else { const int t = step - CTXL; row = b * SEQ + (dir == 0 ? t : SEQ - 1 - t); }
                        const float4* up = (const float4*)(PX + (size_t)row * INW + 768 + g * 16);
                        const float4 u0 = up[0], u1 = up[1], u2 = up[2], u3 = up[3];
                        const float uu[16] = {u0.x, u0.y, u0.z, u0.w, u1.x, u1.y, u1.z, u1.w, u2.x, u2.y, u2.z, u2.w, u3.x, u3.y, u3.z, u3.w};
                        float xr = 0.f, xi = 0.f;
#pragma unroll
                        for (int p = 0; p < 16; ++p) { xr += bbr[p] * uu[p]; xi += bbi[p] * uu[p]; }
                        const float nsr = ar * sr - ai * si + xr, nsi = ar * si + ai * sr + xi;
                        sr = nsr; si = nsi;
                        ST[(((size_t)dir * TA + row) * 16 + g) * 64 + n] = make_float2(sr, si);
                    }
                } else if (it < n_scan + n_qk) {
                    const int j = it - n_scan, row = j / 10, hh = j % 10, d = lane;
                    const float v = PX[(size_t)row * INW + hh * 64 + d];
                    const float ss = wave_sum(v * v);
                    const float w = hh < 8 ? args.in[I_QNW][l * 64 + d] : args.in[I_KNW][l * 64 + d];
                    float y = v * rsqrtf(ss * (1.f / 64.f) + EPS) * w;
                    const float yp = __shfl_xor(y, 16);
                    if (row < TL) {
                        const int t = row & (SEQ - 1);
                        const float c = ROPEC[t * 64 + d], s = ROPES[t * 64 + d];
                        y = y * c + (((d >> 4) & 1) ? yp : -yp) * s;
                    }
                    if (hh < 8) QN[(size_t)row * 512 + hh * 64 + d] = y; else KN[(size_t)row * 128 + (hh - 8) * 64 + d] = y;
                } else {
                    const int j = it - n_scan - n_qk, row = j >> 2, g4 = j & 3, ch = g4 * 64 + lane, hw = 1 << g4;
                    int base, t, L;
                    if (row < TL) { base = row & ~(SEQ - 1); t = row & (SEQ - 1); L = SEQ; } else { const int r2 = row - TL; base = TL + (r2 & ~(CTXL - 1)); t = r2 & (CTXL - 1); L = CTXL; }
                    const int tlo = max(t - hw, 0), thi = min(t + hw, L);
                    float s = 0.f;
                    for (int tt = tlo; tt < thi; ++tt) s += PX[(size_t)(base + tt) * INW + 1024 + ch];
                    DLT[(size_t)row * 256 + ch] = s / (float)(thi - tlo) - PX[(size_t)row * INW + 1024 + ch];
                }
            }
        }
        SEAM();

        if (IN_PH()) { PH_IDS;
            for (int it = gw; it < (TA / 32) * 8; it += nwaves) {
                const int rb = it >> 3, h = it & 7, kvh = h >> 2;
                const int qi = lane >> 1, half = lane & 1;
                const int row = rb * 32 + qi;
                const bool lat = rb < TL / 32;
                const int b = lat ? (rb >> 6) : ((rb - TL / 32) >> 3);
                const int t0 = lat ? ((rb & 63) * 32) : 0, t = t0 + qi;
                float q[32], o[32];
                {   const float4* qp = (const float4*)(QN + (size_t)row * 512 + h * 64 + half * 32);
#pragma unroll
                    for (int i = 0; i < 8; ++i) { const float4 x = qp[i]; q[4 * i] = x.x * 0.125f; q[4 * i + 1] = x.y * 0.125f; q[4 * i + 2] = x.z * 0.125f; q[4 * i + 3] = x.w * 0.125f; } }
#pragma unroll
                for (int i = 0; i < 32; ++i) o[i] = 0.f;
                float m = args.in[I_SINK][l * 8 + h], lsum = 1.f;
                const int klo = max(t0 - 128, 0), khi = min(t0 + 31 + 128, SEQ - 1);
                for (int pass = lat ? 0 : 1; pass < 2; ++pass) {
                    const int k_begin = pass == 0 ? klo : 0, k_end = pass == 0 ? khi + 1 : CTXL, krow0 = pass == 0 ? b * SEQ : TL + b * CTXL;
                    for (int kt = k_begin; kt < k_end; ++kt) {
                        const int kr = krow0 + kt;
                        const float4* kp = (const float4*)(KN + (size_t)kr * 128 + kvh * 64 + half * 32);
                        float s = 0.f;
#pragma unroll
                        for (int i = 0; i < 8; ++i) { const float4 x = kp[i]; s += q[4 * i] * x.x + q[4 * i + 1] * x.y + q[4 * i + 2] * x.z + q[4 * i + 3] * x.w; }
                        s += __shfl_xor(s, 1);
                        const bool valid = (pass == 1) || (abs(t - kt) <= 128);
                        if (valid) {
                            const float mn = fmaxf(m, s), sc = __expf(m - mn), p = __expf(s - mn);
                            lsum = lsum * sc + p; m = mn;
                            const float4* vp = (const float4*)(PX + (size_t)kr * INW + 640 + kvh * 64 + half * 32);
#pragma unroll
                            for (int i = 0; i < 8; ++i) { const float4 x = vp[i];
                                o[4 * i] = o[4 * i] * sc + p * x.x; o[4 * i + 1] = o[4 * i + 1] * sc + p * x.y; o[4 * i + 2] = o[4 * i + 2] * sc + p * x.z; o[4 * i + 3] = o[4 * i + 3] * sc + p * x.w; }
                        }
                    }
                }
                const float inv = 1.f / lsum;
                float4* op = (float4*)(ATT + (size_t)row * 512 + h * 64 + half * 32);
#pragma unroll
                for (int i = 0; i < 8; ++i) op[i] = make_float4(o[4 * i] * inv, o[4 * i + 1] * inv, o[4 * i + 2] * inv, o[4 * i + 3] * inv);
            }
            const float* cre = args.in[I_CRE] + (size_t)l * 2 * 16 * 16 * 64; const float* cim = args.in[I_CIM] + (size_t)l * 2 * 16 * 16 * 64;
            for (size_t i = gtid; i < (size_t)TA * 256; i += gthreads) {
                const int row = (int)(i >> 8), c = (int)(i & 255), g = c >> 4, p = c & 15;
                float y = 0.f;
                for (int dir = 0; dir < 2; ++dir) {
                    const float2* st = ST + (((size_t)dir * TA + row) * 16 + g) * 64;
                    const float* cr = cre + ((size_t)(dir * 16 + g) * 16 + p) * 64; const float* ci = cim + ((size_t)(dir * 16 + g) * 16 + p) * 64;
                    for (int n = 0; n < 64; ++n) { const float2 s = st[n]; y += s.x * cr[n] - s.y * ci[n]; }
                }
                y += args.in[I_SSMD][l * 256 + c] * PX[(size_t)row * INW + 768 + c];
                G[i] = gelu_tanh_f(y);
                const int g4 = c >> 6, dd = c & 63;
                const float* pw = args.in[I_POOLW] + ((size_t)l * 4 + g4) * 64 * 64 + dd;
                const float* dl = DLT + (size_t)row * 256 + g4 * 64;
                float z = 0.f;
                for (int cc = 0; cc < 64; ++cc) z += dl[cc] * pw[cc * 64];
                MRG[(size_t)row * D + 768 + c] = z * args.in[I_POOLS][l * 256 + c];
            }
        }
        SEAM();

        if (IN_PH()) { PH_IDS;
            const float* W = args.in[I_GLUW] + (size_t)l * 256 * 256; const float* gb = args.in[I_GLUB] + l * 256;
            for (int u = bid; u < (TA / 128) * 4; u += nb) {
                const int mt = u >> 2, m0 = mt * 128, n0 = (u & 3) * 64;
                ngemm_tile(smem, tid, G + (size_t)(m0 + (tid >> 2)) * 256, 256,
                    [&](int k, int n) { return W[(size_t)k * 256 + n0 + n]; },
                    [&](int m, int n, const float (&a)[4]) {
#pragma unroll
                        for (int j = 0; j < 4; ++j) { const size_t idx = (size_t)(m0 + m) * 256 + n0 + n + j; SO[idx] = G[idx] * sigmoid_f(a[j] + gb[n0 + n + j]); } });
            }
        }
        SEAM();

        if (IN_PH()) { PH_IDS;
            const float* onw = args.in[I_ONW] + l * 768;
            for (int row = gw; row < TA; row += nwaves) {
                const float4* ap = (const float4*)(ATT + (size_t)row * 512);
                const float4 a0 = ap[lane], a1 = ap[lane + 64];
                float ss = a0.x * a0.x + a0.y * a0.y + a0.z * a0.z + a0.w * a0.w + a1.x * a1.x + a1.y * a1.y + a1.z * a1.z + a1.w * a1.w;
                ss = wave_sum(ss);
                const float ra = rsqrtf(ss * (1.f / 512.f) + EPS);
                const float4 s0 = ((const float4*)(SO + (size_t)row * 256))[lane];
                float s2 = wave_sum(s0.x * s0.x + s0.y * s0.y + s0.z * s0.z + s0.w * s0.w);
                const float rs = rsqrtf(s2 * (1.f / 256.f) + EPS);
                float4* mp = (float4*)(MRG + (size_t)row * D);
                const float4 w0 = ((const float4*)onw)[lane], w1 = ((const float4*)onw)[lane + 64], w2 = ((const float4*)onw)[lane + 128];
                mp[lane] = make_float4(a0.x * ra * w0.x, a0.y * ra * w0.y, a0.z * ra * w0.z, a0.w * ra * w0.w);
                mp[lane + 64] = make_float4(a1.x * ra * w1.x, a1.y * ra * w1.y, a1.z * ra * w1.z, a1.w * ra * w1.w);
                mp[lane + 128] = make_float4(s0.x * rs * w2.x, s0.y * rs * w2.y, s0.z * rs * w2.z, s0.w * rs * w2.w);
            }
        }
        SEAM();

        if (IN_PH()) { PH_IDS;
            const float* W = args.in[I_WOUT] + (size_t)l * D * D;
            for (int u = bid; u < (TA / 128) * (D / 64); u += nb) {
                const int mt = u / (D / 64), m0 = mt * 128, n0 = (u % (D / 64)) * 64;
                ngemm_tile(smem, tid, MRG + (size_t)(m0 + (tid >> 2)) * D, D,
                    [&](int k, int n) { return W[(size_t)k * D + n0 + n]; },
                    [&](int m, int n, const float (&a)[4]) {
                        const int row = m0 + m; const float* g1 = modl + (size_t)mrow_of(row) * 6144 + 2 * D + n0 + n;
                        float4* xp = (float4*)(XS + (size_t)row * D + n0 + n); float4 x = *xp;
                        x.x += g1[0] * a[0]; x.y += g1[1] * a[1]; x.z += g1[2] * a[2]; x.w += g1[3] * a[3]; *xp = x; });
            }
        }
        SEAM();

        if (IN_PH()) { PH_IDS;
            const float* n2w = args.in[I_N2W] + l * D; const float* rw = args.in[I_RW] + (size_t)l * D * NE; const float* rb = args.in[I_RB] + l * NE;
            for (int row = gw; row < nrows_moe; row += nwaves) {
                const int mr = mrow_of(row);
                const float4* xr = (const float4*)(XS + (size_t)row * D);
                float4 v[4];
#pragma unroll
                for (int i = 0; i < 4; ++i) v[i] = xr[lane + i * 64];
                float ss = 0.f;
#pragma unroll
                for (int i = 0; i < 4; ++i) ss += v[i].x * v[i].x + v[i].y * v[i].y + v[i].z * v[i].z + v[i].w * v[i].w;
                ss = wave_sum(ss);
                const float rstd = rsqrtf(ss * (1.f / D) + EPS);
                const float4* sh = (const float4*)(modl + (size_t)mr * 6144 + 3 * D), *sc = (const float4*)(modl + (size_t)mr * 6144 + 4 * D);
                float4* hr = (float4*)(H + (size_t)row * D);
                float lg[32];
#pragma unroll
                for (int e = 0; e < 32; ++e) lg[e] = 0.f;
#pragma unroll
                for (int i = 0; i < 4; ++i) {
                    const float4 w4 = ((const float4*)n2w)[lane + i * 64], s4 = sh[lane + i * 64], c4 = sc[lane + i * 64];
                    float4 o;
                    o.x = v[i].x * rstd * w4.x * (1.f + c4.x) + s4.x; o.y = v[i].y * rstd * w4.y * (1.f + c4.y) + s4.y;
                    o.z = v[i].z * rstd * w4.z * (1.f + c4.z) + s4.z; o.w = v[i].w * rstd * w4.w * (1.f + c4.w) + s4.w;
                    hr[lane + i * 64] = o;
                    const float oo[4] = {o.x, o.y, o.z, o.w};
#pragma unroll
                    for (int j = 0; j < 4; ++j) {
                        const float4* rp = (const float4*)(rw + (size_t)((lane + i * 64) * 4 + j) * NE);
#pragma unroll
                        for (int e4 = 0; e4 < 8; ++e4) { const float4 r = rp[e4];
                            lg[4 * e4] += oo[j] * r.x; lg[4 * e4 + 1] += oo[j] * r.y; lg[4 * e4 + 2] += oo[j] * r.z; lg[4 * e4 + 3] += oo[j] * r.w; }
                    }
                }
#pragma unroll
                for (int e = 0; e < 32; ++e) lg[e] = wave_sum(lg[e]) + rb[e];
                float tv[4]; int ti[4];
#pragma unroll
                for (int k = 0; k < 4; ++k) {
                    float best = -INFINITY; int bi = 0;
#pragma unroll
                    for (int e = 0; e < 32; ++e) if (lg[e] > best) { best = lg[e]; bi = e; }
                    tv[k] = best; ti[k] = bi;
#pragma unroll
                    for (int e = 0; e < 32; ++e) if (e == bi) lg[e] = -INFINITY;
                }
                const float e1 = __expf(tv[1] - tv[0]), e2 = __expf(tv[2] - tv[0]), e3 = __expf(tv[3] - tv[0]);
                const float inv = 1.f / (1.f + e1 + e2 + e3);
                const float gk[4] = {inv, e1 * inv, e2 * inv, e3 * inv};
                if (lane < 4) {
                    float gsel = gk[0]; int esel = ti[0];
                    if (lane == 1) { gsel = gk[1]; esel = ti[1]; } if (lane == 2) { gsel = gk[2]; esel = ti[2]; } if (lane == 3) { gsel = gk[3]; esel = ti[3]; }
                    TOPI[row * 4 + lane] = esel; GATE[row * 4 + lane] = gsel;
                    const unsigned pos = atomicAdd(&counts[esel], 1u);
                    LIST[(size_t)esel * LISTCAP + pos] = row * 4 + lane;
                }
            }
        }
        SEAM();

        int* tstart = (int*)(smem + 9 * 1024);
        if (IN_PH()) { PH_IDS;
            __syncthreads();
            if (tid == 0) { int acc = 0; for (int e = 0; e < NE; ++e) { tstart[e] = acc; acc += ((int)counts[e] + 127) >> 7; } tstart[NE] = acc; }
            __syncthreads();
            const int ntm = tstart[NE];
            for (int u = bid; u < ntm * 32; u += nb) {
                const int mt = u >> 5, ntl = u & 31;
                int e = 0; while (e < NE - 1 && tstart[e + 1] <= mt) ++e;
                const int cnt = (int)counts[e], p0 = (mt - tstart[e]) * 128, j0 = ntl * 32;
                const int* lst = LIST + (size_t)e * LISTCAP;
                const float* W = args.in[I_WGU] + ((size_t)l * NE + e) * D * 2048; const float* bg = args.in[I_BGU] + ((size_t)l * NE + e) * 2048;
                const int pa = p0 + (tid >> 2);
                const float* arow = pa < cnt ? H + (size_t)(lst[pa] >> 2) * D : nullptr;
                float* actb = ACT + (size_t)mt * 128 * D;
                ngemm_tile(smem, tid, arow, D,
                    [&](int k, int n) { return W[(size_t)k * 2048 + ((n & 1) ? 1024 : 0) + j0 + (n >> 1)]; },
                    [&](int m, int n, const float (&a)[4]) {
                        if (p0 + m < cnt) {
#pragma unroll
                            for (int jj = 0; jj < 2; ++jj) { const int j = j0 + (n >> 1) + jj;
                                float gt = a[2 * jj] + bg[j], up = a[2 * jj + 1] + bg[1024 + j];
                                gt = fminf(gt, 7.f); up = fminf(fmaxf(up, -7.f), 7.f);
                                actb[(size_t)m * D + j] = (up + 1.f) * (gt * sigmoid_f(1.702f * gt)); } } });
            }
        }
        SEAM();

        if (IN_PH()) { PH_IDS;
            __syncthreads();
            if (tid == 0) { int acc = 0; for (int e = 0; e < NE; ++e) { tstart[e] = acc; acc += ((int)counts[e] + 127) >> 7; } tstart[NE] = acc; }
            __syncthreads();
            const int ntm = tstart[NE];
            for (int u = bid; u < ntm * 16; u += nb) {
                const int mt = u >> 4, n0 = (u & 15) * 64;
                int e = 0; while (e < NE - 1 && tstart[e + 1] <= mt) ++e;
                const int cnt = (int)counts[e], p0 = (mt - tstart[e]) * 128;
                const int* lst = LIST + (size_t)e * LISTCAP;
                const float* W = args.in[I_WDN] + ((size_t)l * NE + e) * D * D; const float* bd = args.in[I_BDN] + ((size_t)l * NE + e) * D;
                const int pa = p0 + (tid >> 2);
                const float* arow = pa < cnt ? ACT + ((size_t)mt * 128 + (tid >> 2)) * D : nullptr;
                ngemm_tile(smem, tid, arow, D,
                    [&](int k, int n) { return W[(size_t)k * D + n0 + n]; },
                    [&](int m, int n, const float (&a)[4]) {
                        if (p0 + m < cnt) { const int slot = lst[p0 + m];
                            *(float4*)(YB + (size_t)slot * D + n0 + n) = make_float4(a[0] + bd[n0 + n], a[1] + bd[n0 + n + 1], a[2] + bd[n0 + n + 2], a[3] + bd[n0 + n + 3]); } });
            }
        }
        SEAM();
    }

    if (IN_PH()) { PH_IDS;
        for (int row = gw; row < TL; row += nwaves) {
            const float* g2 = MOD + ((size_t)(DEPTH - 1) * 9 + mrow_of(row)) * 6144 + 5 * D;
            float gk[4];
#pragma unroll
            for (int k = 0; k < 4; ++k) gk[k] = GATE[row * 4 + k];
#pragma unroll
            for (int i = 0; i < 4; ++i) {
                float4 v = ((const float4*)(XS + (size_t)row * D))[lane + i * 64];
                float4 s = make_float4(0.f, 0.f, 0.f, 0.f);
#pragma unroll
                for (int k = 0; k < 4; ++k) { const float4 y = ((const float4*)(YB + ((size_t)row * 4 + k) * D))[lane + i * 64];
                    s.x += gk[k] * y.x; s.y += gk[k] * y.y; s.z += gk[k] * y.z; s.w += gk[k] * y.w; }
                const float4 gg = ((const float4*)g2)[lane + i * 64];
                v.x += gg.x * s.x; v.y += gg.y * s.y; v.z += gg.z * s.z; v.w += gg.w * s.w;
                ((float4*)(args.out + (size_t)row * D))[lane + i * 64] = v;
            }
        }
    }
}

extern "C" void kernel_launch(void* const* d_in, const int* in_sizes, int n_in, void* d_out, int out_size, void* d_ws, size_t ws_size, hipStream_t stream) {
    static int grid = 0;
    if (grid == 0) {
        if (n_in != 32 || out_size != TL * D || ws_size < WS_END) { fprintf(stderr, "kernel_launch: unexpected shapes (n_in %d out %d ws %zu need %zu)\n", n_in, out_size, ws_size, (size_t)WS_END); grid = -1; return; }
        int dev = 0, cus = 0, per_cu = 0;
        if (hipGetDevice(&dev) != hipSuccess || hipDeviceGetAttribute(&cus, hipDeviceAttributeMultiprocessorCount, dev) != hipSuccess) { grid = -1; return; }
        if (hipOccupancyMaxActiveBlocksPerMultiprocessor(&per_cu, (const void*)fwd, NT, 0) != hipSuccess || per_cu < 1) { fprintf(stderr, "kernel_launch: occupancy query says %d\n", per_cu); }
        (void)hipGetLastError();
        grid = cus;
    }
    if (grid < 0) return;
    hipMemsetAsync((char*)d_ws + WS_CTL, 0, CTL_BYTES, stream);
    Args a{};
    for (int i = 0; i < 32; ++i) a.in[i] = (const float*)d_in[i];
    a.out = (float*)d_out; a.ws = (unsigned char*)d_ws;
#if defined(MK_PER_PHASE)
    const int nph = 2 + DEPTH * 10;
    for (int p = 0; p < nph; ++p) { a.ph_lo = p; a.ph_hi = p + 1; hipLaunchKernelGGL(fwd, dim3(grid), dim3(NT), 0, stream, a); }
#else
    a.ph_lo = 0; a.ph_hi = 1 << 20;
    hipLaunchKernelGGL(fwd, dim3(grid), dim3(NT), 0, stream, a);
#endif
}
```

```cpp
#include <hip/hip_runtime.h>
#include <cstdio>
#include <cstdint>

constexpr int D = 1024, NBATCH = 8, SEQ = 2048, CTXL = 256, DEPTH = 4;
constexpr int TL = NBATCH * SEQ, TC = NBATCH * CTXL, TA = TL + TC;
constexpr int INW = 1280, NE = 32, TOPK = 4, NMOD = 6;
constexpr int NT = 512;
constexpr int MISC_OFF = 131072, LDS_BYTES = 131072 + 16384;
constexpr float EPS = 1e-6f;
constexpr int LISTCAP = TA * TOPK;
constexpr int ACT_ROWS = TA * TOPK + NE * 128;

constexpr size_t al256(size_t x) { return (x + 255) & ~(size_t)255; }
constexpr size_t WS_CTL = 0;
constexpr size_t CTL_BYTES = 65536;
constexpr size_t CW_BAR = 0;
constexpr size_t CW_CNT = 4096;
constexpr size_t WS_MOD = WS_CTL + CTL_BYTES;
constexpr size_t WS_ROPE = al256(WS_MOD + (size_t)DEPTH * 9 * 6144 * 4);
constexpr size_t WS_DISC = al256(WS_ROPE + (size_t)2 * 2048 * 64 * 4);
constexpr size_t WS_XS = al256(WS_DISC + (size_t)(4096 + 65536) * 4);
constexpr size_t WS_H = al256(WS_XS + (size_t)TA * D * 4);
constexpr size_t WS_PX = al256(WS_H + (size_t)TA * D * 4);
constexpr size_t WS_QN = al256(WS_PX + (size_t)TA * INW * 4);
constexpr size_t WS_KN = al256(WS_QN + (size_t)TA * 512 * 4);
constexpr size_t WS_ATT = al256(WS_KN + (size_t)TA * 128 * 4);
constexpr size_t WS_DLT = al256(WS_ATT + (size_t)TA * 512 * 4);
constexpr size_t WS_G = al256(WS_DLT + (size_t)TA * 256 * 4);
constexpr size_t WS_SO = al256(WS_G + (size_t)TA * 256 * 4);
constexpr size_t WS_MRG = al256(WS_SO + (size_t)TA * 256 * 4);
constexpr size_t WS_ST = al256(WS_MRG + (size_t)TA * D * 4);
constexpr size_t WS_TOPI = al256(WS_ST + (size_t)2 * TA * 16 * 64 * 8);
constexpr size_t WS_GATE = al256(WS_TOPI + (size_t)TA * 4 * 4);
constexpr size_t WS_LIST = al256(WS_GATE + (size_t)TA * 4 * 4);
constexpr size_t WS_ACT = al256(WS_LIST + (size_t)NE * LISTCAP * 4);
constexpr size_t WS_YB = al256(WS_ACT + (size_t)ACT_ROWS * D * 4);
constexpr size_t WS_YB_END = al256(WS_YB + (size_t)TA * TOPK * D * 4);
constexpr int ACT_ROWS2 = TA * TOPK + NE * 256;
constexpr size_t WS_WGUT = WS_YB_END;
constexpr size_t WS_WDNT = al256(WS_WGUT + (size_t)DEPTH * NE * 2048 * D * 2);
constexpr size_t WS_H2B = al256(WS_WDNT + (size_t)DEPTH * NE * D * D * 2);
constexpr size_t WS_ACTB = al256(WS_H2B + (size_t)TA * D * 2);
constexpr size_t WS_YBB = al256(WS_ACTB + (size_t)ACT_ROWS2 * D * 2);
constexpr size_t WS_END = al256(WS_YBB + (size_t)TA * TOPK * D * 2);

#define XB_TMO      128
#define XB_XCNT(j)  (256  + 64 * (j))
#define XB_XSUB(j)  (1280 + 64 * (j))
#define XB_XGEN(j)  (2304 + 64 * (j))
#define XB_TOP      3328
#define XB_TOPGEN   3392
#define XCD_BAR_WORDS 3456
#define XB_SPIN_CAP (1u << 25)
#define LAS __attribute__((address_space(3)))

__device__ __forceinline__ unsigned xb_ld(unsigned* p)              { return __hip_atomic_load(p, __ATOMIC_RELAXED, __HIP_MEMORY_SCOPE_AGENT); }
__device__ __forceinline__ unsigned xb_add(unsigned* p, unsigned v) { return __hip_atomic_fetch_add(p, v, __ATOMIC_RELAXED, __HIP_MEMORY_SCOPE_AGENT); }
__device__ __forceinline__ unsigned xb_xcc_id() { return (unsigned)__builtin_amdgcn_s_getreg((3 << 11) | 20) & 0xFu; }
#define XB_SPIN(cond, bar) do { unsigned _sp = 0; while (cond) { __builtin_amdgcn_s_sleep(1); \
    if ((++_sp & 255u) == 0u) { if (xb_ld(&(bar)[XB_TMO])) break; if (_sp > XB_SPIN_CAP) { atomicAdd(&(bar)[XB_TMO], 1u); break; } } } } while (0)

struct XcdBarrier { unsigned* bar; unsigned x; volatile LAS unsigned* st; };

__device__ __forceinline__ XcdBarrier xcd_barrier_post(unsigned* bar, volatile LAS unsigned* st) {
    XcdBarrier b; b.bar = bar; b.x = xb_xcc_id(); b.st = st;
    if (threadIdx.x == 0) (void)xb_add(&bar[XB_XCNT(b.x)], 1u);
    return b;
}
__device__ __forceinline__ void xcd_barrier_complete(unsigned* bar, unsigned x, unsigned& nloc, unsigned& nx) {
    const unsigned G = gridDim.x * gridDim.y * gridDim.z;
    unsigned sum, cnt, mine, sp = 0u;
    for (;;) {
        sum = 0u; cnt = 0u; mine = 0u;
#pragma unroll
        for (unsigned j = 0; j < 16; ++j) { const unsigned c = xb_ld(&bar[XB_XCNT(j)]); sum += c; cnt += (c > 0u) ? 1u : 0u; mine = (j == x) ? c : mine; }
        if (sum == G) break;
        __builtin_amdgcn_s_sleep(1);
        if ((++sp & 255u) == 0u) { if (xb_ld(&bar[XB_TMO])) break; if (sp > XB_SPIN_CAP) { atomicAdd(&bar[XB_TMO], 1u); break; } }
    }
    nloc = mine > 0u ? mine : 1u; nx = cnt > 0u ? cnt : 1u;
}
__device__ __noinline__ void xcd_barrier_impl(unsigned* const bar_, const unsigned bx_, volatile LAS unsigned* const st_) {
    XcdBarrier b; b.bar = bar_; b.x = bx_; b.st = st_;
    asm volatile("s_waitcnt vmcnt(0)" ::: "memory");
    __syncthreads();
    if (threadIdx.x == 0) {
        unsigned* bar = b.bar;
        __builtin_amdgcn_s_waitcnt(0);
        unsigned nloc = b.st[0], nx = b.st[1];
        if (nloc == 0u) { xcd_barrier_complete(bar, b.x, nloc, nx); b.st[0] = nloc; b.st[1] = nx; }
        const unsigned old = xb_add(&bar[XB_XSUB(b.x)], 1u);
        const unsigned gen = old / nloc;
        if (old + 1u == (gen + 1u) * nloc) {
            __builtin_amdgcn_fence(__ATOMIC_RELEASE, "agent");
            asm volatile("s_waitcnt vmcnt(0)" ::: "memory");
            const unsigned og = xb_add(&bar[XB_TOP], 1u);
            const unsigned tg = og / nx;
            if (og + 1u == (tg + 1u) * nx) xb_add(&bar[XB_TOPGEN], 1u);
            else XB_SPIN(xb_ld(&bar[XB_TOPGEN]) == tg, bar);
            __builtin_amdgcn_fence(__ATOMIC_ACQUIRE, "agent");
            xb_add(&bar[XB_XGEN(b.x)], 1u);
            asm volatile("s_waitcnt vmcnt(0)" ::: "memory");
        } else {
            XB_SPIN(xb_ld(&bar[XB_XGEN(b.x)]) == gen, bar);
            __builtin_amdgcn_fence(__ATOMIC_ACQUIRE, "agent");
            asm volatile("s_waitcnt vmcnt(0)" ::: "memory");
        }
    }
    __syncthreads();
}
__device__ __forceinline__ void xcd_barrier(const XcdBarrier& b) { xcd_barrier_impl(b.bar, b.x, b.st); }

struct Args { const float* in[32]; float* out; unsigned char* ws; int ph_lo, ph_hi; };

enum { I_X = 0, I_C, I_CTX, I_CCTX, I_WMOD, I_BMOD, I_N1W, I_N2W, I_WIN, I_QNW, I_KNW, I_SINK, I_ARE, I_AIM, I_LOGDT, I_BRE, I_BIM,
       I_CRE, I_CIM, I_SSMD, I_GLUW, I_GLUB, I_POOLW, I_POOLS, I_ONW, I_WOUT, I_RW, I_RB, I_WGU, I_BGU, I_WDN, I_BDN };

__device__ __forceinline__ float wave_sum(float v) {
#pragma unroll
    for (int o = 32; o > 0; o >>= 1) v += __shfl_xor(v, o);
    return v;
}
__device__ __forceinline__ float silu_f(float x) { return x / (1.f + __expf(-x)); }
__device__ __forceinline__ float sigmoid_f(float x) { return 1.f / (1.f + __expf(-x)); }
__device__ __forceinline__ float gelu_tanh_f(float x) { const float u = 0.7978845608028654f * (x + 0.044715f * x * x * x); return 0.5f * x * (1.f + tanhf(u)); }
__device__ __forceinline__ int mrow_of(int row) { return row < TL ? (row >> 11) : 8; }

template <class BF, class EF>
__device__ __forceinline__ void ngemm_tile(float* sm, const int tid, const float* arow, int K, BF bf, EF ef) {
    float (*As)[132] = (float (*)[132])sm;
    float (*Bs)[68] = (float (*)[68])(sm + 16 * 132);
    const int am = tid >> 2, ak = (tid & 3) * 4, bk = tid >> 5, bn = (tid & 31) * 2, ty = tid >> 4, tx = tid & 15;
    float acc[4][4];
#pragma unroll
    for (int i = 0; i < 4; ++i)
#pragma unroll
        for (int j = 0; j < 4; ++j) acc[i][j] = 0.f;
    for (int k0 = 0; k0 < K; k0 += 16) {
        float4 av = make_float4(0.f, 0.f, 0.f, 0.f);
        if (arow) av = *(const float4*)(arow + k0 + ak);
        const float b0 = bf(k0 + bk, bn), b1 = bf(k0 + bk, bn + 1);
        __syncthreads();
        As[ak + 0][am] = av.x; As[ak + 1][am] = av.y; As[ak + 2][am] = av.z; As[ak + 3][am] = av.w;
        Bs[bk][bn] = b0; Bs[bk][bn + 1] = b1;
        __syncthreads();
#pragma unroll
        for (int kk = 0; kk < 16; ++kk) {
            const float4 a4 = *(const float4*)&As[kk][ty * 4];
            const float4 b4 = *(const float4*)&Bs[kk][tx * 4];
            const float aa[4] = {a4.x, a4.y, a4.z, a4.w}, bb[4] = {b4.x, b4.y, b4.z, b4.w};
#pragma unroll
            for (int i = 0; i < 4; ++i)
#pragma unroll
                for (int j = 0; j < 4; ++j) acc[i][j] += aa[i] * bb[j];
        }
    }
#pragma unroll
    for (int i = 0; i < 4; ++i) ef(ty * 4 + i, tx * 4, acc[i]);
}


namespace mg {
typedef unsigned short bf16_t;
typedef short bf16x8 __attribute__((ext_vector_type(8)));
typedef float f32x4 __attribute__((ext_vector_type(4)));
typedef unsigned u32x4 __attribute__((ext_vector_type(4)));
constexpr int BM = 256, BK = 64, HALF = 128, HTB = HALF * BK * 2, STAGE_BYTES = 8 * HTB;
__host__ __device__ __forceinline__ int lds_byte(int r, int c) { const int st = (r >> 4) * 2 + (c >> 5), rr = r & 15, cc = c & 31, ob = rr * 64 + cc * 2; return st * 1024 + (ob ^ (((ob >> 9) & 1) << 5)); }
__host__ __device__ __forceinline__ void stage_rc(int b, int& R, int& C) { const int st = b / 1024, sb = b % 1024, swz = sb ^ (((sb >> 9) & 1) << 5); R = (st >> 1) * 16 + swz / 64; C = (st & 1) * 32 + (swz % 64) / 2; }
__host__ __device__ __forceinline__ int perm32(int rho) { const int n = rho >> 4, i = rho & 15; return 8 * (i >> 2) + 4 * n + (i & 3); }
__device__ __forceinline__ unsigned cvt_pk_bf16(float lo, float hi) { unsigned r; asm volatile("v_cvt_pk_bf16_f32 %0, %1, %2" : "=v"(r) : "v"(lo), "v"(hi)); return r; }

struct Unit { const char* a; const char* b; int pm, pn, e, p0, cnt; };

template <class Epi, class Sched>
__device__ __forceinline__ void gemm_phase(LAS unsigned char* lds, const int K, const Sched& S, const Epi& E) {
    int tid = threadIdx.x; asm volatile("" : "+v"(tid));
    const int wid = __builtin_amdgcn_readfirstlane(tid >> 6), lane = tid & 63, wr = wid >> 2, wc = wid & 3, fr = lane & 15, fq = lane >> 4;
    const int nt = K / BK;
    unsigned voffB[2];
#pragma unroll
    for (int i = 0; i < 2; ++i) { int R, C; stage_rc(tid * 16 + i * 8192, R, C); const int Rb = Epi::PERM ? ((R & ~31) + perm32(R & 31)) : R; voffB[i] = (unsigned)(Rb * K + C) * 2u; }
    const size_t kstep = (size_t)(BK * 2);
    const size_t hstep = (size_t)HALF * K * 2;
    const unsigned ldsw = (unsigned)wid * 1024u;
    const int aoff = lds_byte(wr * 64 + fr, fq * 8), boff = lds_byte(wc * 32 + fr, fq * 8);
#define MG_SA(b, h) (((b) * 2 + (h)) * HTB)
#define MG_SB(b, h) ((4 + (b) * 2 + (h)) * HTB)
#define MG_STAGE(bufoff, gbase, voff) do { _Pragma("unroll") for (int _i = 0; _i < 2; ++_i) \
        __builtin_amdgcn_global_load_lds((const unsigned*)((const char*)(gbase) + (voff)[_i]), (LAS unsigned*)(lds + (bufoff) + ldsw + _i * 8192), 16, 0, 0); } while (0)
#define MG_LDA(dst, b, h) do { _Pragma("unroll") for (int m = 0; m < 4; ++m) _Pragma("unroll") for (int k = 0; k < 2; ++k) dst[m][k] = *(const LAS bf16x8*)(lds + MG_SA(b, h) + aoff + m * 2048 + k * 1024); } while (0)
#define MG_LDB(dst, b, h) do { _Pragma("unroll") for (int n = 0; n < 2; ++n) _Pragma("unroll") for (int k = 0; k < 2; ++k) dst[n][k] = *(const LAS bf16x8*)(lds + MG_SB(b, h) + boff + n * 2048 + k * 1024); } while (0)
#define MG_MMA(ai, bj, At, Bt) do { __builtin_amdgcn_s_setprio(1); _Pragma("unroll") for (int m = 0; m < 4; ++m) _Pragma("unroll") for (int n = 0; n < 2; ++n) _Pragma("unroll") for (int k = 0; k < 2; ++k) \
        acc[ai][bj][m][n] = __builtin_amdgcn_mfma_f32_16x16x32_bf16(Bt[n][k], At[m][k], acc[ai][bj][m][n], 0, 0, 0); __builtin_amdgcn_s_setprio(0); } while (0)
#define MG_WAIT_V(n) asm volatile("s_waitcnt vmcnt(" #n ")" ::: "memory")
#define MG_WAIT_L(n) asm volatile("s_waitcnt lgkmcnt(" #n ")" ::: "memory")
#define MG_BAR __builtin_amdgcn_s_barrier()
#define MG_SCHED __builtin_amdgcn_sched_barrier(0)
    Unit cur, nxt; int ui = 0;
    if (!S.next(0, cur)) return;
    f32x4 acc[2][2][4][2];
#pragma unroll
    for (int a = 0; a < 2; ++a)
#pragma unroll
        for (int b = 0; b < 2; ++b)
#pragma unroll
            for (int m = 0; m < 4; ++m)
#pragma unroll
                for (int n = 0; n < 2; ++n) acc[a][b][m][n] = (f32x4){0.f, 0.f, 0.f, 0.f};
    bf16x8 At[4][2], B0[2][2], B1[2][2];
    unsigned cvo0[2], cvo1[2], nvo0[2], nvo1[2];
    S.a_voff(cur, cvo0, cvo1);
    const char* cA = cur.a; const char* cB = cur.b;
    MG_STAGE(MG_SB(0, 0), cB, voffB); MG_STAGE(MG_SA(0, 0), cA, cvo0); MG_STAGE(MG_SB(0, 1), cB + hstep, voffB); MG_STAGE(MG_SA(0, 1), cA, cvo1);
    if (wr == 1) MG_BAR;
    MG_WAIT_V(4); MG_BAR;
    MG_STAGE(MG_SB(1, 0), cB + kstep, voffB); MG_STAGE(MG_SA(1, 0), cA + kstep, cvo0); MG_STAGE(MG_SB(1, 1), cB + hstep + kstep, voffB);
    MG_WAIT_V(6); MG_BAR;
    for (;;) {
        const bool has_next = S.next(ui + 1, nxt);
        const char* nA = has_next ? nxt.a : cA; const char* nB = has_next ? nxt.b : cB;
        if (has_next) S.a_voff(nxt, nvo0, nvo1); else { nvo0[0] = cvo0[0]; nvo0[1] = cvo0[1]; nvo1[0] = cvo1[0]; nvo1[1] = cvo1[1]; }
        for (int t = 0; t < nt; t += 2) {
            const bool last = (t == nt - 2);
            const char* a1 = cA + (size_t)(t + 1) * kstep;
            const char* a2 = last ? nA : cA + (size_t)(t + 2) * kstep; const char* b2 = last ? nB : cB + (size_t)(t + 2) * kstep;
            const char* a3 = a2 + kstep; const char* b3 = b2 + kstep;
            MG_LDB(B0, 0, 0); MG_SCHED; MG_LDA(At, 0, 0); MG_STAGE(MG_SA(1, 1), a1, cvo1);
            if (last) { cvo0[0] = nvo0[0]; cvo0[1] = nvo0[1]; cvo1[0] = nvo1[0]; cvo1[1] = nvo1[1]; }
            MG_WAIT_L(8); MG_BAR; MG_WAIT_L(0); MG_MMA(0, 0, At, B0); MG_BAR; MG_SCHED;
            MG_LDB(B1, 0, 1); MG_STAGE(MG_SB(0, 0), b2, voffB);
            MG_BAR; MG_WAIT_L(0); MG_MMA(0, 1, At, B1); MG_BAR;
            MG_LDA(At, 0, 1); MG_STAGE(MG_SA(0, 0), a2, cvo0);
            MG_BAR; MG_WAIT_L(0); MG_MMA(1, 0, At, B0); MG_BAR; MG_SCHED;
            MG_STAGE(MG_SB(0, 1), b2 + hstep, voffB);
            MG_WAIT_V(6); MG_BAR; MG_MMA(1, 1, At, B1); MG_BAR;
            MG_LDB(B0, 1, 0); MG_SCHED; MG_LDA(At, 1, 0); MG_STAGE(MG_SA(0, 1), a2, cvo1);
            MG_WAIT_L(8); MG_BAR; MG_WAIT_L(0); MG_MMA(0, 0, At, B0); MG_BAR; MG_SCHED;
            MG_LDB(B1, 1, 1); MG_STAGE(MG_SB(1, 0), b3, voffB);
            MG_BAR; MG_WAIT_L(0); MG_MMA(0, 1, At, B1); MG_BAR;
            MG_LDA(At, 1, 1); MG_STAGE(MG_SA(1, 0), a3, cvo0);
            MG_BAR; MG_WAIT_L(0); MG_MMA(1, 0, At, B0); MG_BAR; MG_SCHED;
            MG_STAGE(MG_SB(1, 1), b3 + hstep, voffB);
            MG_WAIT_V(6); MG_BAR; MG_MMA(1, 1, At, B1); MG_BAR;
        }
        {
            int tz = threadIdx.x; asm volatile("" : "+v"(tz));
            const int wz = __builtin_amdgcn_readfirstlane(tz >> 6), lz = tz & 63;
            E(acc, cur, wz >> 2, wz & 3, lz & 15, lz >> 4); }
        if (!has_next) break;
#pragma unroll
        for (int a = 0; a < 2; ++a)
#pragma unroll
            for (int b = 0; b < 2; ++b)
#pragma unroll
                for (int m = 0; m < 4; ++m)
#pragma unroll
                    for (int n = 0; n < 2; ++n) acc[a][b][m][n] = (f32x4){0.f, 0.f, 0.f, 0.f};
        cur = nxt; cA = nA; cB = nB; ++ui;
    }
    MG_WAIT_V(0);
    if (wr == 0) MG_BAR;
    MG_BAR;
#undef MG_SA
#undef MG_SB
#undef MG_STAGE
#undef MG_LDA
#undef MG_LDB
#undef MG_MMA
#undef MG_WAIT_V
#undef MG_WAIT_L
#undef MG_BAR
#undef MG_SCHED
}

struct MoeSched {
    int tsv, cntv;
    const int* list;
    const char* A;
    const char* Bt;
    int ntn, G, c, K;
    __device__ __forceinline__ bool next(int i, Unit& u) const {
        const int L = i * G + c, ntm = __builtin_amdgcn_readlane(tsv, NE);
        if (L >= ntm * ntn) return false;
        const int tnext = __shfl_down(tsv, 1);
        int tz = threadIdx.x; asm volatile("" : "+v"(tz)); const int lane = tz & 63;
        const int e = __builtin_popcountll(__ballot(lane < NE && tnext * ntn <= L));
        const int ts = __builtin_amdgcn_readlane(tsv, e), te = __builtin_amdgcn_readlane(tsv, e + 1);
        const int mte = te - ts, r = L - ts * ntn, pn = r / mte, mtl = r - pn * mte;
        u.pm = ts + mtl; u.pn = pn; u.e = e; u.p0 = mtl * 256; u.cnt = __builtin_amdgcn_readlane(cntv, e);
        u.a = list ? A : A + (size_t)u.pm * 256 * K * 2;
        u.b = Bt + ((size_t)(e * ntn + pn) * 256) * K * 2;
        return true;
    }
    __device__ __forceinline__ void a_voff(const Unit& u, unsigned (&v0)[2], unsigned (&v1)[2]) const {
        int tz = threadIdx.x; asm volatile("" : "+v"(tz));
#pragma unroll
        for (int i = 0; i < 2; ++i) {
            int R, C; stage_rc(tz * 16 + i * 8192, R, C);
            if (list) {
                const int* lst = list + (size_t)u.e * LISTCAP;
                const int q0 = min(u.p0 + R, u.cnt - 1), q1 = min(u.p0 + 128 + R, u.cnt - 1);
                v0[i] = (unsigned)((lst[q0] >> 2) * K + C) * 2u; v1[i] = (unsigned)((lst[q1] >> 2) * K + C) * 2u;
            } else { v0[i] = (unsigned)(R * K + C) * 2u; v1[i] = (unsigned)((128 + R) * K + C) * 2u; }
        }
    }
};
struct EpiSwiglu {
    static constexpr bool PERM = true;
    bf16_t* act; const float* bgu;
    __device__ __forceinline__ void operator()(const f32x4 (&acc)[2][2][4][2], const Unit& u, int wr, int wc, int fr, int fq) const {
        const int j = u.pn * 128 + wc * 32 + 8 * fq;
        const float* bg = bgu + (size_t)u.e * 2048 + j;
        const f32x4 g0 = *(const f32x4*)(bg), g1 = *(const f32x4*)(bg + 4), u0 = *(const f32x4*)(bg + 1024), u1 = *(const f32x4*)(bg + 1028);
#pragma unroll
        for (int ai = 0; ai < 2; ++ai)
#pragma unroll
            for (int m = 0; m < 4; ++m) {
                const int rl = ai * 128 + wr * 64 + m * 16 + fr;
                float o[8];
#pragma unroll
                for (int n = 0; n < 2; ++n)
#pragma unroll
                    for (int i = 0; i < 4; ++i) {
                        float gt = acc[ai][0][m][n][i] + (n ? g1[i] : g0[i]), up = acc[ai][1][m][n][i] + (n ? u1[i] : u0[i]);
                        gt = fminf(gt, 7.f); up = fminf(fmaxf(up, -7.f), 7.f);
                        o[n * 4 + i] = (up + 1.f) * (gt / (1.f + __expf(-1.702f * gt)));
                    }
                u32x4 w; w.x = cvt_pk_bf16(o[0], o[1]); w.y = cvt_pk_bf16(o[2], o[3]); w.z = cvt_pk_bf16(o[4], o[5]); w.w = cvt_pk_bf16(o[6], o[7]);
                *(u32x4*)(act + ((size_t)u.pm * 256 + rl) * D + j) = w;
            }
    }
};
struct EpiDown {
    static constexpr bool PERM = true;
    bf16_t* yb; const float* bdn; const int* list;
    __device__ __forceinline__ void operator()(const f32x4 (&acc)[2][2][4][2], const Unit& u, int wr, int wc, int fr, int fq) const {
        const int c0 = u.pn * 256 + wc * 32 + 8 * fq;
        const float* bd = bdn + (size_t)u.e * D + c0;
        f32x4 bv[2][2];
#pragma unroll
        for (int bj = 0; bj < 2; ++bj)
#pragma unroll
            for (int n = 0; n < 2; ++n) bv[bj][n] = *(const f32x4*)(bd + bj * 128 + 4 * n);
        const int* lst = list + (size_t)u.e * LISTCAP;
#pragma unroll
        for (int ai = 0; ai < 2; ++ai)
#pragma unroll
            for (int m = 0; m < 4; ++m) {
                const int pos = u.p0 + ai * 128 + wr * 64 + m * 16 + fr;
                if (pos < u.cnt) {
                    bf16_t* rowp = yb + (size_t)lst[pos] * D + c0;
#pragma unroll
                    for (int bj = 0; bj < 2; ++bj) {
                        const f32x4 v0 = acc[ai][bj][m][0] + bv[bj][0], v1 = acc[ai][bj][m][1] + bv[bj][1];
                        u32x4 w; w.x = cvt_pk_bf16(v0[0], v0[1]); w.y = cvt_pk_bf16(v0[2], v0[3]); w.z = cvt_pk_bf16(v1[0], v1[1]); w.w = cvt_pk_bf16(v1[2], v1[3]);
                        *(u32x4*)(rowp + bj * 128) = w;
                    }
                }
            }
    }
};
}

template <class RF>
__device__ __forceinline__ void transpose_cvt_tile(float* sm, const int tid, const float* src, int ldn, int k0, int n0, unsigned short* dst, int ldk, RF dst_row) {
    float (*T)[129] = (float (*)[129])sm;
    __syncthreads();
#pragma unroll
    for (int i = 0; i < 4; ++i) {
        const int kk = (tid >> 4) + 32 * i, cc = (tid & 15) * 4;
        const float4 v = *(const float4*)(src + (size_t)(k0 + kk) * ldn + n0 + cc);
        T[cc][kk] = v.x; T[cc + 1][kk] = v.y; T[cc + 2][kk] = v.z; T[cc + 3][kk] = v.w;
    }
    __syncthreads();
#pragma unroll
    for (int i = 0; i < 2; ++i) {
        const int n = (tid >> 4) + 32 * i, kk = (tid & 15) * 8;
        mg::u32x4 w;
        w.x = mg::cvt_pk_bf16(T[n][kk], T[n][kk + 1]); w.y = mg::cvt_pk_bf16(T[n][kk + 2], T[n][kk + 3]);
        w.z = mg::cvt_pk_bf16(T[n][kk + 4], T[n][kk + 5]); w.w = mg::cvt_pk_bf16(T[n][kk + 6], T[n][kk + 7]);
        *(mg::u32x4*)(dst + (size_t)dst_row(n0 + n) * ldk + k0 + kk) = w;
    }
}
__device__ __forceinline__ float bf2f(unsigned short b) { return __uint_as_float(((unsigned)b) << 16); }

__global__ void __launch_bounds__(NT, 2) fwd(Args args) {
    extern __shared__ __attribute__((aligned(16))) unsigned char lds[];
    float* smem = (float*)lds;
    LAS unsigned char* ldsl = (LAS unsigned char*)lds;
    LAS unsigned* misc = (LAS unsigned*)(ldsl + MISC_OFF);
    const int bid = blockIdx.x, nb = gridDim.x;
    const int nwaves = nb * (NT / 64), gthreads = nb * NT;
#define PH_IDS int tid = threadIdx.x; asm volatile("" : "+v"(tid)); const int lane = tid & 63, wave = tid >> 6, gw = wave * nb + bid, gtid = bid * NT + tid; (void)lane; (void)wave; (void)gw; (void)gtid; \
    kaptr_t ka = (kaptr_t)__builtin_amdgcn_kernarg_segment_ptr(); asm volatile("" : "+s"(ka)); unsigned char* const ws = KA_LOAD(unsigned char*, 264); (void)ws
    unsigned* ctl = (unsigned*)(args.ws + WS_CTL);
    typedef const unsigned char __attribute__((address_space(4)))* kaptr_t;
#define KA_LOAD(T, off) (*(T const __attribute__((address_space(4)))*)(ka + (off)))
#define INP(i) KA_LOAD(const float*, 8 * (i))
#define OUTP KA_LOAD(float*, 256)
#define MOD ((float*)(ws + WS_MOD))
#define ROPEC ((float*)(ws + WS_ROPE))
#define ROPES (ROPEC + 2048 * 64)
#define DISC ((float*)(ws + WS_DISC))
#define XS ((float*)(ws + WS_XS))
#define H ((float*)(ws + WS_H))
#define PX ((float*)(ws + WS_PX))
#define QN ((float*)(ws + WS_QN))
#define KN ((float*)(ws + WS_KN))
#define ATT ((float*)(ws + WS_ATT))
#define DLT ((float*)(ws + WS_DLT))
#define G ((float*)(ws + WS_G))
#define SO ((float*)(ws + WS_SO))
#define MRG ((float*)(ws + WS_MRG))
#define ST ((float2*)(ws + WS_ST))
#define TOPI ((int*)(ws + WS_TOPI))
#define GATE ((float*)(ws + WS_GATE))
#define LIST ((int*)(ws + WS_LIST))
#define WGUT ((unsigned short*)(ws + WS_WGUT))
#define WDNT ((unsigned short*)(ws + WS_WDNT))
#define H2B ((unsigned short*)(ws + WS_H2B))
#define ACTB ((unsigned short*)(ws + WS_ACTB))
#define YBB ((unsigned short*)(ws + WS_YBB))
#define modl (MOD + (size_t)l * 9 * 6144)
#define counts (((unsigned*)(ws + WS_CTL)) + CW_CNT + l * NE)
    if (threadIdx.x < 4) misc[threadIdx.x] = 0u;
    __syncthreads();
    XcdBarrier bar = xcd_barrier_post(ctl + CW_BAR, (volatile LAS unsigned*)misc);
    const int lo = args.ph_lo, hi = args.ph_hi;
    int ph = 0;
#define IN_PH() (lo <= ph && ph < hi)
#define SEAM() do { if (lo <= ph && ph + 1 < hi) xcd_barrier(bar); ++ph; } while (0)

    if (IN_PH()) { PH_IDS;
        {   const float4* x4 = (const float4*)INP(I_X); const float4* c4 = (const float4*)INP(I_CTX); float4* xs4 = (float4*)XS;
            for (size_t i = gtid; i < (size_t)TA * 256; i += gthreads) xs4[i] = i < (size_t)TL * 256 ? x4[i] : c4[i - (size_t)TL * 256]; }
        for (int i = gtid; i < 2048 * 64; i += gthreads) {
            const int t = i >> 6, d = i & 63, f = d & 15, axis = d >> 5;
            const float pos = axis == 0 ? (float)(t >> 6) : (float)(t & 63);
            const float inv = powf(10000.f, -(float)(2 * f) / 32.f);
            const float ang = pos * inv;
            ROPEC[i] = cosf(ang); ROPES[i] = sinf(ang);
        }
        for (int it = bid; it < DEPTH * NE * (256 + 128); it += nb) {
            const int le = it / 384, r = it % 384;
            if (r < 256) { const int kt = r >> 5, ntl = r & 31;
                transpose_cvt_tile(smem, tid, INP(I_WGU) + (size_t)le * D * 2048, 2048, kt * 128, ntl * 64, WGUT + (size_t)le * 2048 * D, D,
                    [](int n) { const int half = n >> 10, rem = n & 1023; return (rem >> 7) * 256 + half * 128 + (rem & 127); });
            } else { const int r2 = r - 256, kt = r2 >> 4, ntl = r2 & 15;
                transpose_cvt_tile(smem, tid, INP(I_WDN) + (size_t)le * D * D, D, kt * 128, ntl * 64, WDNT + (size_t)le * D * D, D, [](int n) { return n; }); }
        }
        __syncthreads();
        for (int i = tid; i < 9 * 1024; i += NT) { const float v = i < 8192 ? INP(I_C)[i] : INP(I_CCTX)[i - 8192]; smem[i] = silu_f(v); }
        __syncthreads();
        for (int it = bid; it < DEPTH * 96; it += nb) {
            const int l = it / 96, j = (it % 96) * 64 + lane;
            const float* w = INP(I_WMOD) + (size_t)l * D * 6144 + j;
            float acc[9];
#pragma unroll
            for (int m = 0; m < 9; ++m) acc[m] = 0.f;
            for (int k = wave * 128; k < wave * 128 + 128; ++k) {
                const float wv = w[(size_t)k * 6144];
#pragma unroll
                for (int m = 0; m < 9; ++m) acc[m] += smem[m * 1024 + k] * wv;
            }
            float* pb = smem + 9 * 1024;
#pragma unroll
            for (int m = 0; m < 9; ++m) pb[(wave * 9 + m) * 64 + lane] = acc[m];
            __syncthreads();
            if (wave == 0) {
                const float bias = INP(I_BMOD)[(size_t)l * 6144 + j];
#pragma unroll
                for (int m = 0; m < 9; ++m) { float s = 0.f;
#pragma unroll
                    for (int w8 = 0; w8 < 8; ++w8) s += pb[(w8 * 9 + m) * 64 + lane];
                    MOD[((size_t)l * 9 + m) * 6144 + j] = s + bias; }
            }
            __syncthreads();
        }
    }
    SEAM();

    for (int l = 0; l < DEPTH; ++l) {
        const int nrows_moe = (l == DEPTH - 1) ? TL : TA;

        if (IN_PH()) { PH_IDS;
            const float* n1w = INP(I_N1W) + l * D;
            for (int row = gw; row < TA; row += nwaves) {
                const int mr = mrow_of(row);
                float4* xr = (float4*)(XS + (size_t)row * D);
                float4 v[4];
#pragma unroll
                for (int i = 0; i < 4; ++i) v[i] = xr[lane + i * 64];
                if (l > 0) {
                    const float* g2 = MOD + ((size_t)(l - 1) * 9 + mr) * 6144 + 5 * D;
                    float gk[4];
#pragma unroll
                    for (int k = 0; k < 4; ++k) gk[k] = GATE[row * 4 + k];
#pragma unroll
                    for (int i = 0; i < 4; ++i) {
                        float4 s = make_float4(0.f, 0.f, 0.f, 0.f);
#pragma unroll
                        for (int k = 0; k < 4; ++k) { const uint2 y = ((const uint2*)(YBB + ((size_t)row * 4 + k) * D))[lane + i * 64];
                            s.x += gk[k] * __uint_as_float(y.x << 16); s.y += gk[k] * __uint_as_float(y.x & 0xffff0000u); s.z += gk[k] * __uint_as_float(y.y << 16); s.w += gk[k] * __uint_as_float(y.y & 0xffff0000u); }
                        const float4 gg = ((const float4*)g2)[lane + i * 64];
                        v[i].x += gg.x * s.x; v[i].y += gg.y * s.y; v[i].z += gg.z * s.z; v[i].w += gg.w * s.w;
                        xr[lane + i * 64] = v[i];
                    }
                }
                float ss = 0.f;
#pragma unroll
                for (int i = 0; i < 4; ++i) ss += v[i].x * v[i].x + v[i].y * v[i].y + v[i].z * v[i].z + v[i].w * v[i].w;
                ss = wave_sum(ss);
                const float rstd = rsqrtf(ss * (1.f / D) + EPS);
                const float4* sh = (const float4*)(modl + (size_t)mr * 6144), *sc = (const float4*)(modl + (size_t)mr * 6144 + D);
                float4* hr = (float4*)(H + (size_t)row * D);
#pragma unroll
                for (int i = 0; i < 4; ++i) {
                    const float4 w4 = ((const float4*)n1w)[lane + i * 64], s4 = sh[lane + i * 64], c4 = sc[lane + i * 64];
                    float4 o;
                    o.x = v[i].x * rstd * w4.x * (1.f + c4.x) + s4.x; o.y = v[i].y * rstd * w4.y * (1.f + c4.y) + s4.y;
                    o.z = v[i].z * rstd * w4.z * (1.f + c4.z) + s4.z; o.w = v[i].w * rstd * w4.w * (1.f + c4.w) + s4.w;
                    hr[lane + i * 64] = o;
                }
            }
            for (int i = gtid; i < 2048; i += gthreads) {
                const int dg = i >> 6;
                const size_t pbase = (size_t)l * 2048 + i;
                const float are = INP(I_ARE)[pbase], aim = INP(I_AIM)[pbase];
                const float dt = expf(INP(I_LOGDT)[l * 32 + dg]);
                const float mag = expf(are * dt), ar = mag * cosf(aim * dt), ai = mag * sinf(aim * dt);
                const float den = are * are + aim * aim;
                const float qr = ((ar - 1.0f) * are + ai * aim) / den, qi = (ai * are - (ar - 1.0f) * aim) / den;
                DISC[i] = ar; DISC[2048 + i] = ai;
                const float* br = INP(I_BRE) + pbase * 16; const float* bi = INP(I_BIM) + pbase * 16;
                for (int p = 0; p < 16; ++p) {
                    DISC[4096 + i * 16 + p] = qr * br[p] - qi * bi[p];
                    DISC[4096 + 32768 + i * 16 + p] = qr * bi[p] + qi * br[p];
                }
            }
        }
        SEAM();

        if (IN_PH()) { PH_IDS;
            const float* W = INP(I_WIN) + (size_t)l * D * INW;
            for (int u = bid; u < (TA / 128) * (INW / 64); u += nb) {
                const int mt = u / (INW / 64), ntl = u % (INW / 64), m0 = mt * 128, n0 = ntl * 64;
                ngemm_tile(smem, tid, H + (size_t)(m0 + (tid >> 2)) * D, D,
                    [&](int k, int n) { return W[(size_t)k * INW + n0 + n]; },
                    [&](int m, int n, const float (&a)[4]) { *(float4*)(PX + (size_t)(m0 + m) * INW + n0 + n) = make_float4(a[0], a[1], a[2], a[3]); });
            }
        }
        SEAM();

        if (IN_PH()) { PH_IDS;
            const int n_scan = 256, n_qk = TA * 10, n_dl = TA * 4;
            for (int it = gw; it < n_scan + n_qk + n_dl; it += nwaves) {
                if (it < n_scan) {
                    const int b = it >> 5, dir = (it >> 4) & 1, g = it & 15, n = lane;
                    const int di = (dir * 16 + g) * 64 + n;
                    const float ar = DISC[di], ai = DISC[2048 + di];
                    float bbr[16], bbi[16];
#pragma unroll
                    for (int p = 0; p < 16; ++p) { bbr[p] = DISC[4096 + di * 16 + p]; bbi[p] = DISC[4096 + 32768 + di * 16 + p]; }
                    float sr = 0.f, si = 0.f;
                    for (int step = 0; step < CTXL + SEQ; ++step) {
                        int row;
                        if (step < CTXL) row = TL + b * CTXL + (dir == 0 ? step : CTXL - 1 - step);
                        else { const int t = step - CTXL; row = b * SEQ + (dir == 0 ? t : SEQ - 1 - t); }
                        const float4* up = (const float4*)(PX + (size_t)row * INW + 768 + g * 16);
                        const float4 u0 = up[0], u1 = up[1], u2 = up[2], u3 = up[3];
                        const float uu[16] = {u0.x, u0.y, u0.z, u0.w, u1.x, u1.y, u1.z, u1.w, u2.x, u2.y, u2.z, u2.w, u3.x, u3.y, u3.z, u3.w};
                        float xr = 0.f, xi = 0.f;
#pragma unroll
                        for (int p = 0; p < 16; ++p) { xr += bbr[p] * uu[p]; xi += bbi[p] * uu[p]; }
                        const float nsr = ar * sr - ai * si + xr, nsi = ar * si + ai * sr + xi;
                        sr = nsr; si = nsi;
                        ST[(((size_t)dir * TA + row) * 16 + g) * 64 + n] = make_float2(sr, si);
                    }
                } else if (it < n_scan + n_qk) {
                    const int j = it - n_scan, row = j / 10, hh = j % 10, d = lane;
                    const float v = PX[(size_t)row * INW + hh * 64 + d];
                    const float ss = wave_sum(v * v);
                    const float w = hh < 8 ? INP(I_QNW)[l * 64 + d] : INP(I_KNW)[l * 64 + d];
                    float y = v * rsqrtf(ss * (1.f / 64.f) + EPS) * w;
                    const float yp = __shfl_xor(y, 16);
                    if (row < TL) {
                        const int t = row & (SEQ - 1);
                        const float c = ROPEC[t * 64 + d], s = ROPES[t * 64 + d];
                        y = y * c + (((d >> 4) & 1) ? yp : -yp) * s;
                    }
                    if (hh < 8) QN[(size_t)row * 512 + hh * 64 + d] = y; else KN[(size_t)row * 128 + (hh - 8) * 64 + d] = y;
                } else {
                    const int j = it - n_scan - n_qk, row = j >> 2, g4 = j & 3, ch = g4 * 64 + lane, hw = 1 << g4;
                    int base, t, L;
                    if (row < TL) { base = row & ~(SEQ - 1); t = row & (SEQ - 1); L = SEQ; } else { const int r2 = row - TL; base = TL + (r2 & ~(CTXL - 1)); t = r2 & (CTXL - 1); L = CTXL; }
                    const int tlo = max(t - hw, 0), thi = min(t + hw, L);
                    float s = 0.f;
                    for (int tt = tlo; tt < thi; ++tt) s += PX[(size_t)(base + tt) * INW + 1024 + ch];
                    DLT[(size_t)row * 256 + ch] = s / (float)(thi - tlo) - PX[(size_t)row * INW + 1024 + ch];
                }
            }
        }
        SEAM();

        if (IN_PH()) { PH_IDS;
            for (int it = gw; it < (TA / 32) * 8; it += nwaves) {
                const int rb = it >> 3, h = it & 7, kvh = h >> 2;
                const int qi = lane >> 1, half = lane & 1;
                const int row = rb * 32 + qi;
                const bool lat = rb < TL / 32;
                const int b = lat ? (rb >> 6) : ((rb - TL / 32) >> 3);
                const int t0 = lat ? ((rb & 63) * 32) : 0, t = t0 + qi;
                float q[32], o[32];
                {   const float4* qp = (const float4*)(QN + (size_t)row * 512 + h * 64 + half * 32);
#pragma unroll
                    for (int i = 0; i < 8; ++i) { const float4 x = qp[i]; q[4 * i] = x.x * 0.125f; q[4 * i + 1] = x.y * 0.125f; q[4 * i + 2] = x.z * 0.125f; q[4 * i + 3] = x.w * 0.125f; } }
#pragma unroll
                for (int i = 0; i < 32; ++i) o[i] = 0.f;
                float m = INP(I_SINK)[l * 8 + h], lsum = 1.f;
                const int klo = max(t0 - 128, 0), khi = min(t0 + 31 + 128, SEQ - 1);
                for (int pass = lat ? 0 : 1; pass < 2; ++pass) {
                    const int k_begin = pass == 0 ? klo : 0, k_end = pass == 0 ? khi + 1 : CTXL, krow0 = pass == 0 ? b * SEQ : TL + b * CTXL;
                    for (int kt = k_begin; kt < k_end; ++kt) {
                        const int kr = krow0 + kt;
                        const float4* kp = (const float4*)(KN + (size_t)kr * 128 + kvh * 64 + half * 32);
                        float s = 0.f;
#pragma unroll
                        for (int i = 0; i < 8; ++i) { const float4 x = kp[i]; s += q[4 * i] * x.x + q[4 * i + 1] * x.y + q[4 * i + 2] * x.z + q[4 * i + 3] * x.w; }
                        s += __shfl_xor(s, 1);
                        const bool valid = (pass == 1) || (abs(t - kt) <= 128);
                        if (valid) {
                            const float mn = fmaxf(m, s), sc = __expf(m - mn), p = __expf(s - mn);
                            lsum = lsum * sc + p; m = mn;
                            const float4* vp = (const float4*)(PX + (size_t)kr * INW + 640 + kvh * 64 + half * 32);
#pragma unroll
                            for (int i = 0; i < 8; ++i) { const float4 x = vp[i];
                                o[4 * i] = o[4 * i] * sc + p * x.x; o[4 * i + 1] = o[4 * i + 1] * sc + p * x.y; o[4 * i + 2] = o[4 * i + 2] * sc + p * x.z; o[4 * i + 3] = o[4 * i + 3] * sc + p * x.w; }
                        }
                    }
                }
                const float inv = 1.f / lsum;
                float4* op = (float4*)(ATT + (size_t)row * 512 + h * 64 + half * 32);
#pragma unroll
                for (int i = 0; i < 8; ++i) op[i] = make_float4(o[4 * i] * inv, o[4 * i + 1] * inv, o[4 * i + 2] * inv, o[4 * i + 3] * inv);
            }
            const float* cre = INP(I_CRE) + (size_t)l * 2 * 16 * 16 * 64; const float* cim = INP(I_CIM) + (size_t)l * 2 * 16 * 16 * 64;
            for (size_t i = gtid; i < (size_t)TA * 256; i += gthreads) {
                const int row = (int)(i >> 8), c = (int)(i & 255), g = c >> 4, p = c & 15;
                float y = 0.f;
                for (int dir = 0; dir < 2; ++dir) {
                    const float2* st = ST + (((size_t)dir * TA + row) * 16 + g) * 64;
                    const float* cr = cre + ((size_t)(dir * 16 + g) * 16 + p) * 64; const float* ci = cim + ((size_t)(dir * 16 + g) * 16 + p) * 64;
                    for (int n = 0; n < 64; ++n) { const float2 s = st[n]; y += s.x * cr[n] - s.y * ci[n]; }
                }
                y += INP(I_SSMD)[l * 256 + c] * PX[(size_t)row * INW + 768 + c];
                G[i] = gelu_tanh_f(y);
                const int g4 = c >> 6, dd = c & 63;
                const float* pw = INP(I_POOLW) + ((size_t)l * 4 + g4) * 64 * 64 + dd;
                const float* dl = DLT + (size_t)row * 256 + g4 * 64;
                float z = 0.f;
                for (int cc = 0; cc < 64; ++cc) z += dl[cc] * pw[cc * 64];
                MRG[(size_t)row * D + 768 + c] = z * INP(I_POOLS)[l * 256 + c];
            }
        }
        SEAM();

        if (IN_PH()) { PH_IDS;
            const float* W = INP(I_GLUW) + (size_t)l * 256 * 256; const float* gb = INP(I_GLUB) + l * 256;
            for (int u = bid; u < (TA / 128) * 4; u += nb) {
                const int mt = u >> 2, m0 = mt * 128, n0 = (u & 3) * 64;
                ngemm_tile(smem, tid, G + (size_t)(m0 + (tid >> 2)) * 256, 256,
                    [&](int k, int n) { return W[(size_t)k * 256 + n0 + n]; },
                    [&](int m, int n, const float (&a)[4]) {
#pragma unroll
                        for (int j = 0; j < 4; ++j) { const size_t idx = (size_t)(m0 + m) * 256 + n0 + n + j; SO[idx] = G[idx] * sigmoid_f(a[j] + gb[n0 + n + j]); } });
            }
        }
        SEAM();

        if (IN_PH()) { PH_IDS;
            const float* onw = INP(I_ONW) + l * 768;
            for (int row = gw; row < TA; row += nwaves) {
                const float4* ap = (const float4*)(ATT + (size_t)row * 512);
                const float4 a0 = ap[lane], a1 = ap[lane + 64];
                float ss = a0.x * a0.x + a0.y * a0.y + a0.z * a0.z + a0.w * a0.w + a1.x * a1.x + a1.y * a1.y + a1.z * a1.z + a1.w * a1.w;
                ss = wave_sum(ss);
                const float ra = rsqrtf(ss * (1.f / 512.f) + EPS);
                const float4 s0 = ((const float4*)(SO + (size_t)row * 256))[lane];
                float s2 = wave_sum(s0.x * s0.x + s0.y * s0.y + s0.z * s0.z + s0.w * s0.w);
                const float rs = rsqrtf(s2 * (1.f / 256.f) + EPS);
                float4* mp = (float4*)(MRG + (size_t)row * D);
                const float4 w0 = ((const float4*)onw)[lane], w1 = ((const float4*)onw)[lane + 64], w2 = ((const float4*)onw)[lane + 128];
                mp[lane] = make_float4(a0.x * ra * w0.x, a0.y * ra * w0.y, a0.z * ra * w0.z, a0.w * ra * w0.w);
                mp[lane + 64] = make_float4(a1.x * ra * w1.x, a1.y * ra * w1.y, a1.z * ra * w1.z, a1.w * ra * w1.w);
                mp[lane + 128] = make_float4(s0.x * rs * w2.x, s0.y * rs * w2.y, s0.z * rs * w2.z, s0.w * rs * w2.w);
            }
        }
        SEAM();

        if (IN_PH()) { PH_IDS;
            const float* W = INP(I_WOUT) + (size_t)l * D * D;
            for (int u = bid; u < (TA / 128) * (D / 64); u += nb) {
                const int mt = u / (D / 64), m0 = mt * 128, n0 = (u % (D / 64)) * 64;
                ngemm_tile(smem, tid, MRG + (size_t)(m0 + (tid >> 2)) * D, D,
                    [&](int k, int n) { return W[(size_t)k * D + n0 + n]; },
                    [&](int m, int n, const float (&a)[4]) {
                        const int row = m0 + m; const float* g1 = modl + (size_t)mrow_of(row) * 6144 + 2 * D + n0 + n;
                        float4* xp = (float4*)(XS + (size_t)row * D + n0 + n); float4 x = *xp;
                        x.x += g1[0] * a[0]; x.y += g1[1] * a[1]; x.z += g1[2] * a[2]; x.w += g1[3] * a[3]; *xp = x; });
            }
        }
        SEAM();

        if (IN_PH()) { PH_IDS;
            const float* n2w = INP(I_N2W) + l * D; const float* rw = INP(I_RW) + (size_t)l * D * NE; const float* rb = INP(I_RB) + l * NE;
            for (int row = gw; row < nrows_moe; row += nwaves) {
                const int mr = mrow_of(row);
                const float4* xr = (const float4*)(XS + (size_t)row * D);
                float4 v[4];
#pragma unroll
                for (int i = 0; i < 4; ++i) v[i] = xr[lane + i * 64];
                float ss = 0.f;
#pragma unroll
                for (int i = 0; i < 4; ++i) ss += v[i].x * v[i].x + v[i].y * v[i].y + v[i].z * v[i].z + v[i].w * v[i].w;
                ss = wave_sum(ss);
                const float rstd = rsqrtf(ss * (1.f / D) + EPS);
                const float4* sh = (const float4*)(modl + (size_t)mr * 6144 + 3 * D), *sc = (const float4*)(modl + (size_t)mr * 6144 + 4 * D);
                uint2* hr = (uint2*)(H2B + (size_t)row * D);
                float lg[32];
#pragma unroll
                for (int e = 0; e < 32; ++e) lg[e] = 0.f;
#pragma unroll
                for (int i = 0; i < 4; ++i) {
                    const float4 w4 = ((const float4*)n2w)[lane + i * 64], s4 = sh[lane + i * 64], c4 = sc[lane + i * 64];
                    float4 o;
                    o.x = v[i].x * rstd * w4.x * (1.f + c4.x) + s4.x; o.y = v[i].y * rstd * w4.y * (1.f + c4.y) + s4.y;
                    o.z = v[i].z * rstd * w4.z * (1.f + c4.z) + s4.z; o.w = v[i].w * rstd * w4.w * (1.f + c4.w) + s4.w;
                    hr[lane + i * 64] = make_uint2(mg::cvt_pk_bf16(o.x, o.y), mg::cvt_pk_bf16(o.z, o.w));
                    const float oo[4] = {o.x, o.y, o.z, o.w};
#pragma unroll
                    for (int j = 0; j < 4; ++j) {
                        const float4* rp = (const float4*)(rw + (size_t)((lane + i * 64) * 4 + j) * NE);
#pragma unroll
                        for (int e4 = 0; e4 < 8; ++e4) { const float4 r = rp[e4];
                            lg[4 * e4] += oo[j] * r.x; lg[4 * e4 + 1] += oo[j] * r.y; lg[4 * e4 + 2] += oo[j] * r.z; lg[4 * e4 + 3] += oo[j] * r.w; }
                    }
                }
#pragma unroll
                for (int e = 0; e < 32; ++e) lg[e] = wave_sum(lg[e]) + rb[e];
                float tv[4]; int ti[4];
#pragma unroll
                for (int k = 0; k < 4; ++k) {
                    float best = -INFINITY; int bi = 0;
#pragma unroll
                    for (int e = 0; e < 32; ++e) if (lg[e] > best) { best = lg[e]; bi = e; }
                    tv[k] = best; ti[k] = bi;
#pragma unroll
                    for (int e = 0; e < 32; ++e) if (e == bi) lg[e] = -INFINITY;
                }
                const float e1 = __expf(tv[1] - tv[0]), e2 = __expf(tv[2] - tv[0]), e3 = __expf(tv[3] - tv[0]);
                const float inv = 1.f / (1.f + e1 + e2 + e3);
                const float gk[4] = {inv, e1 * inv, e2 * inv, e3 * inv};
#pragma unroll
                for (int k = 0; k < 4; ++k) {
                    if (lane == k) {
                        TOPI[row * 4 + k] = ti[k]; GATE[row * 4 + k] = gk[k];
                        const unsigned pos = atomicAdd(&counts[ti[k]], 1u);
                        LIST[(size_t)ti[k] * LISTCAP + pos] = row * 4 + k;
                    }
                }
            }
        }
        SEAM();

        if (IN_PH()) { PH_IDS;
            LAS int* tstart = (LAS int*)(misc + 16);
            __syncthreads();
            if (tid == 0) { int acc = 0; for (int e = 0; e < NE; ++e) { const int cn = (int)counts[e]; tstart[e] = acc; tstart[40 + e] = cn; acc += (cn + 255) >> 8; } tstart[NE] = acc; tstart[40 + NE] = 0; }
            __syncthreads();
            const int tsv = tstart[min(lane, NE)], cntv = tstart[40 + min(lane, NE)];
            mg::MoeSched S{tsv, cntv, LIST, (const char*)H2B, (const char*)(WGUT + (size_t)l * NE * 2048 * D), 8, nb, bid, D};
            mg::EpiSwiglu E{ACTB, INP(I_BGU) + (size_t)l * NE * 2048};
            mg::gemm_phase(ldsl, D, S, E);
        }
        SEAM();

        if (IN_PH()) { PH_IDS;
            LAS int* tstart = (LAS int*)(misc + 16);
            __syncthreads();
            if (tid == 0) { int acc = 0; for (int e = 0; e < NE; ++e) { const int cn = (int)counts[e]; tstart[e] = acc; tstart[40 + e] = cn; acc += (cn + 255) >> 8; } tstart[NE] = acc; tstart[40 + NE] = 0; }
            __syncthreads();
            const int tsv = tstart[min(lane, NE)], cntv = tstart[40 + min(lane, NE)];
            mg::MoeSched S{tsv, cntv, nullptr, (const char*)ACTB, (const char*)(WDNT + (size_t)l * NE * D * D), 4, nb, bid, D};
            mg::EpiDown E{YBB, INP(I_BDN) + (size_t)l * NE * D, LIST};
            mg::gemm_phase(ldsl, D, S, E);
        }
        SEAM();
    }

    if (IN_PH()) { PH_IDS;
        for (int row = gw; row < TL; row += nwaves) {
            const float* g2 = MOD + ((size_t)(DEPTH - 1) * 9 + mrow_of(row)) * 6144 + 5 * D;
            float gk[4];
#pragma unroll
            for (int k = 0; k < 4; ++k) gk[k] = GATE[row * 4 + k];
#pragma unroll
            for (int i = 0; i < 4; ++i) {
                float4 v = ((const float4*)(XS + (size_t)row * D))[lane + i * 64];
                float4 s = make_float4(0.f, 0.f, 0.f, 0.f);
#pragma unroll
                for (int k = 0; k < 4; ++k) { const uint2 y = ((const uint2*)(YBB + ((size_t)row * 4 + k) * D))[lane + i * 64];
                    s.x += gk[k] * __uint_as_float(y.x << 16); s.y += gk[k] * __uint_as_float(y.x & 0xffff0000u); s.z += gk[k] * __uint_as_float(y.y << 16); s.w += gk[k] * __uint_as_float(y.y & 0xffff0000u); }
                const float4 gg = ((const float4*)g2)[lane + i * 64];
                v.x += gg.x * s.x; v.y += gg.y * s.y; v.z += gg.z * s.z; v.w += gg.w * s.w;
                ((float4*)(OUTP + (size_t)row * D))[lane + i * 64] = v;
            }
        }
    }
}

extern "C" void kernel_launch(void* const* d_in, const int* in_sizes, int n_in, void* d_out, int out_size, void* d_ws, size_t ws_size, hipStream_t stream) {
    static int grid = 0;
    if (grid == 0) {
        if (n_in != 32 || out_size != TL * D || ws_size < WS_END) { fprintf(stderr, "kernel_launch: unexpected shapes (n_in %d out %d ws %zu need %zu)\n", n_in, out_size, ws_size, (size_t)WS_END); grid = -1; return; }
        int dev = 0, cus = 0, per_cu = 0;
        if (hipGetDevice(&dev) != hipSuccess || hipDeviceGetAttribute(&cus, hipDeviceAttributeMultiprocessorCount, dev) != hipSuccess) { grid = -1; return; }
        if (hipFuncSetAttribute((const void*)fwd, hipFuncAttributeMaxDynamicSharedMemorySize, LDS_BYTES) != hipSuccess) { fprintf(stderr, "kernel_launch: hipFuncSetAttribute failed\n"); grid = -1; return; }
        if (hipOccupancyMaxActiveBlocksPerMultiprocessor(&per_cu, (const void*)fwd, NT, LDS_BYTES) != hipSuccess || per_cu < 1) { fprintf(stderr, "kernel_launch: occupancy query says %d\n", per_cu); }
        (void)hipGetLastError();
        grid = cus;
    }
    if (grid < 0) return;
    (void)hipMemsetAsync((char*)d_ws + WS_CTL, 0, CTL_BYTES, stream);
    Args a{};
    for (int i = 0; i < 32; ++i) a.in[i] = (const float*)d_in[i];
    a.out = (float*)d_out; a.ws = (unsigned char*)d_ws;
#if defined(MK_PER_PHASE)
    const int nph = 2 + DEPTH * 10;
    for (int p = 0; p < nph; ++p) { a.ph_lo = p; a.ph_hi = p + 1; hipLaunchKernelGGL(fwd, dim3(grid), dim3(NT), LDS_BYTES, stream, a); }
#else
    a.ph_lo = 0; a.ph_hi = 1 << 20;
    hipLaunchKernelGGL(fwd, dim3(grid), dim3(NT), LDS_BYTES, stream, a);
#endif
}
```

```cpp
#include <hip/hip_runtime.h>
#include <cstdio>
#include <cstdint>

constexpr int D = 1024, NBATCH = 8, SEQ = 2048, CTXL = 256, DEPTH = 4;
constexpr int TL = NBATCH * SEQ, TC = NBATCH * CTXL, TA = TL + TC;
constexpr int INW = 1280, NE = 32, TOPK = 4, NMOD = 6;
constexpr int NT = 512;
constexpr int MISC_OFF = 131072, LDS_BYTES = 131072 + 16384;
constexpr float EPS = 1e-6f;
constexpr int LISTCAP = TA * TOPK;
constexpr int ACT_ROWS = TA * TOPK + NE * 128;

constexpr size_t al256(size_t x) { return (x + 255) & ~(size_t)255; }
constexpr size_t WS_CTL = 0;
constexpr size_t CTL_BYTES = 65536;
constexpr size_t CW_BAR = 0;
constexpr size_t CW_CNT = 4096;
constexpr size_t WS_MOD = WS_CTL + CTL_BYTES;
constexpr size_t WS_ROPE = al256(WS_MOD + (size_t)DEPTH * 9 * 6144 * 4);
constexpr size_t WS_DISC = al256(WS_ROPE + (size_t)2 * 2048 * 64 * 4);
constexpr size_t WS_XS = al256(WS_DISC + (size_t)(4096 + 65536) * 4);
constexpr size_t WS_H = al256(WS_XS + (size_t)TA * D * 4);
constexpr size_t WS_PX = al256(WS_H + (size_t)TA * D * 4);
constexpr size_t WS_QN = al256(WS_PX + (size_t)TA * INW * 4);
constexpr size_t WS_KN = al256(WS_QN + (size_t)TA * 512 * 4);
constexpr size_t WS_ATT = al256(WS_KN + (size_t)TA * 128 * 4);
constexpr size_t WS_DLT = al256(WS_ATT + (size_t)TA * 512 * 4);
constexpr size_t WS_G = al256(WS_DLT + (size_t)TA * 256 * 4);
constexpr size_t WS_SO = al256(WS_G + (size_t)TA * 256 * 4);
constexpr size_t WS_MRG = al256(WS_SO + (size_t)TA * 256 * 4);
constexpr size_t WS_ST = al256(WS_MRG + (size_t)TA * D * 4);
constexpr size_t WS_EB = WS_ST;
constexpr size_t WS_QNB = al256(WS_EB + (size_t)NBATCH * 2 * 16 * 36 * 64 * 8);
constexpr size_t WS_KNB = al256(WS_QNB + (size_t)TA * 512 * 2);
constexpr size_t WS_VTB = al256(WS_KNB + (size_t)TA * 128 * 2);
constexpr size_t WS_VTCB = al256(WS_VTB + (size_t)NBATCH * 2 * 64 * SEQ * 2);
static_assert(WS_VTCB + (size_t)NBATCH * 2 * 64 * CTXL * 2 <= WS_ST + (size_t)2 * TA * 16 * 64 * 8, "carve-up overflows the old state buffer");
constexpr size_t WS_TOPI = al256(WS_ST + (size_t)2 * TA * 16 * 64 * 8);
constexpr size_t WS_GATE = al256(WS_TOPI + (size_t)TA * 4 * 4);
constexpr size_t WS_LIST = al256(WS_GATE + (size_t)TA * 4 * 4);
constexpr size_t WS_ACT = al256(WS_LIST + (size_t)NE * LISTCAP * 4);
constexpr size_t WS_YB = al256(WS_ACT + (size_t)ACT_ROWS * D * 4);
constexpr size_t WS_YB_END = al256(WS_YB + (size_t)TA * TOPK * D * 4);
constexpr int ACT_ROWS2 = TA * TOPK + NE * 256;
constexpr size_t WS_WGUT = WS_YB_END;
constexpr size_t WS_WDNT = al256(WS_WGUT + (size_t)DEPTH * NE * 2048 * D * 2);
constexpr size_t WS_H2B = al256(WS_WDNT + (size_t)DEPTH * NE * D * D * 2);
constexpr size_t WS_ACTB = al256(WS_H2B + (size_t)TA * D * 2);
constexpr size_t WS_YBB = al256(WS_ACTB + (size_t)ACT_ROWS2 * D * 2);
constexpr size_t WS_WINT = al256(WS_YBB + (size_t)TA * TOPK * D * 2);
constexpr size_t WS_WOUTT = al256(WS_WINT + (size_t)DEPTH * INW * D * 2);
constexpr size_t WS_GLUT = al256(WS_WOUTT + (size_t)DEPTH * D * D * 2);
constexpr size_t WS_HB = al256(WS_GLUT + (size_t)DEPTH * 256 * 256 * 2);
constexpr size_t WS_MRGB = al256(WS_HB + (size_t)TA * D * 2);
constexpr size_t WS_GB = al256(WS_MRGB + (size_t)TA * D * 2);
constexpr size_t WS_END = al256(WS_GB + (size_t)TA * 256 * 2);

#define XB_TMO      128
#define XB_XCNT(j)  (256  + 64 * (j))
#define XB_XSUB(j)  (1280 + 64 * (j))
#define XB_XGEN(j)  (2304 + 64 * (j))
#define XB_TOP      3328
#define XB_TOPGEN   3392
#define XCD_BAR_WORDS 3456
#define XB_SPIN_CAP (1u << 25)
#define LAS __attribute__((address_space(3)))

__device__ __forceinline__ unsigned xb_ld(unsigned* p)              { return __hip_atomic_load(p, __ATOMIC_RELAXED, __HIP_MEMORY_SCOPE_AGENT); }
__device__ __forceinline__ unsigned xb_add(unsigned* p, unsigned v) { return __hip_atomic_fetch_add(p, v, __ATOMIC_RELAXED, __HIP_MEMORY_SCOPE_AGENT); }
__device__ __forceinline__ unsigned xb_xcc_id() { return (unsigned)__builtin_amdgcn_s_getreg((3 << 11) | 20) & 0xFu; }
#define XB_SPIN(cond, bar) do { unsigned _sp = 0; while (cond) { __builtin_amdgcn_s_sleep(1); \
    if ((++_sp & 255u) == 0u) { if (xb_ld(&(bar)[XB_TMO])) break; if (_sp > XB_SPIN_CAP) { atomicAdd(&(bar)[XB_TMO], 1u); break; } } } } while (0)

struct XcdBarrier { unsigned* bar; unsigned x; volatile LAS unsigned* st; };

__device__ __forceinline__ XcdBarrier xcd_barrier_post(unsigned* bar, volatile LAS unsigned* st) {
    XcdBarrier b; b.bar = bar; b.x = xb_xcc_id(); b.st = st;
    if (threadIdx.x == 0) (void)xb_add(&bar[XB_XCNT(b.x)], 1u);
    return b;
}
__device__ __forceinline__ void xcd_barrier_complete(unsigned* bar, unsigned x, unsigned& nloc, unsigned& nx) {
    const unsigned G = gridDim.x * gridDim.y * gridDim.z;
    unsigned sum, cnt, mine, sp = 0u;
    for (;;) {
        sum = 0u; cnt = 0u; mine = 0u;
#pragma unroll
        for (unsigned j = 0; j < 16; ++j) { const unsigned c = xb_ld(&bar[XB_XCNT(j)]); sum += c; cnt += (c > 0u) ? 1u : 0u; mine = (j == x) ? c : mine; }
        if (sum == G) break;
        __builtin_amdgcn_s_sleep(1);
        if ((++sp & 255u) == 0u) { if (xb_ld(&bar[XB_TMO])) break; if (sp > XB_SPIN_CAP) { atomicAdd(&bar[XB_TMO], 1u); break; } }
    }
    nloc = mine > 0u ? mine : 1u; nx = cnt > 0u ? cnt : 1u;
}
__device__ __noinline__ void xcd_barrier_impl(unsigned* const bar_, const unsigned bx_, volatile LAS unsigned* const st_) {
    XcdBarrier b; b.bar = bar_; b.x = bx_; b.st = st_;
    asm volatile("s_waitcnt vmcnt(0)" ::: "memory");
    __syncthreads();
    if (threadIdx.x == 0) {
        unsigned* bar = b.bar;
        __builtin_amdgcn_s_waitcnt(0);
        unsigned nloc = b.st[0], nx = b.st[1];
        if (nloc == 0u) { xcd_barrier_complete(bar, b.x, nloc, nx); b.st[0] = nloc; b.st[1] = nx; }
        const unsigned old = xb_add(&bar[XB_XSUB(b.x)], 1u);
        const unsigned gen = old / nloc;
        if (old + 1u == (gen + 1u) * nloc) {
            __builtin_amdgcn_fence(__ATOMIC_RELEASE, "agent");
            asm volatile("s_waitcnt vmcnt(0)" ::: "memory");
            const unsigned og = xb_add(&bar[XB_TOP], 1u);
            const unsigned tg = og / nx;
            if (og + 1u == (tg + 1u) * nx) xb_add(&bar[XB_TOPGEN], 1u);
            else XB_SPIN(xb_ld(&bar[XB_TOPGEN]) == tg, bar);
            __builtin_amdgcn_fence(__ATOMIC_ACQUIRE, "agent");
            xb_add(&bar[XB_XGEN(b.x)], 1u);
            asm volatile("s_waitcnt vmcnt(0)" ::: "memory");
        } else {
            XB_SPIN(xb_ld(&bar[XB_XGEN(b.x)]) == gen, bar);
            __builtin_amdgcn_fence(__ATOMIC_ACQUIRE, "agent");
            asm volatile("s_waitcnt vmcnt(0)" ::: "memory");
        }
    }
    __syncthreads();
}
__device__ __forceinline__ void xcd_barrier(const XcdBarrier& b) { xcd_barrier_impl(b.bar, b.x, b.st); }

struct Args { const float* in[32]; float* out; unsigned char* ws; int ph_lo, ph_hi; };

enum { I_X = 0, I_C, I_CTX, I_CCTX, I_WMOD, I_BMOD, I_N1W, I_N2W, I_WIN, I_QNW, I_KNW, I_SINK, I_ARE, I_AIM, I_LOGDT, I_BRE, I_BIM,
       I_CRE, I_CIM, I_SSMD, I_GLUW, I_GLUB, I_POOLW, I_POOLS, I_ONW, I_WOUT, I_RW, I_RB, I_WGU, I_BGU, I_WDN, I_BDN };

__device__ __forceinline__ float wave_sum(float v) {
#pragma unroll
    for (int o = 32; o > 0; o >>= 1) v += __shfl_xor(v, o);
    return v;
}
__device__ __forceinline__ float silu_f(float x) { return x / (1.f + __expf(-x)); }
__device__ __forceinline__ float sigmoid_f(float x) { return 1.f / (1.f + __expf(-x)); }
__device__ __forceinline__ float gelu_tanh_f(float x) { const float u = 0.7978845608028654f * (x + 0.044715f * x * x * x); return 0.5f * x * (1.f + tanhf(u)); }
__device__ __forceinline__ int mrow_of(int row) { return row < TL ? (row >> 11) : 8; }

template <class BF, class EF>
__device__ __forceinline__ void ngemm_tile(float* sm, const int tid, const float* arow, int K, BF bf, EF ef) {
    float (*As)[132] = (float (*)[132])sm;
    float (*Bs)[68] = (float (*)[68])(sm + 16 * 132);
    const int am = tid >> 2, ak = (tid & 3) * 4, bk = tid >> 5, bn = (tid & 31) * 2, ty = tid >> 4, tx = tid & 15;
    float acc[4][4];
#pragma unroll
    for (int i = 0; i < 4; ++i)
#pragma unroll
        for (int j = 0; j < 4; ++j) acc[i][j] = 0.f;
    for (int k0 = 0; k0 < K; k0 += 16) {
        float4 av = make_float4(0.f, 0.f, 0.f, 0.f);
        if (arow) av = *(const float4*)(arow + k0 + ak);
        const float b0 = bf(k0 + bk, bn), b1 = bf(k0 + bk, bn + 1);
        __syncthreads();
        As[ak + 0][am] = av.x; As[ak + 1][am] = av.y; As[ak + 2][am] = av.z; As[ak + 3][am] = av.w;
        Bs[bk][bn] = b0; Bs[bk][bn + 1] = b1;
        __syncthreads();
#pragma unroll
        for (int kk = 0; kk < 16; ++kk) {
            const float4 a4 = *(const float4*)&As[kk][ty * 4];
            const float4 b4 = *(const float4*)&Bs[kk][tx * 4];
            const float aa[4] = {a4.x, a4.y, a4.z, a4.w}, bb[4] = {b4.x, b4.y, b4.z, b4.w};
#pragma unroll
            for (int i = 0; i < 4; ++i)
#pragma unroll
                for (int j = 0; j < 4; ++j) acc[i][j] += aa[i] * bb[j];
        }
    }
#pragma unroll
    for (int i = 0; i < 4; ++i) ef(ty * 4 + i, tx * 4, acc[i]);
}


namespace mg {
typedef unsigned short bf16_t;
typedef short bf16x8 __attribute__((ext_vector_type(8)));
typedef float f32x4 __attribute__((ext_vector_type(4)));
typedef unsigned u32x4 __attribute__((ext_vector_type(4)));
constexpr int BM = 256, BK = 64, HALF = 128, HTB = HALF * BK * 2, STAGE_BYTES = 8 * HTB;
__host__ __device__ __forceinline__ int lds_byte(int r, int c) { const int st = (r >> 4) * 2 + (c >> 5), rr = r & 15, cc = c & 31, ob = rr * 64 + cc * 2; return st * 1024 + (ob ^ (((ob >> 9) & 1) << 5)); }
__host__ __device__ __forceinline__ void stage_rc(int b, int& R, int& C) { const int st = b / 1024, sb = b % 1024, swz = sb ^ (((sb >> 9) & 1) << 5); R = (st >> 1) * 16 + swz / 64; C = (st & 1) * 32 + (swz % 64) / 2; }
__host__ __device__ __forceinline__ int perm32(int rho) { const int n = rho >> 4, i = rho & 15; return 8 * (i >> 2) + 4 * n + (i & 3); }
__device__ __forceinline__ unsigned cvt_pk_bf16(float lo, float hi) { unsigned r; asm volatile("v_cvt_pk_bf16_f32 %0, %1, %2" : "=v"(r) : "v"(lo), "v"(hi)); return r; }

struct Unit { const char* a; const char* b; int pm, pn, e, p0, cnt; };

template <class Epi, class Sched>
__device__ __forceinline__ void gemm_phase(LAS unsigned char* lds, const int K_, const Sched& S, const Epi& E) {
    int K = K_; asm volatile("" : "+s"(K));
    int tid = threadIdx.x; asm volatile("" : "+v"(tid));
    const int wid = __builtin_amdgcn_readfirstlane(tid >> 6), lane = tid & 63, wr = wid >> 2, wc = wid & 3, fr = lane & 15, fq = lane >> 4;
    const int nt = K / BK;
    unsigned voffB[2];
#pragma unroll
    for (int i = 0; i < 2; ++i) { int R, C; stage_rc(tid * 16 + i * 8192, R, C); const int Rb = Epi::PERM ? ((R & ~31) + perm32(R & 31)) : R; voffB[i] = (unsigned)(Rb * K + C) * 2u; }
    const size_t kstep = (size_t)(BK * 2);
    const size_t hstep = (size_t)HALF * K * 2;
    const unsigned ldsw = (unsigned)wid * 1024u;
    const int aoff = lds_byte(wr * 64 + fr, fq * 8), boff = lds_byte(wc * 32 + fr, fq * 8);
#define MG_SA(b, h) (((b) * 2 + (h)) * HTB)
#define MG_SB(b, h) ((4 + (b) * 2 + (h)) * HTB)
#define MG_STAGE(bufoff, gbase, voff) do { _Pragma("unroll") for (int _i = 0; _i < 2; ++_i) \
        __builtin_amdgcn_global_load_lds((const unsigned*)((const char*)(gbase) + (voff)[_i]), (LAS unsigned*)(lds + (bufoff) + ldsw + _i * 8192), 16, 0, 0); } while (0)
#define MG_LDA(dst, b, h) do { _Pragma("unroll") for (int m = 0; m < 4; ++m) _Pragma("unroll") for (int k = 0; k < 2; ++k) dst[m][k] = *(const LAS bf16x8*)(lds + MG_SA(b, h) + aoff + m * 2048 + k * 1024); } while (0)
#define MG_LDB(dst, b, h) do { _Pragma("unroll") for (int n = 0; n < 2; ++n) _Pragma("unroll") for (int k = 0; k < 2; ++k) dst[n][k] = *(const LAS bf16x8*)(lds + MG_SB(b, h) + boff + n * 2048 + k * 1024); } while (0)
#define MG_MMA(ai, bj, At, Bt) do { __builtin_amdgcn_s_setprio(1); _Pragma("unroll") for (int m = 0; m < 4; ++m) _Pragma("unroll") for (int n = 0; n < 2; ++n) _Pragma("unroll") for (int k = 0; k < 2; ++k) \
        acc[ai][bj][m][n] = __builtin_amdgcn_mfma_f32_16x16x32_bf16(Bt[n][k], At[m][k], acc[ai][bj][m][n], 0, 0, 0); __builtin_amdgcn_s_setprio(0); } while (0)
#define MG_WAIT_V(n) asm volatile("s_waitcnt vmcnt(" #n ")" ::: "memory")
#define MG_WAIT_L(n) asm volatile("s_waitcnt lgkmcnt(" #n ")" ::: "memory")
#define MG_BAR __builtin_amdgcn_s_barrier()
#define MG_SCHED __builtin_amdgcn_sched_barrier(0)
    Unit cur, nxt; int ui = 0;
    if (!S.next(0, cur)) return;
    f32x4 acc[2][2][4][2];
#pragma unroll
    for (int a = 0; a < 2; ++a)
#pragma unroll
        for (int b = 0; b < 2; ++b)
#pragma unroll
            for (int m = 0; m < 4; ++m)
#pragma unroll
                for (int n = 0; n < 2; ++n) acc[a][b][m][n] = (f32x4){0.f, 0.f, 0.f, 0.f};
    bf16x8 At[4][2], B0[2][2], B1[2][2];
    unsigned cvo0[2], cvo1[2], nvo0[2], nvo1[2];
    S.a_voff(cur, cvo0, cvo1);
    const char* cA = cur.a; const char* cB = cur.b;
    MG_STAGE(MG_SB(0, 0), cB, voffB); MG_STAGE(MG_SA(0, 0), cA, cvo0); MG_STAGE(MG_SB(0, 1), cB + hstep, voffB); MG_STAGE(MG_SA(0, 1), cA, cvo1);
    if (wr == 1) MG_BAR;
    MG_WAIT_V(4); MG_BAR;
    MG_STAGE(MG_SB(1, 0), cB + kstep, voffB); MG_STAGE(MG_SA(1, 0), cA + kstep, cvo0); MG_STAGE(MG_SB(1, 1), cB + hstep + kstep, voffB);
    MG_WAIT_V(6); MG_BAR;
    for (;;) {
        const bool has_next = S.next(ui + 1, nxt);
        const char* nA = has_next ? nxt.a : cA; const char* nB = has_next ? nxt.b : cB;
        if (has_next) S.a_voff(nxt, nvo0, nvo1); else { nvo0[0] = cvo0[0]; nvo0[1] = cvo0[1]; nvo1[0] = cvo1[0]; nvo1[1] = cvo1[1]; }
        for (int t = 0; t < nt; t += 2) {
            const bool last = (t == nt - 2);
            const char* a1 = cA + (size_t)(t + 1) * kstep;
            const char* a2 = last ? nA : cA + (size_t)(t + 2) * kstep; const char* b2 = last ? nB : cB + (size_t)(t + 2) * kstep;
            const char* a3 = a2 + kstep; const char* b3 = b2 + kstep;
            MG_LDB(B0, 0, 0); MG_SCHED; MG_LDA(At, 0, 0); MG_STAGE(MG_SA(1, 1), a1, cvo1);
            if (last) { cvo0[0] = nvo0[0]; cvo0[1] = nvo0[1]; cvo1[0] = nvo1[0]; cvo1[1] = nvo1[1]; }
            MG_WAIT_L(8); MG_BAR; MG_WAIT_L(0); MG_MMA(0, 0, At, B0); MG_BAR; MG_SCHED;
            MG_LDB(B1, 0, 1); MG_STAGE(MG_SB(0, 0), b2, voffB);
            MG_BAR; MG_WAIT_L(0); MG_MMA(0, 1, At, B1); MG_BAR;
            MG_LDA(At, 0, 1); MG_STAGE(MG_SA(0, 0), a2, cvo0);
            MG_BAR; MG_WAIT_L(0); MG_MMA(1, 0, At, B0); MG_BAR; MG_SCHED;
            MG_STAGE(MG_SB(0, 1), b2 + hstep, voffB);
            MG_WAIT_V(6); MG_BAR; MG_MMA(1, 1, At, B1); MG_BAR;
            MG_LDB(B0, 1, 0); MG_SCHED; MG_LDA(At, 1, 0); MG_STAGE(MG_SA(0, 1), a2, cvo1);
            MG_WAIT_L(8); MG_BAR; MG_WAIT_L(0); MG_MMA(0, 0, At, B0); MG_BAR; MG_SCHED;
            MG_LDB(B1, 1, 1); MG_STAGE(MG_SB(1, 0), b3, voffB);
            MG_BAR; MG_WAIT_L(0); MG_MMA(0, 1, At, B1); MG_BAR;
            MG_LDA(At, 1, 1); MG_STAGE(MG_SA(1, 0), a3, cvo0);
            MG_BAR; MG_WAIT_L(0); MG_MMA(1, 0, At, B0); MG_BAR; MG_SCHED;
            MG_STAGE(MG_SB(1, 1), b3 + hstep, voffB);
            MG_WAIT_V(6); MG_BAR; MG_MMA(1, 1, At, B1); MG_BAR;
        }
        {
            int tz = threadIdx.x; asm volatile("" : "+v"(tz));
            const int wz = __builtin_amdgcn_readfirstlane(tz >> 6), lz = tz & 63;
            E(acc, cur, wz >> 2, wz & 3, lz & 15, lz >> 4); }
        if (!has_next) break;
#pragma unroll
        for (int a = 0; a < 2; ++a)
#pragma unroll
            for (int b = 0; b < 2; ++b)
#pragma unroll
                for (int m = 0; m < 4; ++m)
#pragma unroll
                    for (int n = 0; n < 2; ++n) acc[a][b][m][n] = (f32x4){0.f, 0.f, 0.f, 0.f};
        cur = nxt; cA = nA; cB = nB; ++ui;
    }
    MG_WAIT_V(0);
    if (wr == 0) MG_BAR;
    MG_BAR;
#undef MG_SA
#undef MG_SB
#undef MG_STAGE
#undef MG_LDA
#undef MG_LDB
#undef MG_MMA
#undef MG_WAIT_V
#undef MG_WAIT_L
#undef MG_BAR
#undef MG_SCHED
}

struct MoeSched {
    int tsv, cntv;
    const int* list;
    const char* A;
    const char* Bt;
    int ntn, G, c, K;
    __device__ __forceinline__ bool next(int i, Unit& u) const {
        const int L = i * G + c, ntm = __builtin_amdgcn_readlane(tsv, NE);
        if (L >= ntm * ntn) return false;
        const int tnext = __shfl_down(tsv, 1);
        int tz = threadIdx.x; asm volatile("" : "+v"(tz)); const int lane = tz & 63;
        const int e = __builtin_popcountll(__ballot(lane < NE && tnext * ntn <= L));
        const int ts = __builtin_amdgcn_readlane(tsv, e), te = __builtin_amdgcn_readlane(tsv, e + 1);
        const int mte = te - ts, r = L - ts * ntn, pn = r / mte, mtl = r - pn * mte;
        u.pm = ts + mtl; u.pn = pn; u.e = e; u.p0 = mtl * 256; u.cnt = __builtin_amdgcn_readlane(cntv, e);
        u.a = list ? A : A + (size_t)u.pm * 256 * K * 2;
        u.b = Bt + ((size_t)(e * ntn + pn) * 256) * K * 2;
        return true;
    }
    __device__ __forceinline__ void a_voff(const Unit& u, unsigned (&v0)[2], unsigned (&v1)[2]) const {
        int tz = threadIdx.x; asm volatile("" : "+v"(tz));
#pragma unroll
        for (int i = 0; i < 2; ++i) {
            int R, C; stage_rc(tz * 16 + i * 8192, R, C);
            if (list) {
                const int* lst = list + (size_t)u.e * LISTCAP;
                const int q0 = min(u.p0 + R, u.cnt - 1), q1 = min(u.p0 + 128 + R, u.cnt - 1);
                v0[i] = (unsigned)((lst[q0] >> 2) * K + C) * 2u; v1[i] = (unsigned)((lst[q1] >> 2) * K + C) * 2u;
            } else { v0[i] = (unsigned)(R * K + C) * 2u; v1[i] = (unsigned)((128 + R) * K + C) * 2u; }
        }
    }
};

struct DenseSched {
    const char* A; const char* Bt; int nM, nN, G, c, K;
    __device__ __forceinline__ bool next(int i, Unit& u) const {
        const int nwg = nM * nN; const long L = (long)i * G + c; if (L >= nwg) return false;
        int wgid = (int)L; { const int q = nwg / 8, r = nwg % 8, xcd = wgid % 8, off = wgid / 8; wgid = (xcd < r ? xcd * (q + 1) : r * (q + 1) + (xcd - r) * q) + off; }
        const int nig = 8 * nN, gid = wgid / nig, fm = gid * 8, gsz = (nM - fm) < 8 ? (nM - fm) : 8;
        u.pm = fm + ((wgid % nig) % gsz); u.pn = (wgid % nig) / gsz; u.e = 0; u.p0 = 0; u.cnt = 0;
        u.a = A + (size_t)u.pm * 256 * K * 2; u.b = Bt + (size_t)u.pn * 256 * K * 2;
        return true;
    }
    __device__ __forceinline__ void a_voff(const Unit&, unsigned (&v0)[2], unsigned (&v1)[2]) const {
        int tz = threadIdx.x; asm volatile("" : "+v"(tz));
#pragma unroll
        for (int i = 0; i < 2; ++i) { int R, C; stage_rc(tz * 16 + i * 8192, R, C); v0[i] = (unsigned)(R * K + C) * 2u; v1[i] = (unsigned)((128 + R) * K + C) * 2u; }
    }
};
struct EpiF32 {
    static constexpr bool PERM = false;
    float* Cm; int ldc;
    __device__ __forceinline__ void operator()(const f32x4 (&acc)[2][2][4][2], const Unit& u, int wr, int wc, int fr, int fq) const {
        const int row0 = u.pm * BM + wr * 64 + fr, col0 = u.pn * BM + wc * 32 + 4 * fq;
#pragma unroll
        for (int ai = 0; ai < 2; ++ai)
#pragma unroll
            for (int m = 0; m < 4; ++m) { float* rowp = Cm + (size_t)(row0 + ai * HALF + m * 16) * ldc + col0;
#pragma unroll
                for (int bj = 0; bj < 2; ++bj)
#pragma unroll
                    for (int n = 0; n < 2; ++n) *(f32x4*)(rowp + bj * HALF + n * 16) = acc[ai][bj][m][n]; }
    }
};
struct EpiResid {
    static constexpr bool PERM = false;
    float* X; const float* gate_l;
    __device__ __forceinline__ void operator()(const f32x4 (&acc)[2][2][4][2], const Unit& u, int wr, int wc, int fr, int fq) const {
        const int row0 = u.pm * BM + wr * 64 + fr, col0 = u.pn * BM + wc * 32 + 4 * fq;
        const float* gp = gate_l + (size_t)(u.pm < TL / 256 ? (u.pm >> 3) : 8) * 6144 + col0;
        f32x4 gv[2][2];
#pragma unroll
        for (int bj = 0; bj < 2; ++bj)
#pragma unroll
            for (int n = 0; n < 2; ++n) gv[bj][n] = *(const f32x4*)(gp + bj * HALF + n * 16);
#pragma unroll
        for (int ai = 0; ai < 2; ++ai)
#pragma unroll
            for (int m = 0; m < 4; ++m) { float* rowp = X + (size_t)(row0 + ai * HALF + m * 16) * D + col0;
#pragma unroll
                for (int bj = 0; bj < 2; ++bj)
#pragma unroll
                    for (int n = 0; n < 2; ++n) { f32x4* p = (f32x4*)(rowp + bj * HALF + n * 16); *p = *p + gv[bj][n] * acc[ai][bj][m][n]; } }
    }
};
struct EpiGlu {
    static constexpr bool PERM = false;
    float* So; const float* Gm; const float* bias;
    __device__ __forceinline__ void operator()(const f32x4 (&acc)[2][2][4][2], const Unit& u, int wr, int wc, int fr, int fq) const {
        const int row0 = u.pm * BM + wr * 64 + fr, col0 = wc * 32 + 4 * fq;
        f32x4 bv[2][2];
#pragma unroll
        for (int bj = 0; bj < 2; ++bj)
#pragma unroll
            for (int n = 0; n < 2; ++n) bv[bj][n] = *(const f32x4*)(bias + col0 + bj * HALF + n * 16);
#pragma unroll
        for (int ai = 0; ai < 2; ++ai)
#pragma unroll
            for (int m = 0; m < 4; ++m) { const size_t ro = (size_t)(row0 + ai * HALF + m * 16) * 256 + col0;
#pragma unroll
                for (int bj = 0; bj < 2; ++bj)
#pragma unroll
                    for (int n = 0; n < 2; ++n) { const f32x4 z = acc[ai][bj][m][n] + bv[bj][n]; const f32x4 g = *(const f32x4*)(Gm + ro + bj * HALF + n * 16); f32x4 o;
#pragma unroll
                        for (int i = 0; i < 4; ++i) o[i] = g[i] / (1.f + __expf(-z[i]));
                        *(f32x4*)(So + ro + bj * HALF + n * 16) = o; } }
    }
};
struct EpiSwiglu {
    static constexpr bool PERM = true;
    bf16_t* act; const float* bgu;
    __device__ __forceinline__ void operator()(const f32x4 (&acc)[2][2][4][2], const Unit& u, int wr, int wc, int fr, int fq) const {
        const int j = u.pn * 128 + wc * 32 + 8 * fq;
        const float* bg = bgu + (size_t)u.e * 2048 + j;
        const f32x4 g0 = *(const f32x4*)(bg), g1 = *(const f32x4*)(bg + 4), u0 = *(const f32x4*)(bg + 1024), u1 = *(const f32x4*)(bg + 1028);
#pragma unroll
        for (int ai = 0; ai < 2; ++ai)
#pragma unroll
            for (int m = 0; m < 4; ++m) {
                const int rl = ai * 128 + wr * 64 + m * 16 + fr;
                float o[8];
#pragma unroll
                for (int n = 0; n < 2; ++n)
#pragma unroll
                    for (int i = 0; i < 4; ++i) {
                        float gt = acc[ai][0][m][n][i] + (n ? g1[i] : g0[i]), up = acc[ai][1][m][n][i] + (n ? u1[i] : u0[i]);
                        gt = fminf(gt, 7.f); up = fminf(fmaxf(up, -7.f), 7.f);
                        o[n * 4 + i] = (up + 1.f) * (gt / (1.f + __expf(-1.702f * gt)));
                    }
                u32x4 w; w.x = cvt_pk_bf16(o[0], o[1]); w.y = cvt_pk_bf16(o[2], o[3]); w.z = cvt_pk_bf16(o[4], o[5]); w.w = cvt_pk_bf16(o[6], o[7]);
                *(u32x4*)(act + ((size_t)u.pm * 256 + rl) * D + j) = w;
            }
    }
};
struct EpiDown {
    static constexpr bool PERM = true;
    bf16_t* yb; const float* bdn; const int* list;
    __device__ __forceinline__ void operator()(const f32x4 (&acc)[2][2][4][2], const Unit& u, int wr, int wc, int fr, int fq) const {
        const int c0 = u.pn * 256 + wc * 32 + 8 * fq;
        const float* bd = bdn + (size_t)u.e * D + c0;
        f32x4 bv[2][2];
#pragma unroll
        for (int bj = 0; bj < 2; ++bj)
#pragma unroll
            for (int n = 0; n < 2; ++n) bv[bj][n] = *(const f32x4*)(bd + bj * 128 + 4 * n);
        const int* lst = list + (size_t)u.e * LISTCAP;
#pragma unroll
        for (int ai = 0; ai < 2; ++ai)
#pragma unroll
            for (int m = 0; m < 4; ++m) {
                const int pos = u.p0 + ai * 128 + wr * 64 + m * 16 + fr;
                if (pos < u.cnt) {
                    bf16_t* rowp = yb + (size_t)lst[pos] * D + c0;
#pragma unroll
                    for (int bj = 0; bj < 2; ++bj) {
                        const f32x4 v0 = acc[ai][bj][m][0] + bv[bj][0], v1 = acc[ai][bj][m][1] + bv[bj][1];
                        u32x4 w; w.x = cvt_pk_bf16(v0[0], v0[1]); w.y = cvt_pk_bf16(v0[2], v0[3]); w.z = cvt_pk_bf16(v1[0], v1[1]); w.w = cvt_pk_bf16(v1[2], v1[3]);
                        *(u32x4*)(rowp + bj * 128) = w;
                    }
                }
            }
    }
};
}

template <class RF>
__device__ __forceinline__ void transpose_cvt_tile(float* sm, const int tid, const float* src, int ldn, int k0, int n0, unsigned short* dst, int ldk, RF dst_row) {
    float (*T)[129] = (float (*)[129])sm;
    __syncthreads();
#pragma unroll
    for (int i = 0; i < 4; ++i) {
        const int kk = (tid >> 4) + 32 * i, cc = (tid & 15) * 4;
        const float4 v = *(const float4*)(src + (size_t)(k0 + kk) * ldn + n0 + cc);
        T[cc][kk] = v.x; T[cc + 1][kk] = v.y; T[cc + 2][kk] = v.z; T[cc + 3][kk] = v.w;
    }
    __syncthreads();
#pragma unroll
    for (int i = 0; i < 2; ++i) {
        const int n = (tid >> 4) + 32 * i, kk = (tid & 15) * 8;
        mg::u32x4 w;
        w.x = mg::cvt_pk_bf16(T[n][kk], T[n][kk + 1]); w.y = mg::cvt_pk_bf16(T[n][kk + 2], T[n][kk + 3]);
        w.z = mg::cvt_pk_bf16(T[n][kk + 4], T[n][kk + 5]); w.w = mg::cvt_pk_bf16(T[n][kk + 6], T[n][kk + 7]);
        *(mg::u32x4*)(dst + (size_t)dst_row(n0 + n) * ldk + k0 + kk) = w;
    }
}
typedef __bf16 bf16x2_t __attribute__((ext_vector_type(2)));
typedef float f32x2_t __attribute__((ext_vector_type(2)));
typedef float f32x16 __attribute__((ext_vector_type(16)));
__device__ __forceinline__ unsigned pk_bf16(float a, float b) { f32x2_t v = {a, b}; bf16x2_t r = __builtin_convertvector(v, bf16x2_t); return __builtin_bit_cast(unsigned, r); }
__device__ __forceinline__ unsigned short bf16_1(float a) { return (unsigned short)(pk_bf16(a, 0.f) & 0xffffu); }
__device__ __forceinline__ float bf2f(unsigned short b) { return __uint_as_float(((unsigned)b) << 16); }

__global__ void __launch_bounds__(NT, 2) fwd(Args args) {
    extern __shared__ __attribute__((aligned(16))) unsigned char lds[];
    float* smem = (float*)lds;
    LAS unsigned char* ldsl = (LAS unsigned char*)lds;
    LAS unsigned* misc = (LAS unsigned*)(ldsl + MISC_OFF);
    const int bid = blockIdx.x, nb = gridDim.x;
    const int nwaves = nb * (NT / 64), gthreads = nb * NT;
#define PH_IDS int tid = threadIdx.x; asm volatile("" : "+v"(tid)); const int lane = tid & 63, wave = tid >> 6, gw = wave * nb + bid, gtid = bid * NT + tid; (void)lane; (void)wave; (void)gw; (void)gtid; \
    kaptr_t ka = (kaptr_t)__builtin_amdgcn_kernarg_segment_ptr(); asm volatile("" : "+s"(ka)); unsigned char* const ws = KA_LOAD(unsigned char*, 264); (void)ws
    unsigned* ctl = (unsigned*)(args.ws + WS_CTL);
    typedef const unsigned char __attribute__((address_space(4)))* kaptr_t;
#define KA_LOAD(T, off) (*(T const __attribute__((address_space(4)))*)(ka + (off)))
#define INP(i) KA_LOAD(const float*, 8 * (i))
#define OUTP KA_LOAD(float*, 256)
#define MOD ((float*)(ws + WS_MOD))
#define ROPEC ((float*)(ws + WS_ROPE))
#define ROPES (ROPEC + 2048 * 64)
#define DISC ((float*)(ws + WS_DISC))
#define XS ((float*)(ws + WS_XS))
#define H ((float*)(ws + WS_H))
#define PX ((float*)(ws + WS_PX))
#define QN ((float*)(ws + WS_QN))
#define KN ((float*)(ws + WS_KN))
#define ATT ((float*)(ws + WS_ATT))
#define DLT ((float*)(ws + WS_DLT))
#define G ((float*)(ws + WS_G))
#define SO ((float*)(ws + WS_SO))
#define MRG ((float*)(ws + WS_MRG))
#define ST ((float2*)(ws + WS_ST))
#define TOPI ((int*)(ws + WS_TOPI))
#define GATE ((float*)(ws + WS_GATE))
#define LIST ((int*)(ws + WS_LIST))
#define WGUT ((unsigned short*)(ws + WS_WGUT))
#define WDNT ((unsigned short*)(ws + WS_WDNT))
#define H2B ((unsigned short*)(ws + WS_H2B))
#define ACTB ((unsigned short*)(ws + WS_ACTB))
#define YBB ((unsigned short*)(ws + WS_YBB))
#define WINT ((unsigned short*)(ws + WS_WINT))
#define WOUTT ((unsigned short*)(ws + WS_WOUTT))
#define GLUT ((unsigned short*)(ws + WS_GLUT))
#define HB ((unsigned short*)(ws + WS_HB))
#define EB ((float2*)(ws + WS_EB))
#define QNB ((unsigned short*)(ws + WS_QNB))
#define KNB ((unsigned short*)(ws + WS_KNB))
#define VTB ((unsigned short*)(ws + WS_VTB))
#define VTCB ((unsigned short*)(ws + WS_VTCB))
#define MRGB ((unsigned short*)(ws + WS_MRGB))
#define GB ((unsigned short*)(ws + WS_GB))
#define modl (MOD + (size_t)l * 9 * 6144)
#define counts (((unsigned*)(ws + WS_CTL)) + CW_CNT + l * NE)
    if (threadIdx.x < 4) misc[threadIdx.x] = 0u;
    __syncthreads();
    XcdBarrier bar = xcd_barrier_post(ctl + CW_BAR, (volatile LAS unsigned*)misc);
    const int lo = args.ph_lo, hi = args.ph_hi;
    int ph = 0;
#define IN_PH() (lo <= ph && ph < hi)
#define SEAM() do { if (lo <= ph && ph + 1 < hi) xcd_barrier(bar); ++ph; } while (0)

    if (IN_PH()) { PH_IDS;
        {   const float4* x4 = (const float4*)INP(I_X); const float4* c4 = (const float4*)INP(I_CTX); float4* xs4 = (float4*)XS;
            for (size_t i = gtid; i < (size_t)TA * 256; i += gthreads) xs4[i] = i < (size_t)TL * 256 ? x4[i] : c4[i - (size_t)TL * 256]; }
        for (int i = gtid; i < 2048 * 64; i += gthreads) {
            const int t = i >> 6, d = i & 63, f = d & 15, axis = d >> 5;
            const float pos = axis == 0 ? (float)(t >> 6) : (float)(t & 63);
            const float inv = powf(10000.f, -(float)(2 * f) / 32.f);
            const float ang = pos * inv;
            ROPEC[i] = cosf(ang); ROPES[i] = sinf(ang);
        }
        for (int it = bid; it < DEPTH * NE * (256 + 128); it += nb) {
            const int le = it / 384, r = it % 384;
            if (r < 256) { const int kt = r >> 5, ntl = r & 31;
                transpose_cvt_tile(smem, tid, INP(I_WGU) + (size_t)le * D * 2048, 2048, kt * 128, ntl * 64, WGUT + (size_t)le * 2048 * D, D,
                    [](int n) { const int half = n >> 10, rem = n & 1023; return (rem >> 7) * 256 + half * 128 + (rem & 127); });
            } else { const int r2 = r - 256, kt = r2 >> 4, ntl = r2 & 15;
                transpose_cvt_tile(smem, tid, INP(I_WDN) + (size_t)le * D * D, D, kt * 128, ntl * 64, WDNT + (size_t)le * D * D, D, [](int n) { return n; }); }
        }
        for (int it = bid; it < DEPTH * (160 + 128 + 8); it += nb) {
            const int l = it / 296, r = it % 296;
            if (r < 160) { const int kt = r / 20, ntl = r % 20;
                transpose_cvt_tile(smem, tid, INP(I_WIN) + (size_t)l * D * INW, INW, kt * 128, ntl * 64, WINT + (size_t)l * INW * D, D, [](int n) { return n; });
            } else if (r < 288) { const int r2 = r - 160, kt = r2 >> 4, ntl = r2 & 15;
                transpose_cvt_tile(smem, tid, INP(I_WOUT) + (size_t)l * D * D, D, kt * 128, ntl * 64, WOUTT + (size_t)l * D * D, D, [](int n) { return n; });
            } else { const int r2 = r - 288, kt = r2 >> 2, ntl = r2 & 3;
                transpose_cvt_tile(smem, tid, INP(I_GLUW) + (size_t)l * 256 * 256, 256, kt * 128, ntl * 64, GLUT + (size_t)l * 256 * 256, 256, [](int n) { return n; }); }
        }
        __syncthreads();
        for (int i = tid; i < 9 * 1024; i += NT) { const float v = i < 8192 ? INP(I_C)[i] : INP(I_CCTX)[i - 8192]; smem[i] = silu_f(v); }
        __syncthreads();
        for (int it = bid; it < DEPTH * 96; it += nb) {
            const int l = it / 96, j = (it % 96) * 64 + lane;
            const float* w = INP(I_WMOD) + (size_t)l * D * 6144 + j;
            float acc[9];
#pragma unroll
            for (int m = 0; m < 9; ++m) acc[m] = 0.f;
            for (int k = wave * 128; k < wave * 128 + 128; ++k) {
                const float wv = w[(size_t)k * 6144];
#pragma unroll
                for (int m = 0; m < 9; ++m) acc[m] += smem[m * 1024 + k] * wv;
            }
            float* pb = smem + 9 * 1024;
#pragma unroll
            for (int m = 0; m < 9; ++m) pb[(wave * 9 + m) * 64 + lane] = acc[m];
            __syncthreads();
            if (wave == 0) {
                const float bias = INP(I_BMOD)[(size_t)l * 6144 + j];
#pragma unroll
                for (int m = 0; m < 9; ++m) { float s = 0.f;
#pragma unroll
                    for (int w8 = 0; w8 < 8; ++w8) s += pb[(w8 * 9 + m) * 64 + lane];
                    MOD[((size_t)l * 9 + m) * 6144 + j] = s + bias; }
            }
            __syncthreads();
        }
    }
    SEAM();

    for (int l = 0; l < DEPTH; ++l) {
        const int nrows_moe = (l == DEPTH - 1) ? TL : TA;

        if (IN_PH()) { PH_IDS;
            const float* n1w = INP(I_N1W) + l * D;
            for (int row = gw; row < TA; row += nwaves) {
                const int mr = mrow_of(row);
                float4* xr = (float4*)(XS + (size_t)row * D);
                float4 v[4];
#pragma unroll
                for (int i = 0; i < 4; ++i) v[i] = xr[lane + i * 64];
                if (l > 0) {
                    const float* g2 = MOD + ((size_t)(l - 1) * 9 + mr) * 6144 + 5 * D;
                    float gk[4];
#pragma unroll
                    for (int k = 0; k < 4; ++k) gk[k] = GATE[row * 4 + k];
#pragma unroll
                    for (int i = 0; i < 4; ++i) {
                        float4 s = make_float4(0.f, 0.f, 0.f, 0.f);
#pragma unroll
                        for (int k = 0; k < 4; ++k) { const uint2 y = ((const uint2*)(YBB + ((size_t)row * 4 + k) * D))[lane + i * 64];
                            s.x += gk[k] * __uint_as_float(y.x << 16); s.y += gk[k] * __uint_as_float(y.x & 0xffff0000u); s.z += gk[k] * __uint_as_float(y.y << 16); s.w += gk[k] * __uint_as_float(y.y & 0xffff0000u); }
                        const float4 gg = ((const float4*)g2)[lane + i * 64];
                        v[i].x += gg.x * s.x; v[i].y += gg.y * s.y; v[i].z += gg.z * s.z; v[i].w += gg.w * s.w;
                        xr[lane + i * 64] = v[i];
                    }
                }
                float ss = 0.f;
#pragma unroll
                for (int i = 0; i < 4; ++i) ss += v[i].x * v[i].x + v[i].y * v[i].y + v[i].z * v[i].z + v[i].w * v[i].w;
                ss = wave_sum(ss);
                const float rstd = rsqrtf(ss * (1.f / D) + EPS);
                const float4* sh = (const float4*)(modl + (size_t)mr * 6144), *sc = (const float4*)(modl + (size_t)mr * 6144 + D);
                uint2* hr = (uint2*)(HB + (size_t)row * D);
#pragma unroll
                for (int i = 0; i < 4; ++i) {
                    const float4 w4 = ((const float4*)n1w)[lane + i * 64], s4 = sh[lane + i * 64], c4 = sc[lane + i * 64];
                    float4 o;
                    o.x = v[i].x * rstd * w4.x * (1.f + c4.x) + s4.x; o.y = v[i].y * rstd * w4.y * (1.f + c4.y) + s4.y;
                    o.z = v[i].z * rstd * w4.z * (1.f + c4.z) + s4.z; o.w = v[i].w * rstd * w4.w * (1.f + c4.w) + s4.w;
                    hr[lane + i * 64] = make_uint2(mg::cvt_pk_bf16(o.x, o.y), mg::cvt_pk_bf16(o.z, o.w));
                }
            }
            for (int i = gtid; i < 2048; i += gthreads) {
                const int dg = i >> 6;
                const size_t pbase = (size_t)l * 2048 + i;
                const float are = INP(I_ARE)[pbase], aim = INP(I_AIM)[pbase];
                const float dt = expf(INP(I_LOGDT)[l * 32 + dg]);
                const float mag = expf(are * dt), ar = mag * cosf(aim * dt), ai = mag * sinf(aim * dt);
                const float den = are * are + aim * aim;
                const float qr = ((ar - 1.0f) * are + ai * aim) / den, qi = (ai * are - (ar - 1.0f) * aim) / den;
                DISC[i] = ar; DISC[2048 + i] = ai;
                const float* br = INP(I_BRE) + pbase * 16; const float* bi = INP(I_BIM) + pbase * 16;
                for (int p = 0; p < 16; ++p) {
                    DISC[4096 + i * 16 + p] = qr * br[p] - qi * bi[p];
                    DISC[4096 + 32768 + i * 16 + p] = qr * bi[p] + qi * br[p];
                }
            }
        }
        SEAM();

        if (IN_PH()) { PH_IDS;
            mg::DenseSched S{(const char*)HB, (const char*)(WINT + (size_t)l * INW * D), TA / 256, INW / 256, nb, bid, D};
            mg::EpiF32 E{PX, INW};
            mg::gemm_phase(ldsl, D, S, E);
        }
        SEAM();

        if (IN_PH()) { PH_IDS;
            LAS float* Uc = (LAS float*)(ldsl + wave * 12800);
            for (int it = gw; it < NBATCH * 36 * 2 * 16; it += nwaves) {
                const int g = it & 15, dir = (it >> 4) & 1, r2 = it >> 5, ck = r2 % 36, b = r2 / 36;
                const int row0 = ck < 4 ? TL + b * CTXL + ck * 64 : b * SEQ + (ck - 4) * 64;
                {   const float4* up = (const float4*)(PX + (size_t)(row0 + lane) * INW + 768 + g * 16);
                    LAS mg::f32x4* ud = (LAS mg::f32x4*)(Uc + lane * 16); const mg::f32x4* upv = (const mg::f32x4*)up; ud[0] = upv[0]; ud[1] = upv[1]; ud[2] = upv[2]; ud[3] = upv[3]; }
                const int di = (dir * 16 + g) * 64 + lane;
                const float ar = DISC[di], ai = DISC[2048 + di];
                float bbr[16], bbi[16];
#pragma unroll
                for (int p4 = 0; p4 < 4; ++p4) { const float4 x = ((const float4*)(DISC + 4096 + di * 16))[p4], y = ((const float4*)(DISC + 4096 + 32768 + di * 16))[p4];
                    bbr[4 * p4] = x.x; bbr[4 * p4 + 1] = x.y; bbr[4 * p4 + 2] = x.z; bbr[4 * p4 + 3] = x.w; bbi[4 * p4] = y.x; bbi[4 * p4 + 1] = y.y; bbi[4 * p4 + 2] = y.z; bbi[4 * p4 + 3] = y.w; }
                float sr = 0.f, si = 0.f;
                for (int i = 0; i < 64; ++i) {
                    const int tt = dir ? 63 - i : i;
                    const LAS mg::f32x4* uq = (const LAS mg::f32x4*)(Uc + tt * 16);
                    const mg::f32x4 u0 = uq[0], u1 = uq[1], u2 = uq[2], u3 = uq[3];
                    const float uu[16] = {u0[0], u0[1], u0[2], u0[3], u1[0], u1[1], u1[2], u1[3], u2[0], u2[1], u2[2], u2[3], u3[0], u3[1], u3[2], u3[3]};
                    float xr = 0.f, xi = 0.f;
#pragma unroll
                    for (int p = 0; p < 16; ++p) { xr += bbr[p] * uu[p]; xi += bbi[p] * uu[p]; }
                    const float nsr = ar * sr - ai * si + xr, nsi = ar * si + ai * sr + xi;
                    sr = nsr; si = nsi;
                }
                const int k = dir ? (ck < 4 ? 3 - ck : 39 - ck) : ck;
                EB[((size_t)((b * 2 + dir) * 16 + g) * 36 + k) * 64 + lane] = make_float2(sr, si);
            }
            for (int row = gw; row < TA; row += nwaves) {
                const int li = lane & 15, hsub = lane >> 4;
#pragma unroll
                for (int pass = 0; pass < 3; ++pass) {
                    const int hh = pass * 4 + hsub;
                    if (hh < 10) {
                        const float4 v = *(const float4*)(PX + (size_t)row * INW + hh * 64 + li * 4);
                        float ss = v.x * v.x + v.y * v.y + v.z * v.z + v.w * v.w;
                        ss += __shfl_xor(ss, 1); ss += __shfl_xor(ss, 2); ss += __shfl_xor(ss, 4); ss += __shfl_xor(ss, 8);
                        const float rs = rsqrtf(ss * (1.f / 64.f) + EPS);
                        const float4 nw = *(const float4*)((hh < 8 ? INP(I_QNW) : INP(I_KNW)) + l * 64 + li * 4);
                        float y0 = v.x * rs * nw.x, y1 = v.y * rs * nw.y, y2 = v.z * rs * nw.z, y3 = v.w * rs * nw.w;
                        if (row < TL) {
                            const float p0 = __shfl_xor(y0, 4), p1 = __shfl_xor(y1, 4), p2 = __shfl_xor(y2, 4), p3 = __shfl_xor(y3, 4);
                            const int t = row & (SEQ - 1);
                            const float4 c = *(const float4*)(ROPEC + t * 64 + li * 4), sn = *(const float4*)(ROPES + t * 64 + li * 4);
                            const float sg = ((li >> 2) & 1) ? 1.f : -1.f;
                            y0 = y0 * c.x + sg * p0 * sn.x; y1 = y1 * c.y + sg * p1 * sn.y; y2 = y2 * c.z + sg * p2 * sn.z; y3 = y3 * c.w + sg * p3 * sn.w;
                        }
                        if (hh < 8) *(uint2*)(QNB + (size_t)row * 512 + hh * 64 + li * 4) = make_uint2(pk_bf16(y0 * 0.125f, y1 * 0.125f), pk_bf16(y2 * 0.125f, y3 * 0.125f));
                        else *(uint2*)(KNB + (size_t)row * 128 + (hh - 8) * 64 + li * 4) = make_uint2(pk_bf16(y0, y1), pk_bf16(y2, y3));
                    }
                }
            }
            for (int it = gw; it < (TA / 64) * 2; it += nwaves) {
                const int rb = it >> 1, kvh = it & 1, row = rb * 64 + lane;
                const float4* vp = (const float4*)(PX + (size_t)row * INW + 640 + kvh * 64);
                unsigned short* dst; int stride;
                if (rb < TL / 64) { const int b = rb >> 5, t = (rb & 31) * 64 + lane; dst = VTB + (size_t)(b * 2 + kvh) * 64 * SEQ + t; stride = SEQ; }
                else { const int q = rb - TL / 64, b = q >> 2, c = (q & 3) * 64 + lane; dst = VTCB + (size_t)(b * 2 + kvh) * 64 * CTXL + c; stride = CTXL; }
#pragma unroll
                for (int i = 0; i < 16; ++i) { const float4 x = vp[i];
                    dst[(size_t)(4 * i) * stride] = bf16_1(x.x); dst[(size_t)(4 * i + 1) * stride] = bf16_1(x.y); dst[(size_t)(4 * i + 2) * stride] = bf16_1(x.z); dst[(size_t)(4 * i + 3) * stride] = bf16_1(x.w); }
            }
            for (int row = gw; row < TA; row += nwaves) {
                const int hw = 1 << (lane >> 4);
                int base, t, L;
                if (row < TL) { base = row & ~(SEQ - 1); t = row & (SEQ - 1); L = SEQ; } else { const int q = row - TL; base = TL + (q & ~(CTXL - 1)); t = q & (CTXL - 1); L = CTXL; }
                const int tlo = max(t - hw, 0), thi = min(t + hw, L);
                float4 sm4 = make_float4(0.f, 0.f, 0.f, 0.f);
                for (int tt = tlo; tt < thi; ++tt) { const float4 x = *(const float4*)(PX + (size_t)(base + tt) * INW + 1024 + lane * 4); sm4.x += x.x; sm4.y += x.y; sm4.z += x.z; sm4.w += x.w; }
                const float inv = 1.f / (float)(thi - tlo);
                const float4 own = *(const float4*)(PX + (size_t)row * INW + 1024 + lane * 4);
                *(float4*)(DLT + (size_t)row * 256 + lane * 4) = make_float4(sm4.x * inv - own.x, sm4.y * inv - own.y, sm4.z * inv - own.z, sm4.w * inv - own.w);
            }
        }
        SEAM();

        if (IN_PH()) { PH_IDS;
            for (int it = bid * (NT / 64) + wave; it < (TA / 32) * 8; it += nwaves) {
                const int h = it & 7, qb = it >> 3, kvh = h >> 2;
                const bool lat = qb < TL / 32;
                const int b = lat ? (qb >> 6) : ((qb - TL / 32) >> 3);
                const int t0 = lat ? ((qb & 63) * 32) : 0;
                const int r = lane & 31, hf = lane >> 5;
                const int qrow = qb * 32 + r;
                mg::bf16x8 qf[4];
#pragma unroll
                for (int ks = 0; ks < 4; ++ks) qf[ks] = *(const mg::bf16x8*)(QNB + (size_t)qrow * 512 + h * 64 + ks * 16 + hf * 8);
                f32x16 o0, o1;
#pragma unroll
                for (int i = 0; i < 16; ++i) { o0[i] = 0.f; o1[i] = 0.f; }
                float m = INP(I_SINK)[l * 8 + h], lsum = hf == 0 ? 1.f : 0.f;
                const int kt_lo = lat ? max(0, (128 - t0) >> 5) : 9, kt_hi = lat ? min(8, (SEQ + 96 - t0) >> 5) : 8;
                for (int kt = kt_lo; kt < 17; ++kt) {
                    if (kt > kt_hi && kt < 9) continue;
                    const bool loc = kt < 9;
                    const unsigned short* kbase; const unsigned short* vbase; int vstride;
                    if (loc) { const int kpos0 = t0 - 128 + kt * 32; kbase = KNB + (size_t)(b * SEQ + kpos0) * 128 + kvh * 64; vbase = VTB + (size_t)(b * 2 + kvh) * 64 * SEQ + kpos0; vstride = SEQ; }
                    else { const int c0 = (kt - 9) * 32; kbase = KNB + (size_t)(TL + b * CTXL + c0) * 128 + kvh * 64; vbase = VTCB + (size_t)(b * 2 + kvh) * 64 * CTXL + c0; vstride = CTXL; }
                    mg::bf16x8 kf[4];
#pragma unroll
                    for (int ks = 0; ks < 4; ++ks) kf[ks] = *(const mg::bf16x8*)(kbase + (size_t)r * 128 + ks * 16 + hf * 8);
                    uint2 vlo[2][2], vhi[2][2];
#pragma unroll
                    for (int dt = 0; dt < 2; ++dt)
#pragma unroll
                        for (int sx = 0; sx < 2; ++sx) { const unsigned short* vp = vbase + (size_t)(dt * 32 + r) * vstride + 16 * sx + 4 * hf; vlo[dt][sx] = *(const uint2*)vp; vhi[dt][sx] = *(const uint2*)(vp + 8); }
                    f32x16 x;
#pragma unroll
                    for (int i = 0; i < 16; ++i) x[i] = 0.f;
#pragma unroll
                    for (int ks = 0; ks < 4; ++ks) x = __builtin_amdgcn_mfma_f32_32x32x16_bf16(kf[ks], qf[ks], x, 0, 0, 0);
                    if (loc && (kt == 0 || kt == 8)) {
#pragma unroll
                        for (int i = 0; i < 16; ++i) { const int key = (i & 3) + 8 * (i >> 2) + 4 * hf; const bool ok = kt == 0 ? key >= r : key <= r; x[i] = ok ? x[i] : -INFINITY; }
                    }
                    float mx = x[0];
#pragma unroll
                    for (int i = 1; i < 16; ++i) mx = fmaxf(mx, x[i]);
                    mx = fmaxf(mx, __shfl_xor(mx, 32));
                    const float mn = fmaxf(m, mx), alpha = __expf(m - mn); m = mn;
                    float ps = 0.f;
#pragma unroll
                    for (int i = 0; i < 16; ++i) { x[i] = __expf(x[i] - mn); ps += x[i]; }
                    lsum = lsum * alpha + ps;
#pragma unroll
                    for (int i = 0; i < 16; ++i) { o0[i] *= alpha; o1[i] *= alpha; }
                    mg::bf16x8 pf[2];
#pragma unroll
                    for (int sx = 0; sx < 2; ++sx) { mg::u32x4 w; w.x = pk_bf16(x[8 * sx], x[8 * sx + 1]); w.y = pk_bf16(x[8 * sx + 2], x[8 * sx + 3]); w.z = pk_bf16(x[8 * sx + 4], x[8 * sx + 5]); w.w = pk_bf16(x[8 * sx + 6], x[8 * sx + 7]); pf[sx] = __builtin_bit_cast(mg::bf16x8, w); }
#pragma unroll
                    for (int sx = 0; sx < 2; ++sx) {
                        mg::u32x4 w0; w0.x = vlo[0][sx].x; w0.y = vlo[0][sx].y; w0.z = vhi[0][sx].x; w0.w = vhi[0][sx].y;
                        mg::u32x4 w1; w1.x = vlo[1][sx].x; w1.y = vlo[1][sx].y; w1.z = vhi[1][sx].x; w1.w = vhi[1][sx].y;
                        o0 = __builtin_amdgcn_mfma_f32_32x32x16_bf16(__builtin_bit_cast(mg::bf16x8, w0), pf[sx], o0, 0, 0, 0);
                        o1 = __builtin_amdgcn_mfma_f32_32x32x16_bf16(__builtin_bit_cast(mg::bf16x8, w1), pf[sx], o1, 0, 0, 0);
                    }
                }
                lsum += __shfl_xor(lsum, 32);
                const float inv = 1.f / lsum;
                float* op = ATT + (size_t)qrow * 512 + h * 64 + 4 * hf;
#pragma unroll
                for (int gi = 0; gi < 4; ++gi) {
                    *(float4*)(op + 8 * gi) = make_float4(o0[4 * gi] * inv, o0[4 * gi + 1] * inv, o0[4 * gi + 2] * inv, o0[4 * gi + 3] * inv);
                    *(float4*)(op + 32 + 8 * gi) = make_float4(o1[4 * gi] * inv, o1[4 * gi + 1] * inv, o1[4 * gi + 2] * inv, o1[4 * gi + 3] * inv);
                }
            }
            {
                LAS float* Uc = (LAS float*)(ldsl + wave * 12800);
                LAS unsigned char* Sb = ldsl + wave * 12800 + 4096;
                const float* cre = INP(I_CRE) + (size_t)l * 2 * 16 * 16 * 64; const float* cim = INP(I_CIM) + (size_t)l * 2 * 16 * 16 * 64;
                for (int it = gw; it < NBATCH * 36 * 16; it += nwaves) {
                    const int g = it & 15, r2 = it >> 4, ck = r2 % 36, b = r2 / 36;
                    const int row0 = ck < 4 ? TL + b * CTXL + ck * 64 : b * SEQ + (ck - 4) * 64;
                    {   const float4* up = (const float4*)(PX + (size_t)(row0 + lane) * INW + 768 + g * 16);
                        LAS mg::f32x4* ud = (LAS mg::f32x4*)(Uc + lane * 16); const mg::f32x4* upv = (const mg::f32x4*)up; ud[0] = upv[0]; ud[1] = upv[1]; ud[2] = upv[2]; ud[3] = upv[3]; }
                    mg::f32x4 yacc[2][2];
#pragma unroll
                    for (int a = 0; a < 2; ++a)
#pragma unroll
                        for (int c = 0; c < 2; ++c) yacc[a][c] = (mg::f32x4){0.f, 0.f, 0.f, 0.f};
                    const int pcol = lane & 15, quad = lane >> 4;
#pragma unroll 1
                    for (int dir = 0; dir < 2; ++dir) {
                        const int di = (dir * 16 + g) * 64 + lane;
                        const float ar = DISC[di], ai = DISC[2048 + di];
                        float bbr[16], bbi[16];
#pragma unroll
                        for (int p4 = 0; p4 < 4; ++p4) { const float4 x = ((const float4*)(DISC + 4096 + di * 16))[p4], y = ((const float4*)(DISC + 4096 + 32768 + di * 16))[p4];
                            bbr[4 * p4] = x.x; bbr[4 * p4 + 1] = x.y; bbr[4 * p4 + 2] = x.z; bbr[4 * p4 + 3] = x.w; bbi[4 * p4] = y.x; bbi[4 * p4 + 1] = y.y; bbi[4 * p4 + 2] = y.z; bbi[4 * p4 + 3] = y.w; }
                        float a64r = ar, a64i = ai;
#pragma unroll
                        for (int q = 0; q < 6; ++q) { const float tr = a64r * a64r - a64i * a64i, ti2 = 2.f * a64r * a64i; a64r = tr; a64i = ti2; }
                        const int k = dir ? (ck < 4 ? 3 - ck : 39 - ck) : ck;
                        const float2* ep = EB + ((size_t)((b * 2 + dir) * 16 + g) * 36) * 64 + lane;
                        float sr = 0.f, si = 0.f;
                        for (int kp = 0; kp < k; ++kp) { const float2 e = ep[(size_t)kp * 64]; const float nsr = a64r * sr - a64i * si + e.x, nsi = a64r * si + a64i * sr + e.y; sr = nsr; si = nsi; }
                        mg::bf16x8 cf[4];
#pragma unroll
                        for (int kk = 0; kk < 4; ++kk) {
                            const float4 c4 = *(const float4*)(cre + ((size_t)(dir * 16 + g) * 16 + pcol) * 64 + kk * 16 + quad * 4);
                            const float4 d4 = *(const float4*)(cim + ((size_t)(dir * 16 + g) * 16 + pcol) * 64 + kk * 16 + quad * 4);
                            mg::u32x4 w; w.x = pk_bf16(c4.x, -d4.x); w.y = pk_bf16(c4.y, -d4.y); w.z = pk_bf16(c4.z, -d4.z); w.w = pk_bf16(c4.w, -d4.w);
                            cf[kk] = __builtin_bit_cast(mg::bf16x8, w);
                        }
#pragma unroll 1
                        for (int half = 0; half < 2; ++half) {
                            const int sb = dir ? 1 - half : half;
                            for (int i = 0; i < 32; ++i) {
                                const int tl = dir ? 31 - i : i, tt = sb * 32 + tl;
                                const LAS mg::f32x4* uq = (const LAS mg::f32x4*)(Uc + tt * 16);
                                const mg::f32x4 u0 = uq[0], u1 = uq[1], u2 = uq[2], u3 = uq[3];
                                const float uu[16] = {u0[0], u0[1], u0[2], u0[3], u1[0], u1[1], u1[2], u1[3], u2[0], u2[1], u2[2], u2[3], u3[0], u3[1], u3[2], u3[3]};
                                float xr = 0.f, xi = 0.f;
#pragma unroll
                                for (int p = 0; p < 16; ++p) { xr += bbr[p] * uu[p]; xi += bbi[p] * uu[p]; }
                                const float nsr = ar * sr - ai * si + xr, nsi = ar * si + ai * sr + xi;
                                sr = nsr; si = nsi;
                                { typedef short s16x2 __attribute__((ext_vector_type(2))); *(LAS s16x2*)(Sb + tl * 272 + lane * 4) = __builtin_bit_cast(s16x2, pk_bf16(sr, si)); }
                            }
#pragma unroll
                            for (int mt = 0; mt < 2; ++mt)
#pragma unroll
                                for (int kk = 0; kk < 4; ++kk) {
                                    const mg::bf16x8 af = *(const LAS mg::bf16x8*)(Sb + (mt * 16 + pcol) * 272 + kk * 64 + quad * 16);
                                    if (sb == 0) yacc[0][mt] = __builtin_amdgcn_mfma_f32_16x16x32_bf16(af, cf[kk], yacc[0][mt], 0, 0, 0);
                                    else yacc[1][mt] = __builtin_amdgcn_mfma_f32_16x16x32_bf16(af, cf[kk], yacc[1][mt], 0, 0, 0);
                                }
                        }
                    }
                    const int c = g * 16 + pcol;
                    const float dch = INP(I_SSMD)[l * 256 + c];
#pragma unroll
                    for (int sb = 0; sb < 2; ++sb)
#pragma unroll
                        for (int mt = 0; mt < 2; ++mt)
#pragma unroll
                            for (int j = 0; j < 4; ++j) {
                                const int tt = sb * 32 + mt * 16 + quad * 4 + j;
                                const float y = yacc[sb][mt][j] + dch * Uc[tt * 16 + pcol];
                                const float gy = gelu_tanh_f(y);
                                const size_t idx = (size_t)(row0 + tt) * 256 + c;
                                G[idx] = gy; GB[idx] = bf16_1(gy);
                            }
                }
            }
            for (size_t i = gtid; i < (size_t)TA * 256; i += gthreads) {
                const int row = (int)(i >> 8), c = (int)(i & 255);
                const int g4 = c >> 6, dd = c & 63;
                const float* pw = INP(I_POOLW) + ((size_t)l * 4 + g4) * 64 * 64 + dd;
                const float* dl = DLT + (size_t)row * 256 + g4 * 64;
                float z = 0.f;
                for (int cc = 0; cc < 64; ++cc) z += dl[cc] * pw[cc * 64];
                MRGB[(size_t)row * D + 768 + c] = bf16_1(z * INP(I_POOLS)[l * 256 + c]);
            }
        }
        SEAM();

        if (IN_PH()) { PH_IDS;
            mg::DenseSched S{(const char*)GB, (const char*)(GLUT + (size_t)l * 256 * 256), TA / 256, 1, nb, bid, 256};
            mg::EpiGlu E{SO, G, INP(I_GLUB) + l * 256};
            mg::gemm_phase(ldsl, 256, S, E);
        }
        SEAM();

        if (IN_PH()) { PH_IDS;
            const float* onw = INP(I_ONW) + l * 768;
            for (int row = gw; row < TA; row += nwaves) {
                const float4* ap = (const float4*)(ATT + (size_t)row * 512);
                const float4 a0 = ap[lane], a1 = ap[lane + 64];
                float ss = a0.x * a0.x + a0.y * a0.y + a0.z * a0.z + a0.w * a0.w + a1.x * a1.x + a1.y * a1.y + a1.z * a1.z + a1.w * a1.w;
                ss = wave_sum(ss);
                const float ra = rsqrtf(ss * (1.f / 512.f) + EPS);
                const float4 s0 = ((const float4*)(SO + (size_t)row * 256))[lane];
                float s2 = wave_sum(s0.x * s0.x + s0.y * s0.y + s0.z * s0.z + s0.w * s0.w);
                const float rs = rsqrtf(s2 * (1.f / 256.f) + EPS);
                uint2* mp = (uint2*)(MRGB + (size_t)row * D);
                const float4 w0 = ((const float4*)onw)[lane], w1 = ((const float4*)onw)[lane + 64], w2 = ((const float4*)onw)[lane + 128];
                mp[lane] = make_uint2(mg::cvt_pk_bf16(a0.x * ra * w0.x, a0.y * ra * w0.y), mg::cvt_pk_bf16(a0.z * ra * w0.z, a0.w * ra * w0.w));
                mp[lane + 64] = make_uint2(mg::cvt_pk_bf16(a1.x * ra * w1.x, a1.y * ra * w1.y), mg::cvt_pk_bf16(a1.z * ra * w1.z, a1.w * ra * w1.w));
                mp[lane + 128] = make_uint2(mg::cvt_pk_bf16(s0.x * rs * w2.x, s0.y * rs * w2.y), mg::cvt_pk_bf16(s0.z * rs * w2.z, s0.w * rs * w2.w));
            }
        }
        SEAM();

        if (IN_PH()) { PH_IDS;
            mg::DenseSched S{(const char*)MRGB, (const char*)(WOUTT + (size_t)l * D * D), TA / 256, D / 256, nb, bid, D};
            mg::EpiResid E{XS, modl + 2 * D};
            mg::gemm_phase(ldsl, D, S, E);
        }
        SEAM();

        if (IN_PH()) { PH_IDS;
            const float* n2w = INP(I_N2W) + l * D; const float* rw = INP(I_RW) + (size_t)l * D * NE; const float* rb = INP(I_RB) + l * NE;
            for (int row = gw; row < nrows_moe; row += nwaves) {
                const int mr = mrow_of(row);
                const float4* xr = (const float4*)(XS + (size_t)row * D);
                float4 v[4];
#pragma unroll
                for (int i = 0; i < 4; ++i) v[i] = xr[lane + i * 64];
                float ss = 0.f;
#pragma unroll
                for (int i = 0; i < 4; ++i) ss += v[i].x * v[i].x + v[i].y * v[i].y + v[i].z * v[i].z + v[i].w * v[i].w;
                ss = wave_sum(ss);
                const float rstd = rsqrtf(ss * (1.f / D) + EPS);
                const float4* sh = (const float4*)(modl + (size_t)mr * 6144 + 3 * D), *sc = (const float4*)(modl + (size_t)mr * 6144 + 4 * D);
                uint2* hr = (uint2*)(H2B + (size_t)row * D);
                float lg[32];
#pragma unroll
                for (int e = 0; e < 32; ++e) lg[e] = 0.f;
#pragma unroll
                for (int i = 0; i < 4; ++i) {
                    const float4 w4 = ((const float4*)n2w)[lane + i * 64], s4 = sh[lane + i * 64], c4 = sc[lane + i * 64];
                    float4 o;
                    o.x = v[i].x * rstd * w4.x * (1.f + c4.x) + s4.x; o.y = v[i].y * rstd * w4.y * (1.f + c4.y) + s4.y;
                    o.z = v[i].z * rstd * w4.z * (1.f + c4.z) + s4.z; o.w = v[i].w * rstd * w4.w * (1.f + c4.w) + s4.w;
                    hr[lane + i * 64] = make_uint2(mg::cvt_pk_bf16(o.x, o.y), mg::cvt_pk_bf16(o.z, o.w));
                    const float oo[4] = {o.x, o.y, o.z, o.w};
#pragma unroll
                    for (int j = 0; j < 4; ++j) {
                        const float4* rp = (const float4*)(rw + (size_t)((lane + i * 64) * 4 + j) * NE);
#pragma unroll
                        for (int e4 = 0; e4 < 8; ++e4) { const float4 r = rp[e4];
                            lg[4 * e4] += oo[j] * r.x; lg[4 * e4 + 1] += oo[j] * r.y; lg[4 * e4 + 2] += oo[j] * r.z; lg[4 * e4 + 3] += oo[j] * r.w; }
                    }
                }
#pragma unroll
                for (int e = 0; e < 32; ++e) lg[e] = wave_sum(lg[e]) + rb[e];
                float tv[4]; int ti[4];
#pragma unroll
                for (int k = 0; k < 4; ++k) {
                    float best = -INFINITY; int bi = 0;
#pragma unroll
                    for (int e = 0; e < 32; ++e) if (lg[e] > best) { best = lg[e]; bi = e; }
                    tv[k] = best; ti[k] = bi;
#pragma unroll
                    for (int e = 0; e < 32; ++e) if (e == bi) lg[e] = -INFINITY;
                }
                const float e1 = __expf(tv[1] - tv[0]), e2 = __expf(tv[2] - tv[0]), e3 = __expf(tv[3] - tv[0]);
                const float inv = 1.f / (1.f + e1 + e2 + e3);
                const float gk[4] = {inv, e1 * inv, e2 * inv, e3 * inv};
#pragma unroll
                for (int k = 0; k < 4; ++k) {
                    if (lane == k) {
                        TOPI[row * 4 + k] = ti[k]; GATE[row * 4 + k] = gk[k];
                        const unsigned pos = atomicAdd(&counts[ti[k]], 1u);
                        LIST[(size_t)ti[k] * LISTCAP + pos] = row * 4 + k;
                    }
                }
            }
        }
        SEAM();

        if (IN_PH()) { PH_IDS;
            LAS int* tstart = (LAS int*)(misc + 16);
            __syncthreads();
            if (tid == 0) { int acc = 0; for (int e = 0; e < NE; ++e) { const int cn = (int)counts[e]; tstart[e] = acc; tstart[40 + e] = cn; acc += (cn + 255) >> 8; } tstart[NE] = acc; tstart[40 + NE] = 0; }
            __syncthreads();
            const int tsv = tstart[min(lane, NE)], cntv = tstart[40 + min(lane, NE)];
            mg::MoeSched S{tsv, cntv, LIST, (const char*)H2B, (const char*)(WGUT + (size_t)l * NE * 2048 * D), 8, nb, bid, D};
            mg::EpiSwiglu E{ACTB, INP(I_BGU) + (size_t)l * NE * 2048};
            mg::gemm_phase(ldsl, D, S, E);
        }
        SEAM();

        if (IN_PH()) { PH_IDS;
            LAS int* tstart = (LAS int*)(misc + 16);
            __syncthreads();
            if (tid == 0) { int acc = 0; for (int e = 0; e < NE; ++e) { const int cn = (int)counts[e]; tstart[e] = acc; tstart[40 + e] = cn; acc += (cn + 255) >> 8; } tstart[NE] = acc; tstart[40 + NE] = 0; }
            __syncthreads();
            const int tsv = tstart[min(lane, NE)], cntv = tstart[40 + min(lane, NE)];
            mg::MoeSched S{tsv, cntv, nullptr, (const char*)ACTB, (const char*)(WDNT + (size_t)l * NE * D * D), 4, nb, bid, D};
            mg::EpiDown E{YBB, INP(I_BDN) + (size_t)l * NE * D, LIST};
            mg::gemm_phase(ldsl, D, S, E);
        }
        SEAM();
    }

    if (IN_PH()) { PH_IDS;
        for (int row = gw; row < TL; row += nwaves) {
            const float* g2 = MOD + ((size_t)(DEPTH - 1) * 9 + mrow_of(row)) * 6144 + 5 * D;
            float gk[4];
#pragma unroll
            for (int k = 0; k < 4; ++k) gk[k] = GATE[row * 4 + k];
#pragma unroll
            for (int i = 0; i < 4; ++i) {
                float4 v = ((const float4*)(XS + (size_t)row * D))[lane + i * 64];
                float4 s = make_float4(0.f, 0.f, 0.f, 0.f);
#pragma unroll
                for (int k = 0; k < 4; ++k) { const uint2 y = ((const uint2*)(YBB + ((size_t)row * 4 + k) * D))[lane + i * 64];
                    s.x += gk[k] * __uint_as_float(y.x << 16); s.y += gk[k] * __uint_as_float(y.x & 0xffff0000u); s.z += gk[k] * __uint_as_float(y.y << 16); s.w += gk[k] * __uint_as_float(y.y & 0xffff0000u); }
                const float4 gg = ((const float4*)g2)[lane + i * 64];
                v.x += gg.x * s.x; v.y += gg.y * s.y; v.z += gg.z * s.z; v.w += gg.w * s.w;
                ((float4*)(OUTP + (size_t)row * D))[lane + i * 64] = v;
            }
        }
    }
}

extern "C" void kernel_launch(void* const* d_in, const int* in_sizes, int n_in, void* d_out, int out_size, void* d_ws, size_t ws_size, hipStream_t stream) {
    static int grid = 0;
    if (grid == 0) {
        if (n_in != 32 || out_size != TL * D || ws_size < WS_END) { fprintf(stderr, "kernel_launch: unexpected shapes (n_in %d out %d ws %zu need %zu)\n", n_in, out_size, ws_size, (size_t)WS_END); grid = -1; return; }
        int dev = 0, cus = 0, per_cu = 0;
        if (hipGetDevice(&dev) != hipSuccess || hipDeviceGetAttribute(&cus, hipDeviceAttributeMultiprocessorCount, dev) != hipSuccess) { grid = -1; return; }
        if (hipFuncSetAttribute((const void*)fwd, hipFuncAttributeMaxDynamicSharedMemorySize, LDS_BYTES) != hipSuccess) { fprintf(stderr, "kernel_launch: hipFuncSetAttribute failed\n"); grid = -1; return; }
        if (hipOccupancyMaxActiveBlocksPerMultiprocessor(&per_cu, (const void*)fwd, NT, LDS_BYTES) != hipSuccess || per_cu < 1) { fprintf(stderr, "kernel_launch: occupancy query says %d\n", per_cu); }
        (void)hipGetLastError();
        grid = cus;
    }
    if (grid < 0) return;
    (void)hipMemsetAsync((char*)d_ws + WS_CTL, 0, CTL_BYTES, stream);
    Args a{};
    for (int i = 0; i < 32; ++i) a.in[i] = (const float*)d_in[i];
    a.out = (float*)d_out; a.ws = (unsigned char*)d_ws;
#if defined(MK_PER_PHASE)
    const int nph = 2 + DEPTH * 10;
    for (int p = 0; p < nph; ++p) { a.ph_lo = p; a.ph_hi = p + 1; hipLaunchKernelGGL(fwd, dim3(grid), dim3(NT), LDS_BYTES, stream, a); }
#else
    a.ph_lo = 0; a.ph_hi = 1 << 20;
    hipLaunchKernelGGL(fwd, dim3(grid), dim3(NT), LDS_BYTES, stream, a);
#endif
}
```

```cpp
#include <hip/hip_runtime.h>
#include <cstdio>
#include <cstdint>

constexpr int D = 1024, NBATCH = 8, SEQ = 2048, CTXL = 256, DEPTH = 4;
constexpr int TL = NBATCH * SEQ, TC = NBATCH * CTXL, TA = TL + TC;
constexpr int INW = 1280, NE = 32, TOPK = 4, NMOD = 6;
constexpr int NT = 512;
constexpr int MISC_OFF = 131072, LDS_BYTES = 163840;
constexpr int UT_OFF = MISC_OFF + 8192, UT_MAX = 12;
constexpr float EPS = 1e-6f;
constexpr int LISTCAP = TA * TOPK;
constexpr int ACT_ROWS = TA * TOPK + NE * 128;

constexpr size_t al256(size_t x) { return (x + 255) & ~(size_t)255; }
constexpr size_t WS_CTL = 0;
constexpr size_t CTL_BYTES = 65536;
constexpr size_t CW_BAR = 0;
constexpr size_t CW_CVT = 3600;
constexpr size_t CW_CNT = 4096;
constexpr size_t WS_MOD = WS_CTL + CTL_BYTES;
constexpr size_t WS_ROPE = al256(WS_MOD + (size_t)DEPTH * 9 * 6144 * 4);
constexpr size_t WS_DISC = al256(WS_ROPE + (size_t)2 * 2048 * 64 * 4);
constexpr size_t WS_XS = al256(WS_DISC + (size_t)(4096 + 65536) * 4);
constexpr size_t WS_H = al256(WS_XS + (size_t)TA * D * 4);
constexpr size_t WS_PX = al256(WS_H + (size_t)TA * D * 4);
constexpr size_t WS_QN = al256(WS_PX + (size_t)TA * INW * 4);
constexpr size_t WS_KN = al256(WS_QN + (size_t)TA * 512 * 4);
constexpr size_t WS_ATT = al256(WS_KN + (size_t)TA * 128 * 4);
constexpr size_t WS_DLT = al256(WS_ATT + (size_t)TA * 512 * 4);
constexpr size_t WS_G = al256(WS_DLT + (size_t)TA * 256 * 4);
constexpr size_t WS_SO = al256(WS_G + (size_t)TA * 256 * 4);
constexpr size_t WS_MRG = al256(WS_SO + (size_t)TA * 256 * 4);
constexpr size_t WS_ST = al256(WS_MRG + (size_t)TA * D * 4);
constexpr size_t WS_EB = WS_ST;
constexpr size_t WS_QNB = al256(WS_EB + (size_t)NBATCH * 2 * 16 * 36 * 64 * 8);
constexpr size_t WS_KNB = al256(WS_QNB + (size_t)TA * 512 * 2);
constexpr size_t WS_VTB = al256(WS_KNB + (size_t)TA * 128 * 2);
constexpr size_t WS_VTCB = al256(WS_VTB + (size_t)NBATCH * 2 * 64 * SEQ * 2);
static_assert(WS_VTCB + (size_t)NBATCH * 2 * 64 * CTXL * 2 <= WS_ST + (size_t)2 * TA * 16 * 64 * 8, "carve-up overflows the old state buffer");
constexpr size_t WS_TOPI = al256(WS_ST + (size_t)2 * TA * 16 * 64 * 8);
constexpr size_t WS_GATE = al256(WS_TOPI + (size_t)TA * 4 * 4);
constexpr size_t WS_LIST = al256(WS_GATE + (size_t)TA * 4 * 4);
constexpr size_t WS_ACT = al256(WS_LIST + (size_t)NE * LISTCAP * 4);
constexpr size_t WS_YB = al256(WS_ACT + (size_t)ACT_ROWS * D * 4);
constexpr size_t WS_YB_END = al256(WS_YB + (size_t)TA * TOPK * D * 4);
constexpr int ACT_ROWS2 = TA * TOPK + NE * 256;
constexpr size_t WS_WGUT = WS_YB_END;
constexpr size_t WS_WDNT = al256(WS_WGUT + (size_t)DEPTH * NE * 2048 * D * 2);
constexpr size_t WS_H2B = al256(WS_WDNT + (size_t)DEPTH * NE * D * D * 2);
constexpr size_t WS_ACTB = al256(WS_H2B + (size_t)TA * D * 2);
constexpr size_t WS_YBB = al256(WS_ACTB + (size_t)ACT_ROWS2 * D * 2);
constexpr size_t WS_WINT = al256(WS_YBB + (size_t)TA * TOPK * D * 2);
constexpr size_t WS_WOUTT = al256(WS_WINT + (size_t)DEPTH * INW * D * 2);
constexpr size_t WS_GLUT = al256(WS_WOUTT + (size_t)DEPTH * D * D * 2);
constexpr size_t WS_HB = al256(WS_GLUT + (size_t)DEPTH * 256 * 256 * 2);
constexpr size_t WS_MRGB = al256(WS_HB + (size_t)TA * D * 2);
constexpr size_t WS_GB = al256(WS_MRGB + (size_t)TA * D * 2);
constexpr size_t WS_PWT = al256(WS_GB + (size_t)TA * 256 * 2);
constexpr size_t WS_END = al256(WS_PWT + (size_t)DEPTH * 4 * 64 * 64 * 2);

#define XB_TMO      128
#define XB_XCNT(j)  (256  + 64 * (j))
#define XB_XSUB(j)  (1280 + 64 * (j))
#define XB_XGEN(j)  (2304 + 64 * (j))
#define XB_TOP      3328
#define XB_TOPGEN   3392
#define XCD_BAR_WORDS 3456
#define XB_SPIN_CAP (1u << 25)
#define LAS __attribute__((address_space(3)))

__device__ __forceinline__ unsigned xb_ld(unsigned* p)              { return __hip_atomic_load(p, __ATOMIC_RELAXED, __HIP_MEMORY_SCOPE_AGENT); }
__device__ __forceinline__ unsigned xb_add(unsigned* p, unsigned v) { return __hip_atomic_fetch_add(p, v, __ATOMIC_RELAXED, __HIP_MEMORY_SCOPE_AGENT); }
__device__ __forceinline__ unsigned xb_xcc_id() { return (unsigned)__builtin_amdgcn_s_getreg((3 << 11) | 20) & 0xFu; }
#define XB_SPIN(cond, bar) do { unsigned _sp = 0; while (cond) { __builtin_amdgcn_s_sleep(1); \
    if ((++_sp & 255u) == 0u) { if (xb_ld(&(bar)[XB_TMO])) break; if (_sp > XB_SPIN_CAP) { atomicAdd(&(bar)[XB_TMO], 1u); break; } } } } while (0)

struct XcdBarrier { unsigned* bar; unsigned x; volatile LAS unsigned* st; };

__device__ __forceinline__ XcdBarrier xcd_barrier_post(unsigned* bar, volatile LAS unsigned* st) {
    XcdBarrier b; b.bar = bar; b.x = xb_xcc_id(); b.st = st;
    if (threadIdx.x == 0) (void)xb_add(&bar[XB_XCNT(b.x)], 1u);
    return b;
}
__device__ __forceinline__ void xcd_barrier_complete(unsigned* bar, unsigned x, unsigned& nloc, unsigned& nx) {
    const unsigned G = gridDim.x * gridDim.y * gridDim.z;
    unsigned sum, cnt, mine, sp = 0u;
    for (;;) {
        sum = 0u; cnt = 0u; mine = 0u;
#pragma unroll
        for (unsigned j = 0; j < 16; ++j) { const unsigned c = xb_ld(&bar[XB_XCNT(j)]); sum += c; cnt += (c > 0u) ? 1u : 0u; mine = (j == x) ? c : mine; }
        if (sum == G) break;
        __builtin_amdgcn_s_sleep(1);
        if ((++sp & 255u) == 0u) { if (xb_ld(&bar[XB_TMO])) break; if (sp > XB_SPIN_CAP) { atomicAdd(&bar[XB_TMO], 1u); break; } }
    }
    nloc = mine > 0u ? mine : 1u; nx = cnt > 0u ? cnt : 1u;
}
__device__ __noinline__ void xcd_barrier_impl(unsigned* const bar_, const unsigned bx_, volatile LAS unsigned* const st_) {
    XcdBarrier b; b.bar = bar_; b.x = bx_; b.st = st_;
    asm volatile("s_waitcnt vmcnt(0)" ::: "memory");
    __syncthreads();
    if (threadIdx.x == 0) {
        unsigned* bar = b.bar;
        __builtin_amdgcn_s_waitcnt(0);
        unsigned nloc = b.st[0], nx = b.st[1];
        if (nloc == 0u) { xcd_barrier_complete(bar, b.x, nloc, nx); b.st[0] = nloc; b.st[1] = nx; }
        const unsigned old = xb_add(&bar[XB_XSUB(b.x)], 1u);
        const unsigned gen = old / nloc;
        if (old + 1u == (gen + 1u) * nloc) {
            __builtin_amdgcn_fence(__ATOMIC_RELEASE, "agent");
            asm volatile("s_waitcnt vmcnt(0)" ::: "memory");
            const unsigned og = xb_add(&bar[XB_TOP], 1u);
            const unsigned tg = og / nx;
            if (og + 1u == (tg + 1u) * nx) xb_add(&bar[XB_TOPGEN], 1u);
            else XB_SPIN(xb_ld(&bar[XB_TOPGEN]) == tg, bar);
            __builtin_amdgcn_fence(__ATOMIC_ACQUIRE, "agent");
            xb_add(&bar[XB_XGEN(b.x)], 1u);
            asm volatile("s_waitcnt vmcnt(0)" ::: "memory");
        } else {
            XB_SPIN(xb_ld(&bar[XB_XGEN(b.x)]) == gen, bar);
            __builtin_amdgcn_fence(__ATOMIC_ACQUIRE, "agent");
            asm volatile("s_waitcnt vmcnt(0)" ::: "memory");
        }
    }
    __syncthreads();
}
__device__ __forceinline__ void xcd_barrier(const XcdBarrier& b) { xcd_barrier_impl(b.bar, b.x, b.st); }

struct Args { const float* in[32]; float* out; unsigned char* ws; int ph_lo, ph_hi; };

enum { I_X = 0, I_C, I_CTX, I_CCTX, I_WMOD, I_BMOD, I_N1W, I_N2W, I_WIN, I_QNW, I_KNW, I_SINK, I_ARE, I_AIM, I_LOGDT, I_BRE, I_BIM,
       I_CRE, I_CIM, I_SSMD, I_GLUW, I_GLUB, I_POOLW, I_POOLS, I_ONW, I_WOUT, I_RW, I_RB, I_WGU, I_BGU, I_WDN, I_BDN };

__device__ __forceinline__ float shx_(float v, int k, int lane) { return __builtin_bit_cast(float, __builtin_amdgcn_ds_bpermute((lane ^ k) << 2, __builtin_bit_cast(int, v))); }
#define SHX(v, k) shx_((v), (k), lane)
__device__ __forceinline__ float wave_sum_(float v, int lane) {
#pragma unroll
    for (int o = 32; o > 0; o >>= 1) v += shx_(v, o, lane);
    return v;
}
#define DPPF(v, ctrl) __builtin_bit_cast(float, __builtin_amdgcn_update_dpp(0, __builtin_bit_cast(int, (v)), (ctrl), 0xf, 0xf, true))
__device__ __forceinline__ float wave_sum_dpp(float v) {
    v += DPPF(v, 0xB1); v += DPPF(v, 0x4E); v += DPPF(v, 0x141); v += DPPF(v, 0x140);
    const int vi = __builtin_bit_cast(int, v);
    return __builtin_bit_cast(float, __builtin_amdgcn_readlane(vi, 0)) + __builtin_bit_cast(float, __builtin_amdgcn_readlane(vi, 16)) + __builtin_bit_cast(float, __builtin_amdgcn_readlane(vi, 32)) + __builtin_bit_cast(float, __builtin_amdgcn_readlane(vi, 48));
}
__device__ __forceinline__ float wave_max_dpp(float v) {
    v = fmaxf(v, DPPF(v, 0xB1)); v = fmaxf(v, DPPF(v, 0x4E)); v = fmaxf(v, DPPF(v, 0x141)); v = fmaxf(v, DPPF(v, 0x140));
    const int vi = __builtin_bit_cast(int, v);
    return fmaxf(fmaxf(__builtin_bit_cast(float, __builtin_amdgcn_readlane(vi, 0)), __builtin_bit_cast(float, __builtin_amdgcn_readlane(vi, 16))), fmaxf(__builtin_bit_cast(float, __builtin_amdgcn_readlane(vi, 32)), __builtin_bit_cast(float, __builtin_amdgcn_readlane(vi, 48))));
}
#define wave_sum(v) wave_sum_dpp(v)
__device__ __forceinline__ float silu_f(float x) { return x / (1.f + __expf(-x)); }
__device__ __forceinline__ float sigmoid_f(float x) { return 1.f / (1.f + __expf(-x)); }
__device__ __forceinline__ float gelu_tanh_f(float x) { const float u2 = -2.302208198f * (x + 0.044715f * x * x * x); return x * __builtin_amdgcn_rcpf(1.f + __builtin_amdgcn_exp2f(u2)); }
__device__ __forceinline__ int mrow_of(int row) { return row < TL ? (row >> 11) : 8; }

template <class BF, class EF>
__device__ __forceinline__ void ngemm_tile(float* sm, const int tid, const float* arow, int K, BF bf, EF ef) {
    float (*As)[132] = (float (*)[132])sm;
    float (*Bs)[68] = (float (*)[68])(sm + 16 * 132);
    const int am = tid >> 2, ak = (tid & 3) * 4, bk = tid >> 5, bn = (tid & 31) * 2, ty = tid >> 4, tx = tid & 15;
    float acc[4][4];
#pragma unroll
    for (int i = 0; i < 4; ++i)
#pragma unroll
        for (int j = 0; j < 4; ++j) acc[i][j] = 0.f;
    for (int k0 = 0; k0 < K; k0 += 16) {
        float4 av = make_float4(0.f, 0.f, 0.f, 0.f);
        if (arow) av = *(const float4*)(arow + k0 + ak);
        const float b0 = bf(k0 + bk, bn), b1 = bf(k0 + bk, bn + 1);
        __syncthreads();
        As[ak + 0][am] = av.x; As[ak + 1][am] = av.y; As[ak + 2][am] = av.z; As[ak + 3][am] = av.w;
        Bs[bk][bn] = b0; Bs[bk][bn + 1] = b1;
        __syncthreads();
#pragma unroll
        for (int kk = 0; kk < 16; ++kk) {
            const float4 a4 = *(const float4*)&As[kk][ty * 4];
            const float4 b4 = *(const float4*)&Bs[kk][tx * 4];
            const float aa[4] = {a4.x, a4.y, a4.z, a4.w}, bb[4] = {b4.x, b4.y, b4.z, b4.w};
#pragma unroll
            for (int i = 0; i < 4; ++i)
#pragma unroll
                for (int j = 0; j < 4; ++j) acc[i][j] += aa[i] * bb[j];
        }
    }
#pragma unroll
    for (int i = 0; i < 4; ++i) ef(ty * 4 + i, tx * 4, acc[i]);
}


typedef __bf16 bf16x2_t __attribute__((ext_vector_type(2)));
typedef float f32x2_t __attribute__((ext_vector_type(2)));
typedef float f32x16 __attribute__((ext_vector_type(16)));
__device__ __forceinline__ unsigned pk_bf16(float a, float b) { f32x2_t v = {a, b}; bf16x2_t r = __builtin_convertvector(v, bf16x2_t); return __builtin_bit_cast(unsigned, r); }
__device__ __forceinline__ unsigned short bf16_1(float a) { return (unsigned short)(pk_bf16(a, 0.f) & 0xffffu); }
__device__ __forceinline__ float clamp448(float x) { return __builtin_amdgcn_fmed3f(x, -448.f, 448.f); }
namespace mg {
typedef unsigned short bf16_t;
typedef short bf16x8 __attribute__((ext_vector_type(8)));
typedef float f32x4 __attribute__((ext_vector_type(4)));
typedef unsigned u32x4 __attribute__((ext_vector_type(4)));
constexpr int BM = 256, BK = 64, HALF = 128, HTB = HALF * BK * 2, STAGE_BYTES = 8 * HTB;
__host__ __device__ __forceinline__ int lds_byte(int r, int c) { const int st = (r >> 4) * 2 + (c >> 5), rr = r & 15, cc = c & 31, ob = rr * 64 + cc * 2; return st * 1024 + (ob ^ (((ob >> 9) & 1) << 5)); }
__host__ __device__ __forceinline__ void stage_rc(int b, int& R, int& C) { const int st = b / 1024, sb = b % 1024, swz = sb ^ (((sb >> 9) & 1) << 5); R = (st >> 1) * 16 + swz / 64; C = (st & 1) * 32 + (swz % 64) / 2; }
__host__ __device__ __forceinline__ int perm32(int rho) { const int n = rho >> 4, i = rho & 15; return 8 * (i >> 2) + 4 * n + (i & 3); }
__device__ __forceinline__ unsigned cvt_pk_bf16(float lo, float hi) { unsigned r; asm volatile("v_cvt_pk_bf16_f32 %0, %1, %2" : "=v"(r) : "v"(lo), "v"(hi)); return r; }

struct Unit { const char* a; const char* b; int pm, pn, e, p0, cnt, idx, half; };

typedef int v8i_t __attribute__((ext_vector_type(8)));
typedef int v4i_t __attribute__((ext_vector_type(4)));
template <class Epi, class Sched, bool FP8 = false>
__device__ __forceinline__ void gemm_phase(LAS unsigned char* lds, const int KB_, const Sched& S, const Epi& E) {
    int K = KB_; asm volatile("" : "+s"(K));
    int tid = threadIdx.x; asm volatile("" : "+v"(tid));
    const int wid = __builtin_amdgcn_readfirstlane(tid >> 6), lane = tid & 63, wr = wid >> 2, wc = wid & 3, fr = lane & 15, fq = lane >> 4;
    const int nt = K / 128;
    unsigned voffB[2];
#pragma unroll
    for (int i = 0; i < 2; ++i) { int R, C; stage_rc(tid * 16 + i * 8192, R, C); const int Rb = Epi::PERM ? ((R & ~31) + perm32(R & 31)) : R; voffB[i] = (unsigned)(Rb * K + C * 2); }
    const size_t kstep = (size_t)128;
    const size_t hstep = (size_t)HALF * K;
    const unsigned ldsw = (unsigned)wid * 1024u;
    const int aoff = lds_byte(wr * 64 + fr, fq * 8), boff = lds_byte(wc * 32 + fr, fq * 8);
#define MG_SA(b, h) (((b) * 2 + (h)) * HTB)
#define MG_SB(b, h) ((4 + (b) * 2 + (h)) * HTB)
#define MG_STAGE(bufoff, gbase, voff) do { _Pragma("unroll") for (int _i = 0; _i < 2; ++_i) \
        __builtin_amdgcn_global_load_lds((const unsigned*)((const char*)(gbase) + (voff)[_i]), (LAS unsigned*)(lds + (bufoff) + ldsw + _i * 8192), 16, 0, 0); } while (0)
#define MG_LDA(dst, b, h) do { _Pragma("unroll") for (int m = 0; m < 4; ++m) _Pragma("unroll") for (int k = 0; k < 2; ++k) dst[m][k] = *(const LAS bf16x8*)(lds + MG_SA(b, h) + aoff + m * 2048 + k * 1024); } while (0)
#define MG_LDB(dst, b, h) do { _Pragma("unroll") for (int n = 0; n < 2; ++n) _Pragma("unroll") for (int k = 0; k < 2; ++k) dst[n][k] = *(const LAS bf16x8*)(lds + MG_SB(b, h) + boff + n * 2048 + k * 1024); } while (0)
#define MG_MMA(ai, bj, At, Bt) do { __builtin_amdgcn_s_setprio(1); _Pragma("unroll") for (int m = 0; m < 4; ++m) _Pragma("unroll") for (int n = 0; n < 2; ++n) { \
        if (FP8) { const v8i_t wf = __builtin_shufflevector(__builtin_bit_cast(v4i_t, Bt[n][0]), __builtin_bit_cast(v4i_t, Bt[n][1]), 0, 1, 2, 3, 4, 5, 6, 7); \
                   const v8i_t xf = __builtin_shufflevector(__builtin_bit_cast(v4i_t, At[m][0]), __builtin_bit_cast(v4i_t, At[m][1]), 0, 1, 2, 3, 4, 5, 6, 7); \
                   acc[ai][bj][m][n] = __builtin_amdgcn_mfma_scale_f32_16x16x128_f8f6f4(wf, xf, acc[ai][bj][m][n], 0, 0, 0, 0x79797979, 0, 0x7f7f7f7f); } \
        else { _Pragma("unroll") for (int k = 0; k < 2; ++k) acc[ai][bj][m][n] = __builtin_amdgcn_mfma_f32_16x16x32_bf16(Bt[n][k], At[m][k], acc[ai][bj][m][n], 0, 0, 0); } } \
        __builtin_amdgcn_s_setprio(0); } while (0)
#define MG_WAIT_V(n) asm volatile("s_waitcnt vmcnt(" #n ")" ::: "memory")
#define MG_WAIT_L(n) asm volatile("s_waitcnt lgkmcnt(" #n ")" ::: "memory")
#define MG_BAR __builtin_amdgcn_s_barrier()
#define MG_SCHED __builtin_amdgcn_sched_barrier(0)
    Unit cur, nxt; int ui = 0;
    if (!S.next(0, cur)) return;
    f32x4 acc[2][2][4][2];
#pragma unroll
    for (int a = 0; a < 2; ++a)
#pragma unroll
        for (int b = 0; b < 2; ++b)
#pragma unroll
            for (int m = 0; m < 4; ++m)
#pragma unroll
                for (int n = 0; n < 2; ++n) acc[a][b][m][n] = (f32x4){0.f, 0.f, 0.f, 0.f};
    bf16x8 At[4][2], B0[2][2], B1[2][2];
    unsigned cvo0[2], cvo1[2], nvo0[2], nvo1[2];
    S.a_voff(cur, cvo0, cvo1);
    const char* cA = cur.a; const char* cB = cur.b;
    MG_STAGE(MG_SB(0, 0), cB, voffB); MG_STAGE(MG_SA(0, 0), cA, cvo0); MG_STAGE(MG_SB(0, 1), cB + hstep, voffB); MG_STAGE(MG_SA(0, 1), cA, cvo1);
    if (wr == 1) MG_BAR;
    MG_WAIT_V(4); MG_BAR;
    MG_STAGE(MG_SB(1, 0), cB + kstep, voffB); MG_STAGE(MG_SA(1, 0), cA + kstep, cvo0); MG_STAGE(MG_SB(1, 1), cB + hstep + kstep, voffB);
    MG_WAIT_V(6); MG_BAR;
    for (;;) {
        const bool has_next = S.next(ui + 1, nxt);
        const char* nA = has_next ? nxt.a : cA; const char* nB = has_next ? nxt.b : cB;
        if (has_next) S.a_voff(nxt, nvo0, nvo1); else { nvo0[0] = cvo0[0]; nvo0[1] = cvo0[1]; nvo1[0] = cvo1[0]; nvo1[1] = cvo1[1]; }
        for (int t = 0; t < nt; t += 2) {
            const bool last = (t == nt - 2);
            const char* a1 = cA + (size_t)(t + 1) * kstep;
            const char* a2 = last ? nA : cA + (size_t)(t + 2) * kstep; const char* b2 = last ? nB : cB + (size_t)(t + 2) * kstep;
            const char* a3 = a2 + kstep; const char* b3 = b2 + kstep;
            MG_LDB(B0, 0, 0); MG_SCHED; MG_LDA(At, 0, 0); MG_STAGE(MG_SA(1, 1), a1, cvo1);
            if (last) { cvo0[0] = nvo0[0]; cvo0[1] = nvo0[1]; cvo1[0] = nvo1[0]; cvo1[1] = nvo1[1]; }
            MG_WAIT_L(8); MG_BAR; MG_WAIT_L(0); MG_MMA(0, 0, At, B0); MG_BAR; MG_SCHED;
            MG_LDB(B1, 0, 1); MG_STAGE(MG_SB(0, 0), b2, voffB);
            MG_BAR; MG_WAIT_L(0); MG_MMA(0, 1, At, B1); MG_BAR;
            MG_LDA(At, 0, 1); MG_STAGE(MG_SA(0, 0), a2, cvo0);
            MG_BAR; MG_WAIT_L(0); if (!cur.half) MG_MMA(1, 0, At, B0); MG_BAR; MG_SCHED;
            MG_STAGE(MG_SB(0, 1), b2 + hstep, voffB);
            MG_WAIT_V(6); MG_BAR; if (!cur.half) MG_MMA(1, 1, At, B1); MG_BAR;
            MG_LDB(B0, 1, 0); MG_SCHED; MG_LDA(At, 1, 0); MG_STAGE(MG_SA(0, 1), a2, cvo1);
            MG_WAIT_L(8); MG_BAR; MG_WAIT_L(0); MG_MMA(0, 0, At, B0); MG_BAR; MG_SCHED;
            MG_LDB(B1, 1, 1); MG_STAGE(MG_SB(1, 0), b3, voffB);
            MG_BAR; MG_WAIT_L(0); MG_MMA(0, 1, At, B1); MG_BAR;
            MG_LDA(At, 1, 1); MG_STAGE(MG_SA(1, 0), a3, cvo0);
            MG_BAR; MG_WAIT_L(0); if (!cur.half) MG_MMA(1, 0, At, B0); MG_BAR; MG_SCHED;
            MG_STAGE(MG_SB(1, 1), b3 + hstep, voffB);
            MG_WAIT_V(6); MG_BAR; if (!cur.half) MG_MMA(1, 1, At, B1); MG_BAR;
        }
        {
            int tz = threadIdx.x; asm volatile("" : "+v"(tz));
            const int wz = __builtin_amdgcn_readfirstlane(tz >> 6), lz = tz & 63;
            if constexpr (!Epi::AFTER) E(acc, cur, wz >> 2, wz & 3, lz & 15, lz >> 4); }
        if (!has_next) break;
#pragma unroll
        for (int a = 0; a < 2; ++a)
#pragma unroll
            for (int b = 0; b < 2; ++b)
#pragma unroll
                for (int m = 0; m < 4; ++m)
#pragma unroll
                    for (int n = 0; n < 2; ++n) acc[a][b][m][n] = (f32x4){0.f, 0.f, 0.f, 0.f};
        cur = nxt; cA = nA; cB = nB; ++ui;
    }
    MG_WAIT_V(0);
    if (wr == 0) MG_BAR;
    MG_BAR;
    if constexpr (Epi::AFTER) {
        int tz = threadIdx.x; asm volatile("" : "+v"(tz));
        const int wz = __builtin_amdgcn_readfirstlane(tz >> 6), lz = tz & 63;
        E.after(acc, cur, wz >> 2, wz & 3, lz & 15, lz >> 4, lds, lz);
    }
#undef MG_SA
#undef MG_SB
#undef MG_STAGE
#undef MG_LDA
#undef MG_LDB
#undef MG_MMA
#undef MG_WAIT_V
#undef MG_WAIT_L
#undef MG_BAR
#undef MG_SCHED
}

struct MoeSched {
    int tsv, cntv;
    const int* list;
    const LAS int* ent;
    const char* A;
    const char* Bt;
    int ntn, G, c, K;
    __device__ __forceinline__ bool next(int i, Unit& u) const {
        const int L = i * G + c, ntm = __builtin_amdgcn_readlane(tsv, NE);
        if (L >= ntm * ntn) return false;
        int tz = threadIdx.x; asm volatile("" : "+v"(tz)); const int lane = tz & 63;
        const int tnext = __builtin_amdgcn_ds_bpermute(((lane + 1) & 63) << 2, tsv);
        const int e = __builtin_popcountll(__ballot(lane < NE && tnext * ntn <= L));
        const int ts = __builtin_amdgcn_readlane(tsv, e), te = __builtin_amdgcn_readlane(tsv, e + 1);
        const int r = L - ts * ntn, mtl = r / ntn, pn = r - mtl * ntn;
        u.pm = ts + mtl; u.pn = pn; u.e = e; u.p0 = mtl * 256; u.cnt = __builtin_amdgcn_readlane(cntv, e); u.idx = i; u.half = 0;
        u.a = list ? A : A + (size_t)u.pm * 256 * K;
        u.b = Bt + ((size_t)(e * ntn + pn) * 256) * K;
        return true;
    }
    __device__ __forceinline__ void a_voff(const Unit& u, unsigned (&v0)[2], unsigned (&v1)[2]) const {
        int tz = threadIdx.x; asm volatile("" : "+v"(tz));
#pragma unroll
        for (int i = 0; i < 2; ++i) {
            int R, C; stage_rc(tz * 16 + i * 8192, R, C);
            if (list) {
                const LAS int* et = ent + u.idx * 256;
                v0[i] = (unsigned)((et[R] >> 2) * K + C * 2); v1[i] = (unsigned)((et[128 + R] >> 2) * K + C * 2);
            } else { v0[i] = (unsigned)(R * K + C * 2); v1[i] = (unsigned)((128 + R) * K + C * 2); }
        }
    }
};

struct DenseSched {
    const char* A; const char* Bt; int nM, nN, G, c, K;
    __device__ __forceinline__ bool next(int i, Unit& u) const {
        const int nwg = nM * nN; int L, hf = 0;
        if (i == 0) { L = c; if (L >= nwg) return false; }
        else if (i == 1) { const int rem = nwg - G; if (rem <= 0 || c >= 2 * rem) return false; L = G + (c >> 1); hf = 1 + (c & 1); }
        else return false;
        int wgid = L; { const int q = nwg / 8, r = nwg % 8, xcd = wgid % 8, off = wgid / 8; wgid = (xcd < r ? xcd * (q + 1) : r * (q + 1) + (xcd - r) * q) + off; }
        const int nig = 8 * nN, gid = wgid / nig, fm = gid * 8, gsz = (nM - fm) < 8 ? (nM - fm) : 8;
        u.pm = fm + ((wgid % nig) % gsz); u.pn = (wgid % nig) / gsz; u.e = 0; u.p0 = 0; u.cnt = 0; u.idx = i; u.half = hf;
        u.a = A + ((size_t)u.pm * 256 + (hf == 2 ? 128 : 0)) * K; u.b = Bt + (size_t)u.pn * 256 * K;
        return true;
    }
    __device__ __forceinline__ void a_voff(const Unit& u, unsigned (&v0)[2], unsigned (&v1)[2]) const {
        int tz = threadIdx.x; asm volatile("" : "+v"(tz));
#pragma unroll
        for (int i = 0; i < 2; ++i) { int R, C; stage_rc(tz * 16 + i * 8192, R, C); v0[i] = (unsigned)(R * K + C * 2); v1[i] = u.half ? v0[i] : (unsigned)((128 + R) * K + C * 2); }
    }
};
struct EpiF32 {
    static constexpr bool PERM = false, AFTER = false;
    float* Cm; int ldc;
    __device__ __forceinline__ void operator()(const f32x4 (&acc)[2][2][4][2], const Unit& u, int wr, int wc, int fr, int fq) const {
        const int row0 = u.pm * BM + (u.half == 2 ? HALF : 0) + wr * 64 + fr, col0 = u.pn * BM + wc * 32 + 4 * fq;
#pragma unroll
        for (int ai = 0; ai < 2; ++ai) { if (ai == 1 && u.half) continue;
#pragma unroll
            for (int m = 0; m < 4; ++m) { float* rowp = Cm + (size_t)(row0 + ai * HALF + m * 16) * ldc + col0;
#pragma unroll
                for (int bj = 0; bj < 2; ++bj)
#pragma unroll
                    for (int n = 0; n < 2; ++n) *(f32x4*)(rowp + bj * HALF + n * 16) = acc[ai][bj][m][n]; } }
    }
};
struct EpiBf16 {
    static constexpr bool PERM = true, AFTER = false;
    unsigned short* Cm; int ldc;
    __device__ __forceinline__ void operator()(const f32x4 (&acc)[2][2][4][2], const Unit& u, int wr, int wc, int fr, int fq) const {
        const int row0 = u.pm * BM + (u.half == 2 ? HALF : 0) + wr * 64 + fr, col0 = u.pn * BM + wc * 32 + 8 * fq;
#pragma unroll
        for (int ai = 0; ai < 2; ++ai) { if (ai == 1 && u.half) continue;
#pragma unroll
            for (int m = 0; m < 4; ++m) { unsigned short* rowp = Cm + (size_t)(row0 + ai * HALF + m * 16) * ldc + col0;
#pragma unroll
                for (int bj = 0; bj < 2; ++bj) { const f32x4 v0 = acc[ai][bj][m][0], v1 = acc[ai][bj][m][1];
                    u32x4 w; w.x = pk_bf16(v0[0], v0[1]); w.y = pk_bf16(v0[2], v0[3]); w.z = pk_bf16(v1[0], v1[1]); w.w = pk_bf16(v1[2], v1[3]);
                    *(u32x4*)(rowp + bj * HALF) = w; } } }
    }
};
struct EpiResid {
    static constexpr bool PERM = false, AFTER = false;
    float* X; const float* gate_l; float gs; const float* in_lat; const float* in_ctx;
    __device__ __forceinline__ void operator()(const f32x4 (&acc)[2][2][4][2], const Unit& u, int wr, int wc, int fr, int fq) const {
        const int row0 = u.pm * BM + (u.half == 2 ? HALF : 0) + wr * 64 + fr, col0 = u.pn * BM + wc * 32 + 4 * fq;
        const float* gp = gate_l + (size_t)(u.pm < TL / 256 ? (u.pm >> 3) : 8) * 6144 + col0;
        const float* src = in_lat ? (u.pm < TL / 256 ? in_lat : in_ctx - (size_t)TL * D) : X;
        f32x4 gv[2][2];
#pragma unroll
        for (int bj = 0; bj < 2; ++bj)
#pragma unroll
            for (int n = 0; n < 2; ++n) gv[bj][n] = *(const f32x4*)(gp + bj * HALF + n * 16);
#pragma unroll
        for (int ai = 0; ai < 2; ++ai) { if (ai == 1 && u.half) continue;
            f32x4 rv[4][2][2];
#pragma unroll
            for (int m = 0; m < 4; ++m) { const size_t ro = (size_t)(row0 + ai * HALF + m * 16) * D + col0;
#pragma unroll
                for (int bj = 0; bj < 2; ++bj)
#pragma unroll
                    for (int n = 0; n < 2; ++n) rv[m][bj][n] = *(const f32x4*)(src + ro + bj * HALF + n * 16); }
            __builtin_amdgcn_sched_barrier(0);
#pragma unroll
            for (int m = 0; m < 4; ++m) { const size_t ro = (size_t)(row0 + ai * HALF + m * 16) * D + col0;
#pragma unroll
                for (int bj = 0; bj < 2; ++bj)
#pragma unroll
                    for (int n = 0; n < 2; ++n) *(f32x4*)(X + ro + bj * HALF + n * 16) = rv[m][bj][n] + gv[bj][n] * acc[ai][bj][m][n] * gs; }
            __builtin_amdgcn_sched_barrier(0); }
    }
};
struct EpiGluNorm {
    static constexpr bool PERM = false, AFTER = true;
    unsigned short* Out; const unsigned short* Gm; const float* bias; const float* onw;
    __device__ __forceinline__ void operator()(const f32x4 (&)[2][2][4][2], const Unit&, int, int, int, int) const {}
    __device__ __forceinline__ void after(f32x4 (&acc)[2][2][4][2], const Unit& u, int wr, int wc, int fr, int fq, LAS unsigned char* lds, int lane) const {
        const int row0 = u.pm * BM + wr * 64 + fr, col0 = wc * 32 + 4 * fq;
        LAS float* ps = (LAS float*)lds;
        f32x4 bv[2][2];
#pragma unroll
        for (int bj = 0; bj < 2; ++bj)
#pragma unroll
            for (int n = 0; n < 2; ++n) bv[bj][n] = *(const f32x4*)(bias + col0 + bj * HALF + n * 16);
#pragma unroll
        for (int ai = 0; ai < 2; ++ai) {
            uint2 gqv[4][2][2];
#pragma unroll
            for (int m = 0; m < 4; ++m) { const size_t ro = (size_t)(row0 + ai * HALF + m * 16) * 256 + col0;
#pragma unroll
                for (int bj = 0; bj < 2; ++bj)
#pragma unroll
                    for (int n = 0; n < 2; ++n) gqv[m][bj][n] = *(const uint2*)(Gm + ro + bj * HALF + n * 16); }
            __builtin_amdgcn_sched_barrier(0);
#pragma unroll
            for (int m = 0; m < 4; ++m) { float p = 0.f;
#pragma unroll
                for (int bj = 0; bj < 2; ++bj)
#pragma unroll
                    for (int n = 0; n < 2; ++n) { const f32x4 z = acc[ai][bj][m][n] + bv[bj][n]; const uint2 gq = gqv[m][bj][n];
                        const f32x4 g = (f32x4){__uint_as_float(gq.x << 16), __uint_as_float(gq.x & 0xffff0000u), __uint_as_float(gq.y << 16), __uint_as_float(gq.y & 0xffff0000u)}; f32x4 o;
#pragma unroll
                        for (int i = 0; i < 4; ++i) { o[i] = g[i] * __builtin_amdgcn_rcpf(1.f + __builtin_amdgcn_exp2f(-1.44269504f * z[i])); p += o[i] * o[i]; }
                        acc[ai][bj][m][n] = o; }
                p += shx_(p, 16, lane); p += shx_(p, 32, lane);
                if (fq == 0) ps[(ai * HALF + wr * 64 + m * 16 + fr) * 4 + wc] = p; } }
        __syncthreads();
        f32x4 wv[2][2];
#pragma unroll
        for (int bj = 0; bj < 2; ++bj)
#pragma unroll
            for (int n = 0; n < 2; ++n) wv[bj][n] = *(const f32x4*)(onw + col0 + bj * HALF + n * 16);
#pragma unroll
        for (int ai = 0; ai < 2; ++ai)
#pragma unroll
            for (int m = 0; m < 4; ++m) { const int rl = ai * HALF + wr * 64 + m * 16 + fr;
                const f32x4 q = *(const LAS f32x4*)(ps + rl * 4);
                const float rs = rsqrtf((q[0] + q[1] + q[2] + q[3]) * (1.f / 256.f) + EPS);
                unsigned short* rowp = Out + (size_t)(u.pm * BM + rl) * D + 512 + col0;
#pragma unroll
                for (int bj = 0; bj < 2; ++bj)
#pragma unroll
                    for (int n = 0; n < 2; ++n) { const f32x4 o = acc[ai][bj][m][n], w = wv[bj][n];
                        *(uint2*)(rowp + bj * HALF + n * 16) = make_uint2(pk_bf16(o[0] * rs * w[0], o[1] * rs * w[1]), pk_bf16(o[2] * rs * w[2], o[3] * rs * w[3])); } }
    }
};
struct EpiSwiglu {
    static constexpr bool PERM = true, AFTER = false;
    unsigned char* act; const LAS float* btab;
    __device__ __forceinline__ void operator()(const f32x4 (&acc)[2][2][4][2], const Unit& u, int wr, int wc, int fr, int fq) const {
        const int j = u.pn * 128 + wc * 32 + 8 * fq;
        const LAS float* bg = btab + u.idx * 256 + wc * 32 + 8 * fq;
        const f32x4 g0 = *(const LAS f32x4*)(bg), g1 = *(const LAS f32x4*)(bg + 4), u0 = *(const LAS f32x4*)(bg + 128), u1 = *(const LAS f32x4*)(bg + 132);
#pragma unroll
        for (int ai = 0; ai < 2; ++ai)
#pragma unroll
            for (int m = 0; m < 4; ++m) {
                const int rl = ai * 128 + wr * 64 + m * 16 + fr;
                float o[8];
#pragma unroll
                for (int n = 0; n < 2; ++n)
#pragma unroll
                    for (int i = 0; i < 4; ++i) {
                        float gt = acc[ai][0][m][n][i] + (n ? g1[i] : g0[i]), up = acc[ai][1][m][n][i] + (n ? u1[i] : u0[i]);
                        gt = fminf(gt, 7.f); up = fminf(fmaxf(up, -7.f), 7.f);
                        o[n * 4 + i] = (up + 1.f) * (gt * __builtin_amdgcn_rcpf(1.f + __builtin_amdgcn_exp2f(-2.45546696f * gt)));
                    }
                int p0 = __builtin_amdgcn_cvt_pk_fp8_f32(o[0], o[1], 0, false); p0 = __builtin_amdgcn_cvt_pk_fp8_f32(o[2], o[3], p0, true);
                int p1 = __builtin_amdgcn_cvt_pk_fp8_f32(o[4], o[5], 0, false); p1 = __builtin_amdgcn_cvt_pk_fp8_f32(o[6], o[7], p1, true);
                *(uint2*)(act + ((size_t)u.pm * 256 + rl) * D + j) = make_uint2((unsigned)p0, (unsigned)p1);
            }
    }
};
struct EpiDown {
    static constexpr bool PERM = true, AFTER = false;
    bf16_t* yb; const LAS float* btab; const LAS int* ent;
    __device__ __forceinline__ void operator()(const f32x4 (&acc)[2][2][4][2], const Unit& u, int wr, int wc, int fr, int fq) const {
        const int c0 = u.pn * 256 + wc * 32 + 8 * fq;
        const LAS float* bd = btab + u.idx * 256 + wc * 32 + 8 * fq;
        f32x4 bv[2][2];
#pragma unroll
        for (int bj = 0; bj < 2; ++bj)
#pragma unroll
            for (int n = 0; n < 2; ++n) bv[bj][n] = *(const LAS f32x4*)(bd + bj * 128 + 4 * n);
        const LAS int* et = ent + u.idx * 256;
#pragma unroll
        for (int ai = 0; ai < 2; ++ai)
#pragma unroll
            for (int m = 0; m < 4; ++m) {
                const int rl = ai * 128 + wr * 64 + m * 16 + fr;
                if (u.p0 + rl < u.cnt) {
                    unsigned char* rowp = (unsigned char*)yb + (size_t)et[rl] * D + c0;
#pragma unroll
                    for (int bj = 0; bj < 2; ++bj) {
                        const f32x4 v0 = acc[ai][bj][m][0] + bv[bj][0], v1 = acc[ai][bj][m][1] + bv[bj][1];
                        int p0 = __builtin_amdgcn_cvt_pk_fp8_f32(clamp448(v0[0]), clamp448(v0[1]), 0, false); p0 = __builtin_amdgcn_cvt_pk_fp8_f32(clamp448(v0[2]), clamp448(v0[3]), p0, true);
                        int p1 = __builtin_amdgcn_cvt_pk_fp8_f32(clamp448(v1[0]), clamp448(v1[1]), 0, false); p1 = __builtin_amdgcn_cvt_pk_fp8_f32(clamp448(v1[2]), clamp448(v1[3]), p1, true);
                        *(uint2*)(rowp + bj * 128) = make_uint2((unsigned)p0, (unsigned)p1);
                    }
                }
            }
    }
};
}

template <class RF>
__device__ __forceinline__ void transpose_cvt_tile(float* sm, const int tid, const float* src, int ldn, int k0, int n0, unsigned short* dst, int ldk, RF dst_row) {
    float (*T)[129] = (float (*)[129])sm;
    __syncthreads();
#pragma unroll
    for (int i = 0; i < 4; ++i) {
        const int kk = (tid >> 4) + 32 * i, cc = (tid & 15) * 4;
        const float4 v = *(const float4*)(src + (size_t)(k0 + kk) * ldn + n0 + cc);
        T[cc][kk] = v.x; T[cc + 1][kk] = v.y; T[cc + 2][kk] = v.z; T[cc + 3][kk] = v.w;
    }
    __syncthreads();
#pragma unroll
    for (int i = 0; i < 2; ++i) {
        const int n = (tid >> 4) + 32 * i, kk = (tid & 15) * 8;
        mg::u32x4 w;
        w.x = mg::cvt_pk_bf16(T[n][kk], T[n][kk + 1]); w.y = mg::cvt_pk_bf16(T[n][kk + 2], T[n][kk + 3]);
        w.z = mg::cvt_pk_bf16(T[n][kk + 4], T[n][kk + 5]); w.w = mg::cvt_pk_bf16(T[n][kk + 6], T[n][kk + 7]);
        *(mg::u32x4*)(dst + (size_t)dst_row(n0 + n) * ldk + k0 + kk) = w;
    }
}
__device__ __forceinline__ mg::f32x4 bf4_f32(uint2 p) { return (mg::f32x4){__uint_as_float(p.x << 16), __uint_as_float(p.x & 0xffff0000u), __uint_as_float(p.y << 16), __uint_as_float(p.y & 0xffff0000u)}; }
__device__ __forceinline__ float bf2f(unsigned short b) { return __uint_as_float(((unsigned)b) << 16); }


struct SsmFrags { mg::bf16x8 bfr[2][2][2]; mg::bf16x8 cf[2][4]; float a0r, a0i, a1r, a1i, dch; };
template <bool READOUT>
__device__ __forceinline__ void ssm_load_frags(SsmFrags& F, const int lane, const int g, const float* DISCp, const float* cre, const float* cim, const float* ssmd) {
    const int j = lane & 31, h = lane >> 5;
    float4 rlo[2][2][2], rhi[2][2][2];
#pragma unroll
    for (int part = 0; part < 2; ++part)
#pragma unroll
        for (int nh = 0; nh < 2; ++nh)
#pragma unroll
            for (int sx = 0; sx < 2; ++sx) {
                const float* p = DISCp + 4096 + part * 32768 + (size_t)(((sx * 16 + g) * 64 + nh * 32 + j) * 16) + 8 * h;
                rlo[part][nh][sx] = ((const float4*)p)[0]; rhi[part][nh][sx] = ((const float4*)p)[1];
            }
    __builtin_amdgcn_sched_barrier(0);
#pragma unroll
    for (int part = 0; part < 2; ++part)
#pragma unroll
        for (int nh = 0; nh < 2; ++nh)
#pragma unroll
            for (int sx = 0; sx < 2; ++sx) {
                const float4 lo = rlo[part][nh][sx], hi = rhi[part][nh][sx];
                mg::u32x4 w; w.x = pk_bf16(lo.x, lo.y); w.y = pk_bf16(lo.z, lo.w); w.z = pk_bf16(hi.x, hi.y); w.w = pk_bf16(hi.z, hi.w);
                F.bfr[part][nh][sx] = __builtin_bit_cast(mg::bf16x8, w);
            }
    const int di0 = (h * 16 + g) * 64 + j;
    F.a0r = DISCp[di0]; F.a0i = DISCp[2048 + di0]; F.a1r = DISCp[di0 + 32]; F.a1i = DISCp[2048 + di0 + 32];
    F.dch = 0.f;
#pragma unroll
    for (int d = 0; d < 2; ++d)
#pragma unroll
        for (int kk = 0; kk < 4; ++kk) F.cf[d][kk] = (mg::bf16x8){0, 0, 0, 0, 0, 0, 0, 0};
    if (READOUT) {
        const int pcol = lane & 15, quad = lane >> 4;
        float4 c4v[2][4], d4v[2][4];
#pragma unroll
        for (int d = 0; d < 2; ++d)
#pragma unroll
            for (int kk = 0; kk < 4; ++kk) {
                c4v[d][kk] = *(const float4*)(cre + ((size_t)(d * 16 + g) * 16 + pcol) * 64 + kk * 16 + quad * 4);
                d4v[d][kk] = *(const float4*)(cim + ((size_t)(d * 16 + g) * 16 + pcol) * 64 + kk * 16 + quad * 4);
            }
        F.dch = ssmd[g * 16 + pcol];
        __builtin_amdgcn_sched_barrier(0);
#pragma unroll
        for (int d = 0; d < 2; ++d)
#pragma unroll
            for (int kk = 0; kk < 4; ++kk) {
                const float4 c4 = c4v[d][kk], d4 = d4v[d][kk];
                mg::u32x4 w; w.x = pk_bf16(c4.x, -d4.x); w.y = pk_bf16(c4.y, -d4.y); w.z = pk_bf16(c4.z, -d4.z); w.w = pk_bf16(c4.w, -d4.w);
                F.cf[d][kk] = __builtin_bit_cast(mg::bf16x8, w);
            }
    }
}
template <bool READOUT>
__device__ __forceinline__ void ssm_chunk(LAS unsigned char* wl, const int lane, const int b, const int ck, const int g, const unsigned short* PXp, const SsmFrags& F, float2* EBp,
                                          float* Gp, unsigned short* GBp) {
    typedef short s16x2 __attribute__((ext_vector_type(2)));
    const int j = lane & 31, h = lane >> 5;
    LAS float* Uc = (LAS float*)wl; LAS unsigned char* Sl = wl + 4096;
    const int row0 = ck < 4 ? TL + b * CTXL + ck * 64 : b * SEQ + (ck - 4) * 64;
    {   const uint4* up = (const uint4*)(PXp + (size_t)(row0 + lane) * INW + 768 + g * 16); const uint4 q0 = up[0], q1 = up[1];
        LAS mg::f32x4* ud = (LAS mg::f32x4*)(Uc + lane * 16);
        ud[0] = bf4_f32(make_uint2(q0.x, q0.y)); ud[1] = bf4_f32(make_uint2(q0.z, q0.w)); ud[2] = bf4_f32(make_uint2(q1.x, q1.y)); ud[3] = bf4_f32(make_uint2(q1.z, q1.w)); }
    const float a0r = F.a0r, a0i = F.a0i, a1r = F.a1r, a1i = F.a1i;
    const int kh = h ? (ck < 4 ? 3 - ck : 39 - ck) : ck;
    float s0r = 0.f, s0i = 0.f, s1r = 0.f, s1i = 0.f;
    mg::f32x4 yacc[4];
    if (READOUT) {
        float p0r = a0r, p0i = a0i, p1r = a1r, p1i = a1i;
#pragma unroll
        for (int q = 0; q < 6; ++q) { const float t0 = p0r * p0r - p0i * p0i, u0 = 2.f * p0r * p0i, t1 = p1r * p1r - p1i * p1i, u1 = 2.f * p1r * p1i; p0r = t0; p0i = u0; p1r = t1; p1i = u1; }
        const float2* ep = EBp + ((size_t)((b * 2 + h) * 16 + g) * 36) * 64 + j;
        const int kf = ck, kb = ck < 4 ? 3 - ck : 39 - ck, kmax = kf > kb ? kf : kb;
        for (int kp0 = 0; kp0 < kmax; kp0 += 4) {
            float2 e0[4], e1[4];
#pragma unroll
            for (int q = 0; q < 4; ++q) { const int kq = max(min(kp0 + q, kh - 1), 0); e0[q] = ep[(size_t)kq * 64]; e1[q] = ep[(size_t)kq * 64 + 32]; }
#pragma unroll
            for (int q = 0; q < 4; ++q) if (kp0 + q < kh) {
                const float n0r = p0r * s0r - p0i * s0i + e0[q].x, n0i = p0r * s0i + p0i * s0r + e0[q].y; s0r = n0r; s0i = n0i;
                const float n1r = p1r * s1r - p1i * s1i + e1[q].x, n1i = p1r * s1i + p1i * s1r + e1[q].y; s1r = n1r; s1i = n1i; }
        }
#pragma unroll
        for (int t = 0; t < 4; ++t) yacc[t] = (mg::f32x4){0.f, 0.f, 0.f, 0.f};
    }
    const int dir_i = (j >> 2) & 1, r_i = (j & 3) + 4 * (j >> 3);
    f32x16 zero16;
#pragma unroll
    for (int i = 0; i < 16; ++i) zero16[i] = 0.f;
#pragma unroll
    for (int blk = 0; blk < 4; ++blk) {
        __builtin_amdgcn_sched_barrier(0);
        const int tok = dir_i ? (3 - blk) * 16 + 15 - r_i : blk * 16 + r_i;
        const LAS mg::f32x4* up = (const LAS mg::f32x4*)(Uc + tok * 16 + 8 * h);
        asm volatile("" : "+v"(up) : "v"(s0r), "v"(s1r));
        const mg::f32x4 u0 = up[0], u1 = up[1];
        mg::u32x4 uw; uw.x = pk_bf16(u0[0], u0[1]); uw.y = pk_bf16(u0[2], u0[3]); uw.z = pk_bf16(u1[0], u1[1]); uw.w = pk_bf16(u1[2], u1[3]);
        const mg::u32x4 zw = (mg::u32x4){0u, 0u, 0u, 0u};
        const mg::bf16x8 af0 = __builtin_bit_cast(mg::bf16x8, dir_i == 0 ? uw : zw), af1 = __builtin_bit_cast(mg::bf16x8, dir_i == 1 ? uw : zw);
#pragma unroll
        for (int nh = 0; nh < 2; ++nh) {
            f32x16 Xr = __builtin_amdgcn_mfma_f32_32x32x16_bf16(af0, F.bfr[0][nh][0], zero16, 0, 0, 0);
            Xr = __builtin_amdgcn_mfma_f32_32x32x16_bf16(af1, F.bfr[0][nh][1], Xr, 0, 0, 0);
            f32x16 Xi = __builtin_amdgcn_mfma_f32_32x32x16_bf16(af0, F.bfr[1][nh][0], zero16, 0, 0, 0);
            Xi = __builtin_amdgcn_mfma_f32_32x32x16_bf16(af1, F.bfr[1][nh][1], Xi, 0, 0, 0);
            float sr = nh ? s1r : s0r, si = nh ? s1i : s0i;
            const float ar = nh ? a1r : a0r, ai = nh ? a1i : a0i;
            LAS unsigned char* sp = Sl + h * 4352 + (h ? 15 * 272 : 0) + (nh * 32 + j) * 4;
            asm volatile("" : "+v"(sp));
            const int sstep = h ? -272 : 272;
#pragma unroll
            for (int r = 0; r < 16; ++r) {
                float tr = __builtin_fmaf(ar, sr, Xr[r]), ti = __builtin_fmaf(ar, si, Xi[r]);
                asm volatile("" : "+v"(tr), "+v"(ti));
                const float nr = __builtin_fmaf(-ai, si, tr), ni = __builtin_fmaf(ai, sr, ti);
                sr = nr; si = ni;
                if (READOUT) { *(LAS s16x2*)sp = __builtin_bit_cast(s16x2, pk_bf16(sr, si)); sp += sstep; }
            }
            if (nh) { s1r = sr; s1i = si; } else { s0r = sr; s0i = si; }
        }
        if (READOUT) {
            const int pcol = lane & 15, quad = lane >> 4;
#pragma unroll
            for (int kk = 0; kk < 4; ++kk) {
                const mg::bf16x8 afw = *(const LAS mg::bf16x8*)(Sl + pcol * 272 + kk * 64 + quad * 16);
                const mg::bf16x8 abw = *(const LAS mg::bf16x8*)(Sl + 4352 + pcol * 272 + kk * 64 + quad * 16);
                yacc[blk] = __builtin_amdgcn_mfma_f32_16x16x32_bf16(afw, F.cf[0][kk], yacc[blk], 0, 0, 0);
                yacc[3 - blk] = __builtin_amdgcn_mfma_f32_16x16x32_bf16(abw, F.cf[1][kk], yacc[3 - blk], 0, 0, 0);
            }
        }
    }
    if (READOUT) {
        const int pcol = lane & 15, quad = lane >> 4, c = g * 16 + pcol;
        const float dch = F.dch;
#pragma unroll
        for (int tb = 0; tb < 4; ++tb)
#pragma unroll
            for (int jj = 0; jj < 4; ++jj) {
                const int tt = tb * 16 + quad * 4 + jj;
                const float y = yacc[tb][jj] + dch * Uc[tt * 16 + pcol];
                const float gy = gelu_tanh_f(y);
                const size_t idx = (size_t)(row0 + tt) * 256 + c;
                GBp[idx] = bf16_1(gy);
            }
    } else {
        float2* eo = EBp + ((size_t)((b * 2 + h) * 16 + g) * 36 + kh) * 64 + j;
        eo[0] = make_float2(s0r, s0i); eo[32] = make_float2(s1r, s1i);
    }
}

__global__ void __launch_bounds__(NT, 2) fwd(Args args) {
    extern __shared__ __attribute__((aligned(16))) unsigned char lds[];
    float* smem = (float*)lds;
    LAS unsigned char* ldsl = (LAS unsigned char*)lds;
    LAS unsigned* misc = (LAS unsigned*)(ldsl + MISC_OFF);
    const int bid = blockIdx.x, nb = gridDim.x;
    const int nwaves = nb * (NT / 64), gthreads = nb * NT;
#define PH_IDS int tid = threadIdx.x; asm volatile("" : "+v"(tid)); const int lane = tid & 63, wave = tid >> 6, gw = wave * nb + bid, gtid = bid * NT + tid; (void)lane; (void)wave; (void)gw; (void)gtid; \
    kaptr_t ka = (kaptr_t)__builtin_amdgcn_kernarg_segment_ptr(); asm volatile("" : "+s"(ka)); unsigned char* const ws = KA_LOAD(unsigned char*, 264); (void)ws
    unsigned* ctl = (unsigned*)(args.ws + WS_CTL);
    typedef const unsigned char __attribute__((address_space(4)))* kaptr_t;
#define KA_LOAD(T, off) (*(T const __attribute__((address_space(4)))*)(ka + (off)))
#define INP(i) KA_LOAD(const float*, 8 * (i))
#define OUTP KA_LOAD(float*, 256)
#define MOD ((float*)(ws + WS_MOD))
#define ROPEC ((float*)(ws + WS_ROPE))
#define ROPES (ROPEC + 2048 * 64)
#define DISC ((float*)(ws + WS_DISC))
#define XS ((float*)(ws + WS_XS))
#define H ((float*)(ws + WS_H))
#define PX ((unsigned short*)(ws + WS_PX))
#define QN ((float*)(ws + WS_QN))
#define KN ((float*)(ws + WS_KN))
#define ATT ((float*)(ws + WS_ATT))
#define DLT ((float*)(ws + WS_DLT))
#define G ((float*)(ws + WS_G))
#define SO ((float*)(ws + WS_SO))
#define MRG ((float*)(ws + WS_MRG))
#define ST ((float2*)(ws + WS_ST))
#define TOPI ((int*)(ws + WS_TOPI))
#define GATE ((float*)(ws + WS_GATE))
#define LIST ((int*)(ws + WS_LIST))
#define WGUT ((unsigned short*)(ws + WS_WGUT))
#define WDNT ((unsigned short*)(ws + WS_WDNT))
#define H2B ((unsigned short*)(ws + WS_H2B))
#define ACTB ((unsigned short*)(ws + WS_ACTB))
#define YBB ((unsigned short*)(ws + WS_YBB))
#define WINT ((unsigned short*)(ws + WS_WINT))
#define WOUTT ((unsigned short*)(ws + WS_WOUTT))
#define GLUT ((unsigned short*)(ws + WS_GLUT))
#define HB ((unsigned short*)(ws + WS_HB))
#define EB ((float2*)(ws + WS_EB))
#define QNB ((unsigned short*)(ws + WS_QNB))
#define KNB ((unsigned short*)(ws + WS_KNB))
#define VTB ((unsigned short*)(ws + WS_VTB))
#define VTCB ((unsigned short*)(ws + WS_VTCB))
#define MRGB ((unsigned short*)(ws + WS_MRGB))
#define GB ((unsigned short*)(ws + WS_GB))
#define PWT ((unsigned short*)(ws + WS_PWT))
#define modl (MOD + (size_t)l * 9 * 6144)
#define counts (((unsigned*)(ws + WS_CTL)) + CW_CNT + l * NE * 32)
    if (threadIdx.x < 4) misc[threadIdx.x] = 0u;
    __syncthreads();
    XcdBarrier bar = xcd_barrier_post(ctl + CW_BAR, (volatile LAS unsigned*)misc);
    const int lo = args.ph_lo, hi = args.ph_hi;
    int ph = 0;
#if defined(TPROBE)
    unsigned long long tp_acc = 0ull, tp_t0 = 0ull; const unsigned long long tp_beg = __builtin_amdgcn_s_memrealtime();
#define TP0 tp_t0 = __builtin_amdgcn_s_memrealtime();
#define TP1 tp_acc += __builtin_amdgcn_s_memrealtime() - tp_t0;
#else
#define TP0
#define TP1
#endif
#define IN_PH() (lo <= ph && ph < hi)
#ifndef REPMASK
#define REPMASK 0
#endif
#define RUN_PH(idx) for (int _rep = 0; _rep < 1 + ((REPMASK >> (idx)) & 1); ++_rep)
#define SEAM() do { if (lo <= ph && ph + 1 < hi) xcd_barrier(bar); ++ph; } while (0)

#define CVT_GROUP(IT0) do { const int it0 = (IT0); \
            const float* srcp[3]; unsigned char* dstp[3]; int ldn_[3], k0_[3], n0_[3], gu_[3]; \
            float4 tv[3][4]; \
            _Pragma("unroll") \
            for (int j = 0; j < 3; ++j) { \
                const int it = min(it0 + j, DEPTH * NE * 384 - 1), le = it / 384, r = it % 384; \
                if (r < 256) { srcp[j] = INP(I_WGU) + (size_t)le * D * 2048; dstp[j] = (unsigned char*)WGUT + (size_t)le * 2048 * D; ldn_[j] = 2048; k0_[j] = (r >> 5) * 128; n0_[j] = (r & 31) * 64; gu_[j] = 1; } \
                else { const int r2 = r - 256; srcp[j] = INP(I_WDN) + (size_t)le * D * D; dstp[j] = (unsigned char*)WDNT + (size_t)le * D * D; ldn_[j] = D; k0_[j] = (r2 >> 4) * 128; n0_[j] = (r2 & 15) * 64; gu_[j] = 0; } \
            _Pragma("unroll") \
                for (int i = 0; i < 4; ++i) tv[j][i] = *(const float4*)(srcp[j] + (size_t)(k0_[j] + (tid >> 4) + 32 * i) * ldn_[j] + n0_[j] + (tid & 15) * 4); \
            } \
            __syncthreads(); \
            _Pragma("unroll") \
            for (int j = 0; j < 3; ++j) { float (*T)[129] = (float (*)[129])(smem + j * 64 * 129); \
            _Pragma("unroll") \
                for (int i = 0; i < 4; ++i) { const int kk = (tid >> 4) + 32 * i, cc = (tid & 15) * 4; T[cc][kk] = tv[j][i].x; T[cc + 1][kk] = tv[j][i].y; T[cc + 2][kk] = tv[j][i].z; T[cc + 3][kk] = tv[j][i].w; } } \
            __syncthreads(); \
            _Pragma("unroll") \
            for (int j = 0; j < 3; ++j) { if (it0 + j < DEPTH * NE * 384) { float (*T)[129] = (float (*)[129])(smem + j * 64 * 129); \
            _Pragma("unroll") \
                for (int i = 0; i < 2; ++i) { \
                    const int n = (tid >> 4) + 32 * i, kk = (tid & 15) * 8, ng = n0_[j] + n; \
                    const int drow = gu_[j] ? (((ng & 1023) >> 7) * 256 + (ng >> 10) * 128 + (ng & 127)) : ng; \
                    int q0 = __builtin_amdgcn_cvt_pk_fp8_f32(clamp448(T[n][kk] * 64.f), clamp448(T[n][kk + 1] * 64.f), 0, false); q0 = __builtin_amdgcn_cvt_pk_fp8_f32(clamp448(T[n][kk + 2] * 64.f), clamp448(T[n][kk + 3] * 64.f), q0, true); \
                    int q1 = __builtin_amdgcn_cvt_pk_fp8_f32(clamp448(T[n][kk + 4] * 64.f), clamp448(T[n][kk + 5] * 64.f), 0, false); q1 = __builtin_amdgcn_cvt_pk_fp8_f32(clamp448(T[n][kk + 6] * 64.f), clamp448(T[n][kk + 7] * 64.f), q1, true); \
                    *(uint2*)(dstp[j] + (size_t)drow * D + k0_[j] + kk) = make_uint2((unsigned)q0, (unsigned)q1); \
                } } } \
        } while (0)
#define CVT_JOBS(LYR, MAXJOBS) do { for (int nj_ = 0; nj_ < (MAXJOBS); ++nj_) { __syncthreads(); \
            if (tid == 0) misc[200] = atomicAdd(((unsigned*)(ws + WS_CTL)) + CW_CVT + 32 * (LYR), 1u); __syncthreads(); \
            const unsigned job_ = misc[200]; if (job_ >= (unsigned)(NE * 128)) break; CVT_GROUP((LYR) * NE * 384 + (int)job_ * 3); } __syncthreads(); } while (0)

    RUN_PH(0) if (IN_PH()) { PH_IDS;
        for (int i = gtid; i < 2048 * 64; i += gthreads) {
            const int t = i >> 6, d = i & 63, f = d & 15, axis = d >> 5;
            const float pos = axis == 0 ? (float)(t >> 6) : (float)(t & 63);
            const float inv = powf(10000.f, -(float)(2 * f) / 32.f);
            const float ang = pos * inv;
            ROPEC[i] = cosf(ang); ROPES[i] = sinf(ang);
        }
        for (int i = gtid; i < DEPTH * 4 * 64 * 64; i += gthreads) { const int cc = i & 63, dd = (i >> 6) & 63, lg4 = i >> 12; PWT[i] = bf16_1(INP(I_POOLW)[((size_t)lg4 * 64 + cc) * 64 + dd]); }
        CVT_JOBS(0, 6);
        for (int it = bid; it < DEPTH * (160 + 128 + 8); it += nb) {
            const int l = it / 296, r = it % 296;
            if (r < 160) { const int kt = r / 20, ntl = r % 20;
                transpose_cvt_tile(smem, tid, INP(I_WIN) + (size_t)l * D * INW, INW, kt * 128, ntl * 64, WINT + (size_t)l * INW * D, D, [](int n) { return n; });
            } else if (r < 288) { const int r2 = r - 160, kt = r2 >> 4, ntl = r2 & 15;
                transpose_cvt_tile(smem, tid, INP(I_WOUT) + (size_t)l * D * D, D, kt * 128, ntl * 64, WOUTT + (size_t)l * D * D, D, [](int n) { return n; });
            } else { const int r2 = r - 288, kt = r2 >> 2, ntl = r2 & 3;
                transpose_cvt_tile(smem, tid, INP(I_GLUW) + (size_t)l * 256 * 256, 256, kt * 128, ntl * 64, GLUT + (size_t)l * 256 * 256, 256, [](int n) { return n; }); }
        }
        __syncthreads();
        for (int i = tid; i < 9 * 1024; i += NT) { const float v = i < 8192 ? INP(I_C)[i] : INP(I_CCTX)[i - 8192]; smem[i] = silu_f(v); }
        __syncthreads();
        for (int it = bid; it < DEPTH * 96; it += nb) {
            const int l = it / 96, j = (it % 96) * 64 + lane;
            const float* w = INP(I_WMOD) + (size_t)l * D * 6144 + j;
            float acc[9];
#pragma unroll
            for (int m = 0; m < 9; ++m) acc[m] = 0.f;
            for (int k = wave * 128; k < wave * 128 + 128; ++k) {
                const float wv = w[(size_t)k * 6144];
#pragma unroll
                for (int m = 0; m < 9; ++m) acc[m] += smem[m * 1024 + k] * wv;
            }
            float* pb = smem + 9 * 1024;
#pragma unroll
            for (int m = 0; m < 9; ++m) pb[(wave * 9 + m) * 64 + lane] = acc[m];
            __syncthreads();
            if (wave == 0) {
                const float bias = INP(I_BMOD)[(size_t)l * 6144 + j];
#pragma unroll
                for (int m = 0; m < 9; ++m) { float s = 0.f;
#pragma unroll
                    for (int w8 = 0; w8 < 8; ++w8) s += pb[(w8 * 9 + m) * 64 + lane];
                    MOD[((size_t)l * 9 + m) * 6144 + j] = s + bias; }
            }
            __syncthreads();
        }
    }
    SEAM();

    for (int l = 0; l < DEPTH; ++l) {
        const int nrows_moe = (l == DEPTH - 1) ? TL : TA;
        const int nrows_mix = (l == DEPTH - 1) ? TL : TA;

        RUN_PH(1) if (IN_PH()) { PH_IDS;
            const float* n1w = INP(I_N1W) + l * D;
            const int r0 = (bid * (NT / 64) + wave) * 9;
            float4 cw[4], shv[4], g2v[4], xn[4]; unsigned yn[4][4]; float gkn[4];
#pragma unroll
            for (int i = 0; i < 4; ++i) { cw[i] = make_float4(0.f, 0.f, 0.f, 0.f); shv[i] = cw[i]; g2v[i] = cw[i]; gkn[i] = 0.f;
#pragma unroll
                for (int k = 0; k < 4; ++k) yn[k][i] = 0u; }
#define A_LOAD(ROW) do { const float4* xr_ = (const float4*)(l > 0 ? XS + (size_t)(ROW) * D : ((ROW) < TL ? INP(I_X) + (size_t)(ROW) * D : INP(I_CTX) + (size_t)((ROW) - TL) * D)); \
                _Pragma("unroll") for (int i = 0; i < 4; ++i) xn[i] = xr_[lane + i * 64]; \
                if (l > 0) { _Pragma("unroll") for (int k = 0; k < 4; ++k) { gkn[k] = GATE[(ROW) * 4 + k]; \
                    _Pragma("unroll") for (int i = 0; i < 4; ++i) yn[k][i] = ((const unsigned*)((const unsigned char*)YBB + ((size_t)(ROW) * 4 + k) * D))[lane + i * 64]; } } } while (0)
            A_LOAD(r0);
            int cur_mr = -1;
            for (int kr = 0; kr < 9; ++kr) {
                const int row = r0 + kr, mr = mrow_of(row);
                float4 v[4]; unsigned y[4][4]; float gk[4];
#pragma unroll
                for (int i = 0; i < 4; ++i) v[i] = xn[i];
#pragma unroll
                for (int k = 0; k < 4; ++k) { gk[k] = gkn[k];
#pragma unroll
                    for (int i = 0; i < 4; ++i) y[k][i] = yn[k][i]; }
                { const int rn = kr + 1 < 9 ? row + 1 : row; A_LOAD(rn); }
                if (mr != cur_mr) {
                    const float4* sh = (const float4*)(modl + (size_t)mr * 6144), *sc = (const float4*)(modl + (size_t)mr * 6144 + D);
                    const float4* g2 = (const float4*)(MOD + ((size_t)(l > 0 ? l - 1 : 0) * 9 + mr) * 6144 + 5 * D);
#pragma unroll
                    for (int i = 0; i < 4; ++i) { const float4 w4 = ((const float4*)n1w)[lane + i * 64], c4 = sc[lane + i * 64];
                        cw[i] = make_float4(w4.x * (1.f + c4.x), w4.y * (1.f + c4.y), w4.z * (1.f + c4.z), w4.w * (1.f + c4.w)); shv[i] = sh[lane + i * 64]; g2v[i] = g2[lane + i * 64]; }
                    cur_mr = mr;
                }
                __builtin_amdgcn_sched_barrier(0);
                if (l > 0) {
                    const float cs = _rep ? 0.f : 1.f;
                    float4* xr = (float4*)(XS + (size_t)row * D);
#pragma unroll
                    for (int i = 0; i < 4; ++i) {
                        float4 sacc = make_float4(0.f, 0.f, 0.f, 0.f);
#pragma unroll
                        for (int k = 0; k < 4; ++k) { const f32x2_t ylo = __builtin_amdgcn_cvt_pk_f32_fp8((int)y[k][i], false), yhi = __builtin_amdgcn_cvt_pk_f32_fp8((int)y[k][i], true);
                            sacc.x += gk[k] * ylo[0]; sacc.y += gk[k] * ylo[1]; sacc.z += gk[k] * yhi[0]; sacc.w += gk[k] * yhi[1]; }
                        v[i].x += cs * g2v[i].x * sacc.x; v[i].y += cs * g2v[i].y * sacc.y; v[i].z += cs * g2v[i].z * sacc.z; v[i].w += cs * g2v[i].w * sacc.w;
                        xr[lane + i * 64] = v[i];
                    }
                }
                float ss = 0.f;
#pragma unroll
                for (int i = 0; i < 4; ++i) ss += v[i].x * v[i].x + v[i].y * v[i].y + v[i].z * v[i].z + v[i].w * v[i].w;
                ss = wave_sum(ss);
                const float rstd = rsqrtf(ss * (1.f / D) + EPS);
                uint2* hr = (uint2*)(HB + (size_t)row * D);
#pragma unroll
                for (int i = 0; i < 4; ++i)
                    hr[lane + i * 64] = make_uint2(pk_bf16(v[i].x * rstd * cw[i].x + shv[i].x, v[i].y * rstd * cw[i].y + shv[i].y), pk_bf16(v[i].z * rstd * cw[i].z + shv[i].z, v[i].w * rstd * cw[i].w + shv[i].w));
            }
#undef A_LOAD
            for (int i = gtid; i < 2048; i += gthreads) {
                const int dg = i >> 6;
                const size_t pbase = (size_t)l * 2048 + i;
                const float are = INP(I_ARE)[pbase], aim = INP(I_AIM)[pbase];
                const float dt = expf(INP(I_LOGDT)[l * 32 + dg]);
                const float mag = expf(are * dt), ar = mag * cosf(aim * dt), ai = mag * sinf(aim * dt);
                const float den = are * are + aim * aim;
                const float qr = ((ar - 1.0f) * are + ai * aim) / den, qi = (ai * are - (ar - 1.0f) * aim) / den;
                DISC[i] = ar; DISC[2048 + i] = ai;
                const float* br = INP(I_BRE) + pbase * 16; const float* bi = INP(I_BIM) + pbase * 16;
                float4 brv[4], biv[4];
#pragma unroll
                for (int p4 = 0; p4 < 4; ++p4) { brv[p4] = ((const float4*)br)[p4]; biv[p4] = ((const float4*)bi)[p4]; }
#pragma unroll
                for (int p4 = 0; p4 < 4; ++p4) {
                    ((float4*)(DISC + 4096 + i * 16))[p4] = make_float4(qr * brv[p4].x - qi * biv[p4].x, qr * brv[p4].y - qi * biv[p4].y, qr * brv[p4].z - qi * biv[p4].z, qr * brv[p4].w - qi * biv[p4].w);
                    ((float4*)(DISC + 4096 + 32768 + i * 16))[p4] = make_float4(qr * biv[p4].x + qi * brv[p4].x, qr * biv[p4].y + qi * brv[p4].y, qr * biv[p4].z + qi * brv[p4].z, qr * biv[p4].w + qi * brv[p4].w);
                }
            }
        }
        SEAM();

        RUN_PH(2) if (IN_PH()) { PH_IDS;
            mg::DenseSched S{(const char*)HB, (const char*)(WINT + (size_t)l * INW * D), TA / 256, INW / 256, nb, bid, 2 * D};
            mg::EpiBf16 E{PX, INW};
            mg::gemm_phase(ldsl, 2 * D, S, E);
            if (_rep == 0 && bid >= 2 * ((TA / 256) * (INW / 256) - nb)) CVT_JOBS(l, 3);
        }
        SEAM();

        RUN_PH(3) if (IN_PH()) { PH_IDS;
            {
                SsmFrags SF; const int g = gw & 15;
                ssm_load_frags<false>(SF, lane, g, DISC, nullptr, nullptr, nullptr);
                for (int p = gw >> 4; p < NBATCH * 36; p += nwaves >> 4) ssm_chunk<false>(ldsl + wave * 12800, lane, p / 36, p % 36, g, PX, SF, EB, nullptr, nullptr);
            }
            {   const int li = lane & 15, hsub = lane >> 4;
                const float4 nwq = *(const float4*)(INP(I_QNW) + l * 64 + li * 4), nwk = *(const float4*)(INP(I_KNW) + l * 64 + li * 4);
                for (int row = gw; row < TA; row += nwaves) {
                    uint2 pv[3];
#pragma unroll
                    for (int pass = 0; pass < 3; ++pass) pv[pass] = *(const uint2*)(PX + (size_t)row * INW + min(pass * 4 + hsub, 9) * 64 + li * 4);
                    const int tpos = row < TL ? (row & (SEQ - 1)) : 0;
                    const float4 c = *(const float4*)(ROPEC + tpos * 64 + li * 4), sn = *(const float4*)(ROPES + tpos * 64 + li * 4);
                    __builtin_amdgcn_sched_barrier(0);
#pragma unroll
                    for (int pass = 0; pass < 3; ++pass) {
                        const int hh = pass * 4 + hsub;
                        if (hh < 10) {
                            const mg::f32x4 v = bf4_f32(pv[pass]);
                            float ss = v[0] * v[0] + v[1] * v[1] + v[2] * v[2] + v[3] * v[3];
                            ss += DPPF(ss, 0xB1); ss += DPPF(ss, 0x4E); ss += DPPF(ss, 0x141); ss += DPPF(ss, 0x140);
                            const float rs = rsqrtf(ss * (1.f / 64.f) + EPS);
                            const float4 nw = hh < 8 ? nwq : nwk;
                            float y0 = v[0] * rs * nw.x, y1 = v[1] * rs * nw.y, y2 = v[2] * rs * nw.z, y3 = v[3] * rs * nw.w;
                            if (row < TL) {
                                const float p0 = SHX(y0, 4), p1 = SHX(y1, 4), p2 = SHX(y2, 4), p3 = SHX(y3, 4);
                                const float sg = ((li >> 2) & 1) ? 1.f : -1.f;
                                y0 = y0 * c.x + sg * p0 * sn.x; y1 = y1 * c.y + sg * p1 * sn.y; y2 = y2 * c.z + sg * p2 * sn.z; y3 = y3 * c.w + sg * p3 * sn.w;
                            }
                            if (hh < 8) *(uint2*)(QNB + (size_t)row * 512 + hh * 64 + li * 4) = make_uint2(pk_bf16(y0 * 0.18033688f, y1 * 0.18033688f), pk_bf16(y2 * 0.18033688f, y3 * 0.18033688f));
                            else {
                                const int kvh = hh - 8, ks = li >> 2, hfk = (li >> 1) & 1, j0 = (li & 1) * 4;
                                unsigned short* kb;
                                if (row < TL) { const int b = row >> 11, t = row & (SEQ - 1); kb = KNB + ((size_t)((b * 2 + kvh) * (SEQ / 32) + (t >> 5))) * 2048 + (size_t)(((ks * 2 + hfk) * 32 + (t & 31)) * 8 + j0); }
                                else { const int q = row - TL, b = q >> 8, cc = q & (CTXL - 1); kb = KNB + (size_t)TL * 128 + ((size_t)((b * 2 + kvh) * (CTXL / 32) + (cc >> 5))) * 2048 + (size_t)(((ks * 2 + hfk) * 32 + (cc & 31)) * 8 + j0); }
                                *(uint2*)kb = make_uint2(pk_bf16(y0, y1), pk_bf16(y2, y3));
                            }
                        }
                    }
                }
            }
            for (int it = gw; it < (TA / 64) * 2; it += nwaves) {
                const int rb = it >> 1, kvh = it & 1, row = rb * 64 + lane;
                const uint4* vp = (const uint4*)(PX + (size_t)row * INW + 640 + kvh * 64);
                unsigned short* dst; int kk;
                if (rb < TL / 64) { const int b = rb >> 5, t = (rb & 31) * 64 + lane; dst = VTB + ((size_t)((b * 2 + kvh) * (SEQ / 32) + (t >> 5))) * 2048; kk = t & 31; }
                else { const int q = rb - TL / 64, b = q >> 2, c = (q & 3) * 64 + lane; dst = VTCB + ((size_t)((b * 2 + kvh) * (CTXL / 32) + (c >> 5))) * 2048; kk = c & 31; }
                const int sxv = kk >> 4, hfv = (kk >> 2) & 1, jv = ((kk >> 3) & 1) * 4 + (kk & 3);
                dst += (size_t)(sxv * 512 + hfv * 8 + jv);
                uint4 vrow[8];
#pragma unroll
                for (int i = 0; i < 8; ++i) vrow[i] = vp[i];
                __builtin_amdgcn_sched_barrier(0);
#pragma unroll
                for (int i = 0; i < 8; ++i) { const uint4 x = vrow[i];
#pragma unroll
                    for (int c = 0; c < 8; ++c) { const int d = 8 * i + c, dt = d >> 5, rr = d & 31; const unsigned wv = (c >> 1) == 0 ? x.x : (c >> 1) == 1 ? x.y : (c >> 1) == 2 ? x.z : x.w;
                        dst[(dt * 64 + rr) * 16] = (unsigned short)((c & 1) ? (wv >> 16) : (wv & 0xffffu)); } }
            }
        }
        SEAM();

        RUN_PH(4) if (IN_PH()) { PH_IDS;
            for (int it = bid * (NT / 64) + wave, arnd = 0; it < (nrows_mix / 32) * 8; it += nwaves, ++arnd) {
                const int h = it & 7, qb = it >> 3, kvh = h >> 2;
                const bool lat = qb < TL / 32;
                const int b = lat ? (qb >> 6) : ((qb - TL / 32) >> 3);
                const int t0 = lat ? ((qb & 63) * 32) : 0;
                const int r = lane & 31, hf = lane >> 5;
                const int qrow = qb * 32 + r;
                mg::bf16x8 qf[4];
#pragma unroll
                for (int ks = 0; ks < 4; ++ks) qf[ks] = *(const mg::bf16x8*)(QNB + (size_t)qrow * 512 + h * 64 + ks * 16 + hf * 8);
                f32x16 o0, o1;
#pragma unroll
                for (int i = 0; i < 16; ++i) { o0[i] = 0.f; o1[i] = 0.f; }
                float lsum = hf == 0 ? __expf(INP(I_SINK)[l * 8 + h] - 8.f) : 0.f;
                const int kt_lo = lat ? max(0, (128 - t0) >> 5) : 9, kt_hi = lat ? min(8, (SEQ + 96 - t0) >> 5) : 8;
#define ATT_LOAD(KT, KF, VLO, VHI) do { const unsigned short* kbase_; const unsigned short* vbase_; \
                    if ((KT) < 9) { const int kti = (t0 - 128 + (KT) * 32) >> 5; kbase_ = KNB + ((size_t)((b * 2 + kvh) * (SEQ / 32) + kti)) * 2048; vbase_ = VTB + ((size_t)((b * 2 + kvh) * (SEQ / 32) + kti)) * 2048; } \
                    else { kbase_ = KNB + (size_t)TL * 128 + ((size_t)((b * 2 + kvh) * (CTXL / 32) + (KT) - 9)) * 2048; vbase_ = VTCB + ((size_t)((b * 2 + kvh) * (CTXL / 32) + (KT) - 9)) * 2048; } \
                    _Pragma("unroll") for (int ks = 0; ks < 4; ++ks) KF[ks] = *(const mg::bf16x8*)(kbase_ + ((ks * 2 + hf) * 32 + r) * 8); \
                    _Pragma("unroll") for (int dt = 0; dt < 2; ++dt) _Pragma("unroll") for (int sx = 0; sx < 2; ++sx) { const uint4 vv = *(const uint4*)(vbase_ + (((dt * 2 + sx) * 32 + r) * 2 + hf) * 8); \
                        VLO[dt][sx] = make_uint2(vv.x, vv.y); VHI[dt][sx] = make_uint2(vv.z, vv.w); } } while (0)
#define ATT_COMPUTE(KT, KF, VLO, VHI) do { \
                    f32x16 x; \
                    _Pragma("unroll") for (int i = 0; i < 16; ++i) x[i] = -11.5415603f; \
                    _Pragma("unroll") for (int ks = 0; ks < 4; ++ks) x = __builtin_amdgcn_mfma_f32_32x32x16_bf16(KF[ks], qf[ks], x, 0, 0, 0); \
                    if ((KT) == 0 || (KT) == 8) { \
                        _Pragma("unroll") for (int i = 0; i < 16; ++i) { const int key = (i & 3) + 8 * (i >> 2) + 4 * hf; const bool ok = (KT) == 0 ? key >= r : key <= r; x[i] = ok ? x[i] : -INFINITY; } } \
                    float ps = 0.f; \
                    _Pragma("unroll") for (int i = 0; i < 16; ++i) { x[i] = __builtin_amdgcn_exp2f(x[i]); ps += x[i]; } \
                    lsum += ps; \
                    mg::bf16x8 pf[2]; \
                    _Pragma("unroll") for (int sx = 0; sx < 2; ++sx) { mg::u32x4 w; w.x = pk_bf16(x[8 * sx], x[8 * sx + 1]); w.y = pk_bf16(x[8 * sx + 2], x[8 * sx + 3]); w.z = pk_bf16(x[8 * sx + 4], x[8 * sx + 5]); w.w = pk_bf16(x[8 * sx + 6], x[8 * sx + 7]); pf[sx] = __builtin_bit_cast(mg::bf16x8, w); } \
                    _Pragma("unroll") for (int sx = 0; sx < 2; ++sx) { \
                        mg::u32x4 w0; w0.x = VLO[0][sx].x; w0.y = VLO[0][sx].y; w0.z = VHI[0][sx].x; w0.w = VHI[0][sx].y; \
                        mg::u32x4 w1; w1.x = VLO[1][sx].x; w1.y = VLO[1][sx].y; w1.z = VHI[1][sx].x; w1.w = VHI[1][sx].y; \
                        o0 = __builtin_amdgcn_mfma_f32_32x32x16_bf16(__builtin_bit_cast(mg::bf16x8, w0), pf[sx], o0, 0, 0, 0); \
                        o1 = __builtin_amdgcn_mfma_f32_32x32x16_bf16(__builtin_bit_cast(mg::bf16x8, w1), pf[sx], o1, 0, 0, 0); } } while (0)
                const int nloc = lat ? kt_hi - kt_lo + 1 : 0, ntot = nloc + 8;
#define ATT_KT(J) ((J) < nloc ? kt_lo + (J) : 9 + (J) - nloc)
                mg::bf16x8 kfA[4], kfB[4]; uint2 vloA[2][2], vhiA[2][2], vloB[2][2], vhiB[2][2];
                { const int kt0 = ATT_KT(0); ATT_LOAD(kt0, kfA, vloA, vhiA); }
                for (int jt = 0; jt + 1 < ntot; jt += 2) {
                    const int ktA = ATT_KT(jt), ktB = ATT_KT(jt + 1), ktN = ATT_KT(min(jt + 2, ntot - 1));
                    ATT_LOAD(ktB, kfB, vloB, vhiB);
                    ATT_COMPUTE(ktA, kfA, vloA, vhiA);
                    ATT_LOAD(ktN, kfA, vloA, vhiA);
                    ATT_COMPUTE(ktB, kfB, vloB, vhiB);
                }
                if (ntot & 1) { const int ktL = ATT_KT(ntot - 1); ATT_COMPUTE(ktL, kfA, vloA, vhiA); }
#undef ATT_KT
#undef ATT_COMPUTE
#undef ATT_LOAD
                lsum += SHX(lsum, 32);
                const float inv = 1.f / lsum;
                float ssq = 0.f;
#pragma unroll
                for (int i = 0; i < 16; ++i) ssq += o0[i] * o0[i] + o1[i] * o1[i];
                ssq *= inv * inv; ssq += SHX(ssq, 32);
                LAS float* xs = (LAS float*)(misc + 256) + (arnd & 1) * 256;
                if (hf == 0) xs[h * 32 + r] = ssq;
                __syncthreads();
                float tot = 0.f;
#pragma unroll
                for (int hh = 0; hh < 8; ++hh) tot += xs[hh * 32 + r];
                const float sc = rsqrtf(tot * (1.f / 512.f) + EPS) * inv;
                const float* onw = INP(I_ONW) + l * 768 + h * 64 + 4 * hf;
                unsigned short* mp = MRGB + (size_t)qrow * D + h * 64 + 4 * hf;
                float4 w0v[4], w1v[4];
#pragma unroll
                for (int gi = 0; gi < 4; ++gi) { w0v[gi] = *(const float4*)(onw + 8 * gi); w1v[gi] = *(const float4*)(onw + 32 + 8 * gi); }
                __builtin_amdgcn_sched_barrier(0);
#pragma unroll
                for (int gi = 0; gi < 4; ++gi) {
                    const float4 w0 = w0v[gi], w1 = w1v[gi];
                    *(uint2*)(mp + 8 * gi) = make_uint2(pk_bf16(o0[4 * gi] * sc * w0.x, o0[4 * gi + 1] * sc * w0.y), pk_bf16(o0[4 * gi + 2] * sc * w0.z, o0[4 * gi + 3] * sc * w0.w));
                    *(uint2*)(mp + 32 + 8 * gi) = make_uint2(pk_bf16(o1[4 * gi] * sc * w1.x, o1[4 * gi + 1] * sc * w1.y), pk_bf16(o1[4 * gi + 2] * sc * w1.z, o1[4 * gi + 3] * sc * w1.w));
                }
            }
            {   SsmFrags SF; const int g = gw & 15;
                ssm_load_frags<true>(SF, lane, g, DISC, INP(I_CRE) + (size_t)l * 2 * 16 * 16 * 64, INP(I_CIM) + (size_t)l * 2 * 16 * 16 * 64, INP(I_SSMD) + l * 256);
                for (int p = gw >> 4; p < NBATCH * 36; p += nwaves >> 4) { if (l == DEPTH - 1 && (p % 36) < 4) continue; ssm_chunk<true>(ldsl + wave * 12800, lane, p / 36, p % 36, g, PX, SF, EB, G, GB); }
            }
            for (int it = gw; it < (nrows_mix / 16) * 4; it += nwaves) {
                const int g4 = it & 3, rb = it >> 2, rl = lane & 15, quad = lane >> 4, hw = 1 << g4;
                const int row = rb * 16 + rl;
                int base, t, L;
                if (row < TL) { base = row & ~(SEQ - 1); t = row & (SEQ - 1); L = SEQ; } else { const int q = row - TL; base = TL + (q & ~(CTXL - 1)); t = q & (CTXL - 1); L = CTXL; }
                const int tb0 = (t - rl) - hw;
                LAS float* Pw = (LAS float*)(ldsl + wave * 12800);
                {
                    mg::f32x4 tmp[8];
#pragma unroll
                    for (int i = 0; i < 8; ++i) { const int lr = (lane >> 4) + 4 * i, c4 = lane & 15; const int tp = min(max(tb0 + lr, 0), L - 1);
                        tmp[i] = bf4_f32(*(const uint2*)(PX + (size_t)(base + tp) * INW + 1024 + g4 * 64 + c4 * 4)); }
#pragma unroll
                    for (int i = 0; i < 8; ++i) { const int lr = (lane >> 4) + 4 * i, c4 = lane & 15; *(LAS mg::f32x4*)(Pw + lr * 64 + c4 * 4) = tmp[i]; }
                }
                const int tlo = max(t - hw, 0), thi = min(t + hw, L);
                const float inv = 1.f / (float)(thi - tlo);
                mg::bf16x8 df[2];
#pragma unroll
                for (int kk = 0; kk < 2; ++kk) {
                    const int ch = kk * 32 + quad * 8;
                    mg::f32x4 s0 = (mg::f32x4){0.f, 0.f, 0.f, 0.f}, s1 = s0;
                    for (int tt = tlo; tt < thi; ++tt) { const LAS mg::f32x4* pp = (const LAS mg::f32x4*)(Pw + (tt - tb0) * 64 + ch); s0 += pp[0]; s1 += pp[1]; }
                    const LAS mg::f32x4* po = (const LAS mg::f32x4*)(Pw + (t - tb0) * 64 + ch); const mg::f32x4 o0 = po[0], o1 = po[1];
                    mg::u32x4 w; w.x = pk_bf16(s0[0] * inv - o0[0], s0[1] * inv - o0[1]); w.y = pk_bf16(s0[2] * inv - o0[2], s0[3] * inv - o0[3]);
                    w.z = pk_bf16(s1[0] * inv - o1[0], s1[1] * inv - o1[1]); w.w = pk_bf16(s1[2] * inv - o1[2], s1[3] * inv - o1[3]);
                    df[kk] = __builtin_bit_cast(mg::bf16x8, w);
                }
                const unsigned short* pwt = PWT + ((size_t)l * 4 + g4) * 64 * 64;
                const float* psc = INP(I_POOLS) + l * 256 + g4 * 64;
                mg::bf16x8 afv[4][2]; float4 scv4[4];
#pragma unroll
                for (int nt = 0; nt < 4; ++nt) { scv4[nt] = *(const float4*)(psc + nt * 16 + quad * 4);
#pragma unroll
                    for (int kk = 0; kk < 2; ++kk) afv[nt][kk] = *(const mg::bf16x8*)(pwt + (size_t)(nt * 16 + rl) * 64 + kk * 32 + quad * 8); }
                __builtin_amdgcn_sched_barrier(0);
#pragma unroll
                for (int nt = 0; nt < 4; ++nt) {
                    mg::f32x4 acc = (mg::f32x4){0.f, 0.f, 0.f, 0.f};
#pragma unroll
                    for (int kk = 0; kk < 2; ++kk) acc = __builtin_amdgcn_mfma_f32_16x16x32_bf16(afv[nt][kk], df[kk], acc, 0, 0, 0);
                    const int dd = nt * 16 + quad * 4;
                    const float4 sc4 = scv4[nt];
                    *(uint2*)(MRGB + (size_t)row * D + 768 + g4 * 64 + dd) = make_uint2(pk_bf16(acc[0] * sc4.x, acc[1] * sc4.y), pk_bf16(acc[2] * sc4.z, acc[3] * sc4.w));
                }
            }
        }
        SEAM();

        RUN_PH(5) if (IN_PH()) { PH_IDS;
            mg::DenseSched S{(const char*)GB, (const char*)(GLUT + (size_t)l * 256 * 256), nrows_mix / 256, 1, nb, bid, 512};
            mg::EpiGluNorm E{MRGB, GB, INP(I_GLUB) + l * 256, INP(I_ONW) + l * 768 + 512};
            mg::gemm_phase(ldsl, 512, S, E);
            if (_rep == 0 && bid >= nrows_mix / 256) CVT_JOBS(l, 4);
        }
        SEAM();

        RUN_PH(6) if (IN_PH()) { PH_IDS;
            mg::DenseSched S{(const char*)MRGB, (const char*)(WOUTT + (size_t)l * D * D), nrows_mix / 256, D / 256, nb, bid, 2 * D};
            mg::EpiResid E{XS, modl + 2 * D, _rep ? 0.f : 1.f, l == 0 ? INP(I_X) : nullptr, l == 0 ? INP(I_CTX) : nullptr};
            mg::gemm_phase(ldsl, 2 * D, S, E);
            if (_rep == 0 && bid >= 2 * ((nrows_mix / 256) * (D / 256) - nb)) CVT_JOBS(l, 1 << 20);
        }
        SEAM();

        RUN_PH(7) if (IN_PH()) { PH_IDS;
            const float* n2w = INP(I_N2W) + l * D; const float* rw = INP(I_RW) + (size_t)l * D * NE; const float* rb = INP(I_RB) + l * NE;
            LAS float* Wl = (LAS float*)ldsl;
            __syncthreads();
            {   mg::f32x4 wtmp[16];
#pragma unroll
                for (int q = 0; q < 16; ++q) wtmp[q] = ((const mg::f32x4*)rw)[tid + q * NT];
#pragma unroll
                for (int q = 0; q < 16; ++q) { const int i = tid + q * NT, c = i >> 3, e4 = i & 7; *(LAS mg::f32x4*)(Wl + c * 32 + ((e4 ^ ((c >> 1) & 7)) << 2)) = wtmp[q]; } }
            __syncthreads();
            const int swz = (lane >> 1) & 7;
            const int RPW = nrows_moe >> 11;
            const int r0 = (bid * (NT / 64) + wave) * RPW;
            float cw[16], shv[16];
#pragma unroll
            for (int m = 0; m < 16; ++m) { cw[m] = 0.f; shv[m] = 0.f; }
            int cur_mr = -1, my_e = 0, my_row = 0; float my_g = 0.f;
#define OPQ2(A, B) asm volatile("" : "+v"(A), "+v"(B))
#define H_FINISH(LG, ROW, KIDX) do { \
                float a16[16], a8[8], a4[4], a2[2]; \
                {   const bool hi = lane & 32; float snd[16], kp[16], rcv[16]; \
                    _Pragma("unroll") for (int j = 0; j < 16; ++j) { float A = LG[j], B = LG[16 + j]; OPQ2(A, B); snd[j] = hi ? A : B; kp[j] = hi ? B : A; } \
                    __builtin_amdgcn_sched_barrier(0); \
                    _Pragma("unroll") for (int j = 0; j < 16; ++j) rcv[j] = SHX(snd[j], 32); \
                    __builtin_amdgcn_sched_barrier(0); \
                    _Pragma("unroll") for (int j = 0; j < 16; ++j) a16[j] = kp[j] + rcv[j]; } \
                {   const bool hi = lane & 16; float snd[8], kp[8], rcv[8]; \
                    _Pragma("unroll") for (int j = 0; j < 8; ++j) { float A = a16[j], B = a16[8 + j]; OPQ2(A, B); snd[j] = hi ? A : B; kp[j] = hi ? B : A; } \
                    __builtin_amdgcn_sched_barrier(0); \
                    _Pragma("unroll") for (int j = 0; j < 8; ++j) rcv[j] = SHX(snd[j], 16); \
                    __builtin_amdgcn_sched_barrier(0); \
                    _Pragma("unroll") for (int j = 0; j < 8; ++j) a8[j] = kp[j] + rcv[j]; } \
                {   const bool hi = lane & 8; \
                    _Pragma("unroll") for (int j = 0; j < 4; ++j) { float A = a8[j], B = a8[4 + j]; OPQ2(A, B); const float send = hi ? A : B, keep = hi ? B : A; a4[j] = keep + DPPF(send, 0x128); } } \
                {   const bool hi = lane & 4; \
                    _Pragma("unroll") for (int j = 0; j < 2; ++j) { float A = a4[j], B = a4[2 + j]; OPQ2(A, B); const float send = hi ? A : B, keep = hi ? B : A; a2[j] = keep + DPPF(send, 0x141); } } \
                float lgt; \
                { const bool hi = lane & 2; float A = a2[0], B = a2[1]; OPQ2(A, B); const float send = hi ? A : B, keep = hi ? B : A; lgt = keep + DPPF(send, 0x4E); } \
                lgt += DPPF(lgt, 0xB1); \
                const int myexp = lane >> 1; \
                lgt += rb[myexp]; \
                float tv[4]; int ti[4]; \
                _Pragma("unroll") for (int q = 0; q < 4; ++q) { \
                    const float mx = wave_max_dpp(lgt); \
                    const unsigned long long bal = __ballot(lgt == mx); \
                    const int wl = __builtin_ctzll(bal); \
                    tv[q] = mx; ti[q] = wl >> 1; \
                    if (myexp == (wl >> 1)) lgt = -INFINITY; } \
                const float e1 = __expf(tv[1] - tv[0]), e2 = __expf(tv[2] - tv[0]), e3 = __expf(tv[3] - tv[0]); \
                const float inv = 1.f / (1.f + e1 + e2 + e3); \
                const float gk[4] = {inv, e1 * inv, e2 * inv, e3 * inv}; \
                _Pragma("unroll") for (int j = 0; j < 4; ++j) if (lane == 4 * (KIDX) + j) { my_e = ti[j]; my_g = gk[j]; my_row = (ROW); } } while (0)
            for (int k = 0; k < RPW;) {
                const bool two = (((r0 + k) & 1) == 0) && (k + 1 < RPW);
                const int rowA = r0 + k, rowB = two ? rowA + 1 : rowA;
                const int mr = mrow_of(rowA);
                float vA[16], vB[16];
#pragma unroll
                for (int m = 0; m < 16; ++m) { vA[m] = XS[(size_t)rowA * D + lane + 64 * m]; vB[m] = XS[(size_t)rowB * D + lane + 64 * m]; }
                if (mr != cur_mr) {
                    const float* sh = modl + (size_t)mr * 6144 + 3 * D; const float* sc = sh + D;
#pragma unroll
                    for (int m = 0; m < 16; ++m) { const int c = lane + 64 * m; cw[m] = n2w[c]; shv[m] = sc[c]; }
                    float sht[16];
#pragma unroll
                    for (int m = 0; m < 16; ++m) sht[m] = sh[lane + 64 * m];
                    __builtin_amdgcn_sched_barrier(0);
#pragma unroll
                    for (int m = 0; m < 16; ++m) { cw[m] = cw[m] * (1.f + shv[m]); shv[m] = sht[m]; }
                    cur_mr = mr;
                }
                __builtin_amdgcn_sched_barrier(0);
                float ssA = 0.f, ssB = 0.f;
#pragma unroll
                for (int m = 0; m < 16; ++m) { ssA += vA[m] * vA[m]; ssB += vB[m] * vB[m]; }
                ssA = wave_sum(ssA); ssB = wave_sum(ssB);
                const float rsA = rsqrtf(ssA * (1.f / D) + EPS), rsB = rsqrtf(ssB * (1.f / D) + EPS);
                unsigned char* hrA = (unsigned char*)H2B + (size_t)rowA * D; unsigned char* hrB = (unsigned char*)H2B + (size_t)rowB * D;
#pragma unroll
                for (int m = 0; m < 16; ++m) {
                    vA[m] = vA[m] * rsA * cw[m] + shv[m]; vB[m] = vB[m] * rsB * cw[m] + shv[m];
                    { const float ca = clamp448(vA[m]); hrA[lane + 64 * m] = (unsigned char)(__builtin_amdgcn_cvt_pk_fp8_f32(ca, ca, 0, false) & 0xff); }
                    { const float cb = clamp448(vB[m]); hrB[lane + 64 * m] = (unsigned char)(__builtin_amdgcn_cvt_pk_fp8_f32(cb, cb, 0, false) & 0xff); }
                }
                float lgA[32], lgB[32];
#pragma unroll
                for (int e = 0; e < 32; ++e) { lgA[e] = 0.f; lgB[e] = 0.f; }
#pragma unroll
                for (int m = 0; m < 16; ++m) {
                    mg::f32x4 wq[8];
#pragma unroll
                    for (int e4 = 0; e4 < 8; ++e4) wq[e4] = *(const LAS mg::f32x4*)(Wl + (lane + 64 * m) * 32 + ((e4 ^ swz) << 2));
                    __builtin_amdgcn_sched_barrier(0);
                    const float oa = vA[m], ob = vB[m];
#pragma unroll
                    for (int e4 = 0; e4 < 8; ++e4) { const mg::f32x4 w = wq[e4];
                        lgA[4 * e4] += oa * w[0]; lgA[4 * e4 + 1] += oa * w[1]; lgA[4 * e4 + 2] += oa * w[2]; lgA[4 * e4 + 3] += oa * w[3];
                        lgB[4 * e4] += ob * w[0]; lgB[4 * e4 + 1] += ob * w[1]; lgB[4 * e4 + 2] += ob * w[2]; lgB[4 * e4 + 3] += ob * w[3]; }
                    __builtin_amdgcn_sched_barrier(0);
                }
                H_FINISH(lgA, rowA, k);
                { const int kb = two ? k + 1 : k; H_FINISH(lgB, rowB, kb); }
                k += two ? 2 : 1;
            }
#undef H_FINISH
            LAS unsigned* lcnt = misc + 128;
            if (tid < 64) lcnt[tid] = 0u;
            __syncthreads();
            const bool has = lane < 4 * RPW && _rep == 0;
            unsigned lpos = 0u;
            if (has) lpos = __hip_atomic_fetch_add(lcnt + my_e, 1u, __ATOMIC_RELAXED, __HIP_MEMORY_SCOPE_WORKGROUP);
            __syncthreads();
            if (tid < NE) { const unsigned n = lcnt[tid]; lcnt[32 + tid] = n ? atomicAdd(&counts[32 * tid], n) : 0u; }
            __syncthreads();
            if (has) {
                const int slot = my_row * 4 + (lane & 3);
                TOPI[slot] = my_e; GATE[slot] = my_g;
                LIST[(size_t)my_e * LISTCAP + lcnt[32 + my_e] + lpos] = slot;
            }
            __syncthreads();
        }
        SEAM();

        RUN_PH(8) if (IN_PH()) { PH_IDS;
            LAS int* tstart = (LAS int*)(misc + 16);
            __syncthreads();
            if (tid == 0) { int acc = 0; for (int e = 0; e < NE; ++e) { const int cn = (int)counts[32 * e]; tstart[e] = acc; tstart[40 + e] = cn; acc += (cn + 255) >> 8; } tstart[NE] = acc; tstart[40 + NE] = 0; }
            __syncthreads();
            const int tsv = tstart[min(lane, NE)], cntv = tstart[40 + min(lane, NE)];
            LAS int* utE = (LAS int*)(ldsl + UT_OFF); LAS float* utB = (LAS float*)(ldsl + UT_OFF + UT_MAX * 1024);
            mg::MoeSched S{tsv, cntv, LIST, utE, (const char*)H2B, (const char*)WGUT + (size_t)l * NE * 2048 * D, 8, nb, bid, D};
            {
                mg::Unit uu; int tv_[UT_MAX];
#pragma unroll
                for (int i = 0; i < UT_MAX; ++i) {
                    const bool ok = S.next(i, uu);
                    const int e_ = ok ? uu.e : 0, p0_ = ok ? uu.p0 : 0, cn_ = ok ? uu.cnt : 1, pn_ = ok ? uu.pn : 0;
                    if (tid < 256) tv_[i] = LIST[(size_t)e_ * LISTCAP + max(min(p0_ + tid, cn_ - 1), 0)];
                    else { const int c = tid - 256; tv_[i] = __float_as_int(INP(I_BGU)[((size_t)l * NE + e_) * 2048 + (c >> 7) * 1024 + pn_ * 128 + (c & 127)]); }
                }
                __builtin_amdgcn_sched_barrier(0);
#pragma unroll
                for (int i = 0; i < UT_MAX; ++i) { if (tid < 256) utE[i * 256 + tid] = tv_[i]; else utB[i * 256 + tid - 256] = __int_as_float(tv_[i]); }
                __syncthreads();
            }
            mg::EpiSwiglu E{(unsigned char*)ACTB, utB};
            mg::gemm_phase<mg::EpiSwiglu, mg::MoeSched, true>(ldsl, D, S, E);
            { const int ntot = tstart[NE] * 8; if (l + 1 < DEPTH && _rep == 0 && (ntot % nb) != 0 && bid >= ntot % nb) CVT_JOBS(l + 1, 3); }
        }
        SEAM();

        RUN_PH(9) if (IN_PH()) { PH_IDS;
            LAS int* tstart = (LAS int*)(misc + 16);
            __syncthreads();
            if (tid == 0) { int acc = 0; for (int e = 0; e < NE; ++e) { const int cn = (int)counts[32 * e]; tstart[e] = acc; tstart[40 + e] = cn; acc += (cn + 255) >> 8; } tstart[NE] = acc; tstart[40 + NE] = 0; }
            __syncthreads();
            const int tsv = tstart[min(lane, NE)], cntv = tstart[40 + min(lane, NE)];
            LAS int* utE = (LAS int*)(ldsl + UT_OFF); LAS float* utB = (LAS float*)(ldsl + UT_OFF + UT_MAX * 1024);
            mg::MoeSched S{tsv, cntv, nullptr, utE, (const char*)ACTB, (const char*)WDNT + (size_t)l * NE * D * D, 4, nb, bid, D};
            {   mg::Unit uu; int tv_[UT_MAX];
#pragma unroll
                for (int i = 0; i < UT_MAX; ++i) {
                    const bool ok = S.next(i, uu);
                    const int e_ = ok ? uu.e : 0, p0_ = ok ? uu.p0 : 0, cn_ = ok ? uu.cnt : 1, pn_ = ok ? uu.pn : 0;
                    if (tid < 256) tv_[i] = LIST[(size_t)e_ * LISTCAP + max(min(p0_ + tid, cn_ - 1), 0)];
                    else { const int c = tid - 256; tv_[i] = __float_as_int(INP(I_BDN)[((size_t)l * NE + e_) * D + pn_ * 256 + c]); }
                }
                __builtin_amdgcn_sched_barrier(0);
#pragma unroll
                for (int i = 0; i < UT_MAX; ++i) { if (tid < 256) utE[i * 256 + tid] = tv_[i]; else utB[i * 256 + tid - 256] = __int_as_float(tv_[i]); }
                __syncthreads();
            }
            mg::EpiDown E{YBB, utB, utE};
            mg::gemm_phase<mg::EpiDown, mg::MoeSched, true>(ldsl, D, S, E);
            { const int ntot = tstart[NE] * 4; if (l + 1 < DEPTH && _rep == 0 && (ntot % nb) != 0 && bid >= ntot % nb) CVT_JOBS(l + 1, 3); }
        }
        SEAM();
    }

    RUN_PH(10) if (IN_PH()) { PH_IDS;
        for (int row = gw; row < TL; row += nwaves) {
            const float* g2 = MOD + ((size_t)(DEPTH - 1) * 9 + mrow_of(row)) * 6144 + 5 * D;
            float gk[4]; float4 xv[4], ggv[4]; unsigned yv[4][4];
#pragma unroll
            for (int k = 0; k < 4; ++k) gk[k] = GATE[row * 4 + k];
#pragma unroll
            for (int i = 0; i < 4; ++i) { xv[i] = ((const float4*)(XS + (size_t)row * D))[lane + i * 64]; ggv[i] = ((const float4*)g2)[lane + i * 64];
#pragma unroll
                for (int k = 0; k < 4; ++k) yv[k][i] = ((const unsigned*)((const unsigned char*)YBB + ((size_t)row * 4 + k) * D))[lane + i * 64]; }
            __builtin_amdgcn_sched_barrier(0);
#pragma unroll
            for (int i = 0; i < 4; ++i) {
                float4 v = xv[i];
                float4 sacc = make_float4(0.f, 0.f, 0.f, 0.f);
#pragma unroll
                for (int k = 0; k < 4; ++k) { const f32x2_t ylo = __builtin_amdgcn_cvt_pk_f32_fp8((int)yv[k][i], false), yhi = __builtin_amdgcn_cvt_pk_f32_fp8((int)yv[k][i], true);
                    sacc.x += gk[k] * ylo[0]; sacc.y += gk[k] * ylo[1]; sacc.z += gk[k] * yhi[0]; sacc.w += gk[k] * yhi[1]; }
                v.x += ggv[i].x * sacc.x; v.y += ggv[i].y * sacc.y; v.z += ggv[i].z * sacc.z; v.w += ggv[i].w * sacc.w;
                ((float4*)(OUTP + (size_t)row * D))[lane + i * 64] = v;
            }
        }
    }
}

extern "C" void kernel_launch(void* const* d_in, const int* in_sizes, int n_in, void* d_out, int out_size, void* d_ws, size_t ws_size, hipStream_t stream) {
    static int grid = 0;
    if (grid == 0) {
        if (n_in != 32 || out_size != TL * D || ws_size < WS_END) { fprintf(stderr, "kernel_launch: unexpected shapes (n_in %d out %d ws %zu need %zu)\n", n_in, out_size, ws_size, (size_t)WS_END); grid = -1; return; }
        int dev = 0, cus = 0, per_cu = 0;
        if (hipGetDevice(&dev) != hipSuccess || hipDeviceGetAttribute(&cus, hipDeviceAttributeMultiprocessorCount, dev) != hipSuccess) { grid = -1; return; }
        if (hipFuncSetAttribute((const void*)fwd, hipFuncAttributeMaxDynamicSharedMemorySize, LDS_BYTES) != hipSuccess) { fprintf(stderr, "kernel_launch: hipFuncSetAttribute failed\n"); grid = -1; return; }
        if (hipOccupancyMaxActiveBlocksPerMultiprocessor(&per_cu, (const void*)fwd, NT, LDS_BYTES) != hipSuccess || per_cu < 1) { fprintf(stderr, "kernel_launch: occupancy query says %d\n", per_cu); }
        (void)hipGetLastError();
        grid = cus;
    }
    if (grid < 0) return;
    (void)hipMemsetAsync((char*)d_ws + WS_CTL, 0, CTL_BYTES, stream);
    Args a{};
    for (int i = 0; i < 32; ++i) a.in[i] = (const float*)d_in[i];
    a.out = (float*)d_out; a.ws = (unsigned char*)d_ws;
#if defined(MK_PER_PHASE)
    const int nph = 2 + DEPTH * 9;
    for (int p = 0; p < nph; ++p) { a.ph_lo = p; a.ph_hi = p + 1; hipLaunchKernelGGL(fwd, dim3(grid), dim3(NT), LDS_BYTES, stream, a); }
#else
    a.ph_lo = 0; a.ph_hi = 1 << 20;
    hipLaunchKernelGGL(fwd, dim3(grid), dim3(NT), LDS_BYTES, stream, a);
#endif
}
```

```cpp
#include <hip/hip_runtime.h>
#include <cstdio>
#include <cstdint>

constexpr int D = 1024, NBATCH = 8, SEQ = 2048, CTXL = 256, DEPTH = 4;
constexpr int TL = NBATCH * SEQ, TC = NBATCH * CTXL, TA = TL + TC;
constexpr int INW = 1280, NE = 32, TOPK = 4, NMOD = 6;
constexpr int NT = 512;
constexpr int MISC_OFF = 131072, LDS_BYTES = 163840;
constexpr int UT_OFF = MISC_OFF + 8192, UT_MAX = 12;
constexpr float EPS = 1e-6f;
constexpr int LISTCAP = TA * TOPK;
constexpr int ACT_ROWS = TA * TOPK + NE * 128;

constexpr size_t al256(size_t x) { return (x + 255) & ~(size_t)255; }
constexpr size_t WS_CTL = 0;
constexpr size_t CTL_BYTES = 65536;
constexpr size_t CW_BAR = 0;
constexpr size_t CW_CVT = 3600;
constexpr size_t CW_CNT = 4096;
constexpr size_t WS_MOD = WS_CTL + CTL_BYTES;
constexpr size_t WS_ROPE = al256(WS_MOD + (size_t)DEPTH * 9 * 6144 * 4);
constexpr size_t WS_DISC = al256(WS_ROPE + (size_t)2 * 2048 * 64 * 4);
constexpr size_t WS_XS = al256(WS_DISC + (size_t)(4096 + 65536) * 4);
constexpr size_t WS_H = al256(WS_XS + (size_t)TA * D * 4);
constexpr size_t WS_PX = al256(WS_H + (size_t)TA * D * 4);
constexpr size_t WS_QN = al256(WS_PX + (size_t)TA * INW * 4);
constexpr size_t WS_KN = al256(WS_QN + (size_t)TA * 512 * 4);
constexpr size_t WS_ATT = al256(WS_KN + (size_t)TA * 128 * 4);
constexpr size_t WS_DLT = al256(WS_ATT + (size_t)TA * 512 * 4);
constexpr size_t WS_G = al256(WS_DLT + (size_t)TA * 256 * 4);
constexpr size_t WS_SO = al256(WS_G + (size_t)TA * 256 * 4);
constexpr size_t WS_MRG = al256(WS_SO + (size_t)TA * 256 * 4);
constexpr size_t WS_ST = al256(WS_MRG + (size_t)TA * D * 4);
constexpr size_t WS_EB = WS_ST;
constexpr size_t WS_QNB = al256(WS_EB + (size_t)NBATCH * 2 * 16 * 36 * 64 * 8);
constexpr size_t WS_KNB = al256(WS_QNB + (size_t)TA * 512 * 2);
constexpr size_t WS_VTB = al256(WS_KNB + (size_t)TA * 128 * 2);
constexpr size_t WS_VTCB = al256(WS_VTB + (size_t)NBATCH * 2 * 64 * SEQ * 2);
static_assert(WS_VTCB + (size_t)NBATCH * 2 * 64 * CTXL * 2 <= WS_ST + (size_t)2 * TA * 16 * 64 * 8, "carve-up overflows the old state buffer");
constexpr size_t WS_TOPI = al256(WS_ST + (size_t)2 * TA * 16 * 64 * 8);
constexpr size_t WS_GATE = al256(WS_TOPI + (size_t)TA * 4 * 4);
constexpr size_t WS_LIST = al256(WS_GATE + (size_t)TA * 4 * 4);
constexpr size_t WS_ACT = al256(WS_LIST + (size_t)NE * LISTCAP * 4);
constexpr size_t WS_YB = al256(WS_ACT + (size_t)ACT_ROWS * D * 4);
constexpr size_t WS_YB_END = al256(WS_YB + (size_t)TA * TOPK * D * 4);
constexpr int ACT_ROWS2 = TA * TOPK + NE * 256;
constexpr size_t WS_WGUT = WS_YB_END;
constexpr size_t WS_WDNT = al256(WS_WGUT + (size_t)DEPTH * NE * 2048 * D * 2);
constexpr size_t WS_H2B = al256(WS_WDNT + (size_t)DEPTH * NE * D * D * 2);
constexpr size_t WS_ACTB = al256(WS_H2B + (size_t)TA * D * 2);
constexpr size_t WS_YBB = al256(WS_ACTB + (size_t)ACT_ROWS2 * D * 2);
constexpr size_t WS_WINT = al256(WS_YBB + (size_t)TA * TOPK * D * 2);
constexpr size_t WS_WOUTT = al256(WS_WINT + (size_t)DEPTH * INW * D * 2);
constexpr size_t WS_GLUT = al256(WS_WOUTT + (size_t)DEPTH * D * D * 2);
constexpr size_t WS_HB = al256(WS_GLUT + (size_t)DEPTH * 256 * 256 * 2);
constexpr size_t WS_MRGB = al256(WS_HB + (size_t)TA * D * 2);
constexpr size_t WS_GB = al256(WS_MRGB + (size_t)TA * D * 2);
constexpr size_t WS_PWT = al256(WS_GB + (size_t)TA * 256 * 2);
constexpr size_t WS_END = al256(WS_PWT + (size_t)DEPTH * 4 * 64 * 64 * 2);

#define XB_TMO      128
#define XB_XCNT(j)  (256  + 64 * (j))
#define XB_XSUB(j)  (1280 + 64 * (j))
#define XB_XGEN(j)  (2304 + 64 * (j))
#define XB_TOP      3328
#define XB_TOPGEN   3392
#define XCD_BAR_WORDS 3456
#define XB_SPIN_CAP (1u << 25)
#define LAS __attribute__((address_space(3)))

__device__ __forceinline__ unsigned xb_ld(unsigned* p)              { return __hip_atomic_load(p, __ATOMIC_RELAXED, __HIP_MEMORY_SCOPE_AGENT); }
__device__ __forceinline__ unsigned xb_add(unsigned* p, unsigned v) { return __hip_atomic_fetch_add(p, v, __ATOMIC_RELAXED, __HIP_MEMORY_SCOPE_AGENT); }
__device__ __forceinline__ unsigned xb_xcc_id() { return (unsigned)__builtin_amdgcn_s_getreg((3 << 11) | 20) & 0xFu; }
#define XB_SPIN(cond, bar) do { unsigned _sp = 0; while (cond) { __builtin_amdgcn_s_sleep(1); \
    if ((++_sp & 255u) == 0u) { if (xb_ld(&(bar)[XB_TMO])) break; if (_sp > XB_SPIN_CAP) { atomicAdd(&(bar)[XB_TMO], 1u); break; } } } } while (0)

struct XcdBarrier { unsigned* bar; unsigned x; volatile LAS unsigned* st; };

__device__ __forceinline__ XcdBarrier xcd_barrier_post(unsigned* bar, volatile LAS unsigned* st) {
    XcdBarrier b; b.bar = bar; b.x = xb_xcc_id(); b.st = st;
    if (threadIdx.x == 0) (void)xb_add(&bar[XB_XCNT(b.x)], 1u);
    return b;
}
__device__ __forceinline__ void xcd_barrier_complete(unsigned* bar, unsigned x, unsigned& nloc, unsigned& nx) {
    const unsigned G = gridDim.x * gridDim.y * gridDim.z;
    unsigned sum, cnt, mine, sp = 0u;
    for (;;) {
        sum = 0u; cnt = 0u; mine = 0u;
#pragma unroll
        for (unsigned j = 0; j < 16; ++j) { const unsigned c = xb_ld(&bar[XB_XCNT(j)]); sum += c; cnt += (c > 0u) ? 1u : 0u; mine = (j == x) ? c : mine; }
        if (sum == G) break;
        __builtin_amdgcn_s_sleep(1);
        if ((++sp & 255u) == 0u) { if (xb_ld(&bar[XB_TMO])) break; if (sp > XB_SPIN_CAP) { atomicAdd(&bar[XB_TMO], 1u); break; } }
    }
    nloc = mine > 0u ? mine : 1u; nx = cnt > 0u ? cnt : 1u;
}
__device__ __noinline__ void xcd_barrier_impl(unsigned* const bar_, const unsigned bx_, volatile LAS unsigned* const st_) {
    XcdBarrier b; b.bar = bar_; b.x = bx_; b.st = st_;
    asm volatile("s_waitcnt vmcnt(0)" ::: "memory");
    __syncthreads();
    if (threadIdx.x == 0) {
        unsigned* bar = b.bar;
        __builtin_amdgcn_s_waitcnt(0);
        unsigned nloc = b.st[0], nx = b.st[1];
        if (nloc == 0u) { xcd_barrier_complete(bar, b.x, nloc, nx); b.st[0] = nloc; b.st[1] = nx; }
        const unsigned old = xb_add(&bar[XB_XSUB(b.x)], 1u);
        const unsigned gen = old / nloc;
        if (old + 1u == (gen + 1u) * nloc) {
            __builtin_amdgcn_fence(__ATOMIC_RELEASE, "agent");
            asm volatile("s_waitcnt vmcnt(0)" ::: "memory");
            const unsigned og = xb_add(&bar[XB_TOP], 1u);
            const unsigned tg = og / nx;
            if (og + 1u == (tg + 1u) * nx) xb_add(&bar[XB_TOPGEN], 1u);
            else XB_SPIN(xb_ld(&bar[XB_TOPGEN]) == tg, bar);
            __builtin_amdgcn_fence(__ATOMIC_ACQUIRE, "agent");
            xb_add(&bar[XB_XGEN(b.x)], 1u);
            asm volatile("s_waitcnt vmcnt(0)" ::: "memory");
        } else {
            XB_SPIN(xb_ld(&bar[XB_XGEN(b.x)]) == gen, bar);
            __builtin_amdgcn_fence(__ATOMIC_ACQUIRE, "agent");
            asm volatile("s_waitcnt vmcnt(0)" ::: "memory");
        }
    }
    __syncthreads();
}
__device__ __forceinline__ void xcd_barrier(const XcdBarrier& b) { xcd_barrier_impl(b.bar, b.x, b.st); }

struct Args { const float* in[32]; float* out; unsigned char* ws; int ph_lo, ph_hi; };

enum { I_X = 0, I_C, I_CTX, I_CCTX, I_WMOD, I_BMOD, I_N1W, I_N2W, I_WIN, I_QNW, I_KNW, I_SINK, I_ARE, I_AIM, I_LOGDT, I_BRE, I_BIM,
       I_CRE, I_CIM, I_SSMD, I_GLUW, I_GLUB, I_POOLW, I_POOLS, I_ONW, I_WOUT, I_RW, I_RB, I_WGU, I_BGU, I_WDN, I_BDN };

__device__ __forceinline__ float shx_(float v, int k, int lane) { return __builtin_bit_cast(float, __builtin_amdgcn_ds_bpermute((lane ^ k) << 2, __builtin_bit_cast(int, v))); }
#define SHX(v, k) shx_((v), (k), lane)
__device__ __forceinline__ float wave_sum_(float v, int lane) {
#pragma unroll
    for (int o = 32; o > 0; o >>= 1) v += shx_(v, o, lane);
    return v;
}
#define DPPF(v, ctrl) __builtin_bit_cast(float, __builtin_amdgcn_update_dpp(0, __builtin_bit_cast(int, (v)), (ctrl), 0xf, 0xf, true))
__device__ __forceinline__ float wave_sum_dpp(float v) {
    v += DPPF(v, 0xB1); v += DPPF(v, 0x4E); v += DPPF(v, 0x141); v += DPPF(v, 0x140);
    const int vi = __builtin_bit_cast(int, v);
    return __builtin_bit_cast(float, __builtin_amdgcn_readlane(vi, 0)) + __builtin_bit_cast(float, __builtin_amdgcn_readlane(vi, 16)) + __builtin_bit_cast(float, __builtin_amdgcn_readlane(vi, 32)) + __builtin_bit_cast(float, __builtin_amdgcn_readlane(vi, 48));
}
__device__ __forceinline__ float wave_max_dpp(float v) {
    v = fmaxf(v, DPPF(v, 0xB1)); v = fmaxf(v, DPPF(v, 0x4E)); v = fmaxf(v, DPPF(v, 0x141)); v = fmaxf(v, DPPF(v, 0x140));
    const int vi = __builtin_bit_cast(int, v);
    return fmaxf(fmaxf(__builtin_bit_cast(float, __builtin_amdgcn_readlane(vi, 0)), __builtin_bit_cast(float, __builtin_amdgcn_readlane(vi, 16))), fmaxf(__builtin_bit_cast(float, __builtin_amdgcn_readlane(vi, 32)), __builtin_bit_cast(float, __builtin_amdgcn_readlane(vi, 48))));
}
#define wave_sum(v) wave_sum_dpp(v)
__device__ __forceinline__ float silu_f(float x) { return x / (1.f + __expf(-x)); }
__device__ __forceinline__ float sigmoid_f(float x) { return 1.f / (1.f + __expf(-x)); }
__device__ __forceinline__ float gelu_tanh_f(float x) { const float u2 = -2.302208198f * (x + 0.044715f * x * x * x); return x * __builtin_amdgcn_rcpf(1.f + __builtin_amdgcn_exp2f(u2)); }
__device__ __forceinline__ int mrow_of(int row) { return row < TL ? (row >> 11) : 8; }

template <class BF, class EF>
__device__ __forceinline__ void ngemm_tile(float* sm, const int tid, const float* arow, int K, BF bf, EF ef) {
    float (*As)[132] = (float (*)[132])sm;
    float (*Bs)[68] = (float (*)[68])(sm + 16 * 132);
    const int am = tid >> 2, ak = (tid & 3) * 4, bk = tid >> 5, bn = (tid & 31) * 2, ty = tid >> 4, tx = tid & 15;
    float acc[4][4];
#pragma unroll
    for (int i = 0; i < 4; ++i)
#pragma unroll
        for (int j = 0; j < 4; ++j) acc[i][j] = 0.f;
    for (int k0 = 0; k0 < K; k0 += 16) {
        float4 av = make_float4(0.f, 0.f, 0.f, 0.f);
        if (arow) av = *(const float4*)(arow + k0 + ak);
        const float b0 = bf(k0 + bk, bn), b1 = bf(k0 + bk, bn + 1);
        __syncthreads();
        As[ak + 0][am] = av.x; As[ak + 1][am] = av.y; As[ak + 2][am] = av.z; As[ak + 3][am] = av.w;
        Bs[bk][bn] = b0; Bs[bk][bn + 1] = b1;
        __syncthreads();
#pragma unroll
        for (int kk = 0; kk < 16; ++kk) {
            const float4 a4 = *(const float4*)&As[kk][ty * 4];
            const float4 b4 = *(const float4*)&Bs[kk][tx * 4];
            const float aa[4] = {a4.x, a4.y, a4.z, a4.w}, bb[4] = {b4.x, b4.y, b4.z, b4.w};
#pragma unroll
            for (int i = 0; i < 4; ++i)
#pragma unroll
                for (int j = 0; j < 4; ++j) acc[i][j] += aa[i] * bb[j];
        }
    }
#pragma unroll
    for (int i = 0; i < 4; ++i) ef(ty * 4 + i, tx * 4, acc[i]);
}


typedef __bf16 bf16x2_t __attribute__((ext_vector_type(2)));
typedef float f32x2_t __attribute__((ext_vector_type(2)));
typedef float f32x16 __attribute__((ext_vector_type(16)));
__device__ __forceinline__ unsigned pk_bf16(float a, float b) { f32x2_t v = {a, b}; bf16x2_t r = __builtin_convertvector(v, bf16x2_t); return __builtin_bit_cast(unsigned, r); }
__device__ __forceinline__ unsigned short bf16_1(float a) { return (unsigned short)(pk_bf16(a, 0.f) & 0xffffu); }
__device__ __forceinline__ float clamp448(float x) { return __builtin_amdgcn_fmed3f(x, -448.f, 448.f); }
namespace mg {
typedef unsigned short bf16_t;
typedef short bf16x8 __attribute__((ext_vector_type(8)));
typedef float f32x4 __attribute__((ext_vector_type(4)));
typedef unsigned u32x4 __attribute__((ext_vector_type(4)));
constexpr int BM = 256, BK = 64, HALF = 128, HTB = HALF * BK * 2, STAGE_BYTES = 8 * HTB;
__host__ __device__ __forceinline__ int lds_byte(int r, int c) { const int st = (r >> 4) * 2 + (c >> 5), rr = r & 15, cc = c & 31, ob = rr * 64 + cc * 2; return st * 1024 + (ob ^ (((ob >> 9) & 1) << 5)); }
__host__ __device__ __forceinline__ void stage_rc(int b, int& R, int& C) { const int st = b / 1024, sb = b % 1024, swz = sb ^ (((sb >> 9) & 1) << 5); R = (st >> 1) * 16 + swz / 64; C = (st & 1) * 32 + (swz % 64) / 2; }
__host__ __device__ __forceinline__ int perm32(int rho) { const int n = rho >> 4, i = rho & 15; return 8 * (i >> 2) + 4 * n + (i & 3); }
__device__ __forceinline__ unsigned cvt_pk_bf16(float lo, float hi) { unsigned r; asm volatile("v_cvt_pk_bf16_f32 %0, %1, %2" : "=v"(r) : "v"(lo), "v"(hi)); return r; }

struct Unit { const char* a; const char* b; int pm, pn, e, p0, cnt, idx, half; };

typedef int v8i_t __attribute__((ext_vector_type(8)));
typedef int v4i_t __attribute__((ext_vector_type(4)));
template <class Epi, class Sched, bool FP8 = false>
__device__ __forceinline__ void gemm_phase(LAS unsigned char* lds, const int KB_, const Sched& S, const Epi& E) {
    int K = KB_; asm volatile("" : "+s"(K));
    int tid = threadIdx.x; asm volatile("" : "+v"(tid));
    const int wid = __builtin_amdgcn_readfirstlane(tid >> 6), lane = tid & 63, wr = wid >> 2, wc = wid & 3, fr = lane & 15, fq = lane >> 4;
    const int nt = K / 128;
    unsigned voffB[2];
#pragma unroll
    for (int i = 0; i < 2; ++i) { int R, C; stage_rc(tid * 16 + i * 8192, R, C); const int Rb = Epi::PERM ? ((R & ~31) + perm32(R & 31)) : R; voffB[i] = (unsigned)(Rb * K + C * 2); }
    const size_t kstep = (size_t)128;
    const size_t hstep = (size_t)HALF * K;
    const unsigned ldsw = (unsigned)wid * 1024u;
    const int aoff = lds_byte(wr * 64 + fr, fq * 8), boff = lds_byte(wc * 32 + fr, fq * 8);
#define MG_SA(b, h) (((b) * 2 + (h)) * HTB)
#define MG_SB(b, h) ((4 + (b) * 2 + (h)) * HTB)
#define MG_STAGE(bufoff, gbase, voff) do { _Pragma("unroll") for (int _i = 0; _i < 2; ++_i) \
        __builtin_amdgcn_global_load_lds((const unsigned*)((const char*)(gbase) + (voff)[_i]), (LAS unsigned*)(lds + (bufoff) + ldsw + _i * 8192), 16, 0, 0); } while (0)
#define MG_LDA(dst, b, h) do { _Pragma("unroll") for (int m = 0; m < 4; ++m) _Pragma("unroll") for (int k = 0; k < 2; ++k) dst[m][k] = *(const LAS bf16x8*)(lds + MG_SA(b, h) + aoff + m * 2048 + k * 1024); } while (0)
#define MG_LDB(dst, b, h) do { _Pragma("unroll") for (int n = 0; n < 2; ++n) _Pragma("unroll") for (int k = 0; k < 2; ++k) dst[n][k] = *(const LAS bf16x8*)(lds + MG_SB(b, h) + boff + n * 2048 + k * 1024); } while (0)
#define MG_MMA(ai, bj, At, Bt) do { __builtin_amdgcn_s_setprio(1); _Pragma("unroll") for (int m = 0; m < 4; ++m) _Pragma("unroll") for (int n = 0; n < 2; ++n) { \
        if (FP8) { const v8i_t wf = __builtin_shufflevector(__builtin_bit_cast(v4i_t, Bt[n][0]), __builtin_bit_cast(v4i_t, Bt[n][1]), 0, 1, 2, 3, 4, 5, 6, 7); \
                   const v8i_t xf = __builtin_shufflevector(__builtin_bit_cast(v4i_t, At[m][0]), __builtin_bit_cast(v4i_t, At[m][1]), 0, 1, 2, 3, 4, 5, 6, 7); \
                   acc[ai][bj][m][n] = __builtin_amdgcn_mfma_scale_f32_16x16x128_f8f6f4(wf, xf, acc[ai][bj][m][n], 0, 0, 0, 0x79797979, 0, 0x7f7f7f7f); } \
        else { _Pragma("unroll") for (int k = 0; k < 2; ++k) acc[ai][bj][m][n] = __builtin_amdgcn_mfma_f32_16x16x32_bf16(Bt[n][k], At[m][k], acc[ai][bj][m][n], 0, 0, 0); } } \
        __builtin_amdgcn_s_setprio(0); } while (0)
#define MG_WAIT_V(n) asm volatile("s_waitcnt vmcnt(" #n ")" ::: "memory")
#define MG_WAIT_L(n) asm volatile("s_waitcnt lgkmcnt(" #n ")" ::: "memory")
#define MG_BAR __builtin_amdgcn_s_barrier()
#define MG_SCHED __builtin_amdgcn_sched_barrier(0)
    Unit cur, nxt; int ui = 0;
    if (!S.next(0, cur)) return;
    f32x4 acc[2][2][4][2];
#pragma unroll
    for (int a = 0; a < 2; ++a)
#pragma unroll
        for (int b = 0; b < 2; ++b)
#pragma unroll
            for (int m = 0; m < 4; ++m)
#pragma unroll
                for (int n = 0; n < 2; ++n) acc[a][b][m][n] = (f32x4){0.f, 0.f, 0.f, 0.f};
    bf16x8 At[4][2], B0[2][2], B1[2][2];
    unsigned cvo0[2], cvo1[2], nvo0[2], nvo1[2];
    S.a_voff(cur, cvo0, cvo1);
    const char* cA = cur.a; const char* cB = cur.b;
    MG_STAGE(MG_SB(0, 0), cB, voffB); MG_STAGE(MG_SA(0, 0), cA, cvo0); MG_STAGE(MG_SB(0, 1), cB + hstep, voffB); MG_STAGE(MG_SA(0, 1), cA, cvo1);
    if (wr == 1) MG_BAR;
    MG_WAIT_V(4); MG_BAR;
    MG_STAGE(MG_SB(1, 0), cB + kstep, voffB); MG_STAGE(MG_SA(1, 0), cA + kstep, cvo0); MG_STAGE(MG_SB(1, 1), cB + hstep + kstep, voffB);
    MG_WAIT_V(6); MG_BAR;
    for (;;) {
        const bool has_next = S.next(ui + 1, nxt);
        const char* nA = has_next ? nxt.a : cA; const char* nB = has_next ? nxt.b : cB;
        if (has_next) S.a_voff(nxt, nvo0, nvo1); else { nvo0[0] = cvo0[0]; nvo0[1] = cvo0[1]; nvo1[0] = cvo1[0]; nvo1[1] = cvo1[1]; }
        for (int t = 0; t < nt; t += 2) {
            const bool last = (t == nt - 2);
            const char* a1 = cA + (size_t)(t + 1) * kstep;
            const char* a2 = last ? nA : cA + (size_t)(t + 2) * kstep; const char* b2 = last ? nB : cB + (size_t)(t + 2) * kstep;
            const char* a3 = a2 + kstep; const char* b3 = b2 + kstep;
            MG_LDB(B0, 0, 0); MG_SCHED; MG_LDA(At, 0, 0); MG_STAGE(MG_SA(1, 1), a1, cvo1);
            if (last) { cvo0[0] = nvo0[0]; cvo0[1] = nvo0[1]; cvo1[0] = nvo1[0]; cvo1[1] = nvo1[1]; }
            MG_WAIT_L(8); MG_BAR; MG_WAIT_L(0); MG_MMA(0, 0, At, B0); MG_BAR; MG_SCHED;
            MG_LDB(B1, 0, 1); MG_STAGE(MG_SB(0, 0), b2, voffB);
            MG_BAR; MG_WAIT_L(0); MG_MMA(0, 1, At, B1); MG_BAR;
            MG_LDA(At, 0, 1); MG_STAGE(MG_SA(0, 0), a2, cvo0);
            MG_BAR; MG_WAIT_L(0); if (!cur.half) MG_MMA(1, 0, At, B0); MG_BAR; MG_SCHED;
            MG_STAGE(MG_SB(0, 1), b2 + hstep, voffB);
            MG_WAIT_V(6); MG_BAR; if (!cur.half) MG_MMA(1, 1, At, B1); MG_BAR;
            MG_LDB(B0, 1, 0); MG_SCHED; MG_LDA(At, 1, 0); MG_STAGE(MG_SA(0, 1), a2, cvo1);
            MG_WAIT_L(8); MG_BAR; MG_WAIT_L(0); MG_MMA(0, 0, At, B0); MG_BAR; MG_SCHED;
            MG_LDB(B1, 1, 1); MG_STAGE(MG_SB(1, 0), b3, voffB);
            MG_BAR; MG_WAIT_L(0); MG_MMA(0, 1, At, B1); MG_BAR;
            MG_LDA(At, 1, 1); MG_STAGE(MG_SA(1, 0), a3, cvo0);
            MG_BAR; MG_WAIT_L(0); if (!cur.half) MG_MMA(1, 0, At, B0); MG_BAR; MG_SCHED;
            MG_STAGE(MG_SB(1, 1), b3 + hstep, voffB);
            MG_WAIT_V(6); MG_BAR; if (!cur.half) MG_MMA(1, 1, At, B1); MG_BAR;
        }
        {
            int tz = threadIdx.x; asm volatile("" : "+v"(tz));
            const int wz = __builtin_amdgcn_readfirstlane(tz >> 6), lz = tz & 63;
            if constexpr (!Epi::AFTER) E(acc, cur, wz >> 2, wz & 3, lz & 15, lz >> 4); }
        if (!has_next) break;
#pragma unroll
        for (int a = 0; a < 2; ++a)
#pragma unroll
            for (int b = 0; b < 2; ++b)
#pragma unroll
                for (int m = 0; m < 4; ++m)
#pragma unroll
                    for (int n = 0; n < 2; ++n) acc[a][b][m][n] = (f32x4){0.f, 0.f, 0.f, 0.f};
        cur = nxt; cA = nA; cB = nB; ++ui;
    }
    MG_WAIT_V(0);
    if (wr == 0) MG_BAR;
    MG_BAR;
    if constexpr (Epi::AFTER) {
        int tz = threadIdx.x; asm volatile("" : "+v"(tz));
        const int wz = __builtin_amdgcn_readfirstlane(tz >> 6), lz = tz & 63;
        E.after(acc, cur, wz >> 2, wz & 3, lz & 15, lz >> 4, lds, lz);
    }
#undef MG_SA
#undef MG_SB
#undef MG_STAGE
#undef MG_LDA
#undef MG_LDB
#undef MG_MMA
#undef MG_WAIT_V
#undef MG_WAIT_L
#undef MG_BAR
#undef MG_SCHED
}

struct MoeSched {
    int tsv, cntv;
    const int* list;
    const LAS int* ent;
    const char* A;
    const char* Bt;
    int ntn, G, c, K;
    __device__ __forceinline__ bool next(int i, Unit& u) const {
        const int L = i * G + c, ntm = __builtin_amdgcn_readlane(tsv, NE);
        if (L >= ntm * ntn) return false;
        int tz = threadIdx.x; asm volatile("" : "+v"(tz)); const int lane = tz & 63;
        const int tnext = __builtin_amdgcn_ds_bpermute(((lane + 1) & 63) << 2, tsv);
        const int e = __builtin_popcountll(__ballot(lane < NE && tnext * ntn <= L));
        const int ts = __builtin_amdgcn_readlane(tsv, e), te = __builtin_amdgcn_readlane(tsv, e + 1);
        const int r = L - ts * ntn, mtl = r / ntn, pn = r - mtl * ntn;
        u.pm = ts + mtl; u.pn = pn; u.e = e; u.p0 = mtl * 256; u.cnt = __builtin_amdgcn_readlane(cntv, e); u.idx = i; u.half = 0;
        u.a = list ? A : A + (size_t)u.pm * 256 * K;
        u.b = Bt + ((size_t)(e * ntn + pn) * 256) * K;
        return true;
    }
    __device__ __forceinline__ void a_voff(const Unit& u, unsigned (&v0)[2], unsigned (&v1)[2]) const {
        int tz = threadIdx.x; asm volatile("" : "+v"(tz));
#pragma unroll
        for (int i = 0; i < 2; ++i) {
            int R, C; stage_rc(tz * 16 + i * 8192, R, C);
            if (list) {
                const LAS int* et = ent + u.idx * 256;
                v0[i] = (unsigned)((et[R] >> 2) * K + C * 2); v1[i] = (unsigned)((et[128 + R] >> 2) * K + C * 2);
            } else { v0[i] = (unsigned)(R * K + C * 2); v1[i] = (unsigned)((128 + R) * K + C * 2); }
        }
    }
};

struct DenseSched {
    const char* A; const char* Bt; int nM, nN, G, c, K;
    __device__ __forceinline__ bool next(int i, Unit& u) const {
        const int nwg = nM * nN; int L, hf = 0;
        if (i == 0) { L = c; if (L >= nwg) return false; }
        else if (i == 1) { const int rem = nwg - G; if (rem <= 0 || c >= 2 * rem) return false; L = G + (c >> 1); hf = 1 + (c & 1); }
        else return false;
        int wgid = L; { const int q = nwg / 8, r = nwg % 8, xcd = wgid % 8, off = wgid / 8; wgid = (xcd < r ? xcd * (q + 1) : r * (q + 1) + (xcd - r) * q) + off; }
        const int nig = 8 * nN, gid = wgid / nig, fm = gid * 8, gsz = (nM - fm) < 8 ? (nM - fm) : 8;
        u.pm = fm + ((wgid % nig) % gsz); u.pn = (wgid % nig) / gsz; u.e = 0; u.p0 = 0; u.cnt = 0; u.idx = i; u.half = hf;
        u.a = A + ((size_t)u.pm * 256 + (hf == 2 ? 128 : 0)) * K; u.b = Bt + (size_t)u.pn * 256 * K;
        return true;
    }
    __device__ __forceinline__ void a_voff(const Unit& u, unsigned (&v0)[2], unsigned (&v1)[2]) const {
        int tz = threadIdx.x; asm volatile("" : "+v"(tz));
#pragma unroll
        for (int i = 0; i < 2; ++i) { int R, C; stage_rc(tz * 16 + i * 8192, R, C); v0[i] = (unsigned)(R * K + C * 2); v1[i] = u.half ? v0[i] : (unsigned)((128 + R) * K + C * 2); }
    }
};
struct EpiF32 {
    static constexpr bool PERM = false, AFTER = false;
    float* Cm; int ldc;
    __device__ __forceinline__ void operator()(const f32x4 (&acc)[2][2][4][2], const Unit& u, int wr, int wc, int fr, int fq) const {
        const int row0 = u.pm * BM + (u.half == 2 ? HALF : 0) + wr * 64 + fr, col0 = u.pn * BM + wc * 32 + 4 * fq;
#pragma unroll
        for (int ai = 0; ai < 2; ++ai) { if (ai == 1 && u.half) continue;
#pragma unroll
            for (int m = 0; m < 4; ++m) { float* rowp = Cm + (size_t)(row0 + ai * HALF + m * 16) * ldc + col0;
#pragma unroll
                for (int bj = 0; bj < 2; ++bj)
#pragma unroll
                    for (int n = 0; n < 2; ++n) *(f32x4*)(rowp + bj * HALF + n * 16) = acc[ai][bj][m][n]; } }
    }
};
struct EpiBf16 {
    static constexpr bool PERM = true, AFTER = false;
    unsigned short* Cm; int ldc;
    __device__ __forceinline__ void operator()(const f32x4 (&acc)[2][2][4][2], const Unit& u, int wr, int wc, int fr, int fq) const {
        const int row0 = u.pm * BM + (u.half == 2 ? HALF : 0) + wr * 64 + fr, col0 = u.pn * BM + wc * 32 + 8 * fq;
#pragma unroll
        for (int ai = 0; ai < 2; ++ai) { if (ai == 1 && u.half) continue;
#pragma unroll
            for (int m = 0; m < 4; ++m) { unsigned short* rowp = Cm + (size_t)(row0 + ai * HALF + m * 16) * ldc + col0;
#pragma unroll
                for (int bj = 0; bj < 2; ++bj) { const f32x4 v0 = acc[ai][bj][m][0], v1 = acc[ai][bj][m][1];
                    u32x4 w; w.x = pk_bf16(v0[0], v0[1]); w.y = pk_bf16(v0[2], v0[3]); w.z = pk_bf16(v1[0], v1[1]); w.w = pk_bf16(v1[2], v1[3]);
                    *(u32x4*)(rowp + bj * HALF) = w; } } }
    }
};
struct EpiResid {
    static constexpr bool PERM = false, AFTER = false;
    float* X; const float* gate_l; float gs; const float* in_lat; const float* in_ctx;
    __device__ __forceinline__ void operator()(const f32x4 (&acc)[2][2][4][2], const Unit& u, int wr, int wc, int fr, int fq) const {
        const int row0 = u.pm * BM + (u.half == 2 ? HALF : 0) + wr * 64 + fr, col0 = u.pn * BM + wc * 32 + 4 * fq;
        const float* gp = gate_l + (size_t)(u.pm < TL / 256 ? (u.pm >> 3) : 8) * 6144 + col0;
        const float* src = in_lat ? (u.pm < TL / 256 ? in_lat : in_ctx - (size_t)TL * D) : X;
        f32x4 gv[2][2];
#pragma unroll
        for (int bj = 0; bj < 2; ++bj)
#pragma unroll
            for (int n = 0; n < 2; ++n) gv[bj][n] = *(const f32x4*)(gp + bj * HALF + n * 16);
#pragma unroll
        for (int ai = 0; ai < 2; ++ai) { if (ai == 1 && u.half) continue;
            f32x4 rv[4][2][2];
#pragma unroll
            for (int m = 0; m < 4; ++m) { const size_t ro = (size_t)(row0 + ai * HALF + m * 16) * D + col0;
#pragma unroll
                for (int bj = 0; bj < 2; ++bj)
#pragma unroll
                    for (int n = 0; n < 2; ++n) rv[m][bj][n] = *(const f32x4*)(src + ro + bj * HALF + n * 16); }
            __builtin_amdgcn_sched_barrier(0);
#pragma unroll
            for (int m = 0; m < 4; ++m) { const size_t ro = (size_t)(row0 + ai * HALF + m * 16) * D + col0;
#pragma unroll
                for (int bj = 0; bj < 2; ++bj)
#pragma unroll
                    for (int n = 0; n < 2; ++n) *(f32x4*)(X + ro + bj * HALF + n * 16) = rv[m][bj][n] + gv[bj][n] * acc[ai][bj][m][n] * gs; }
            __builtin_amdgcn_sched_barrier(0); }
    }
};
struct EpiGluNorm {
    static constexpr bool PERM = false, AFTER = true;
    unsigned short* Out; const unsigned short* Gm; const float* bias; const float* onw;
    __device__ __forceinline__ void operator()(const f32x4 (&)[2][2][4][2], const Unit&, int, int, int, int) const {}
    __device__ __forceinline__ void after(f32x4 (&acc)[2][2][4][2], const Unit& u, int wr, int wc, int fr, int fq, LAS unsigned char* lds, int lane) const {
        const int row0 = u.pm * BM + wr * 64 + fr, col0 = wc * 32 + 4 * fq;
        LAS float* ps = (LAS float*)lds;
        f32x4 bv[2][2];
#pragma unroll
        for (int bj = 0; bj < 2; ++bj)
#pragma unroll
            for (int n = 0; n < 2; ++n) bv[bj][n] = *(const f32x4*)(bias + col0 + bj * HALF + n * 16);
#pragma unroll
        for (int ai = 0; ai < 2; ++ai) {
            uint2 gqv[4][2][2];
#pragma unroll
            for (int m = 0; m < 4; ++m) { const size_t ro = (size_t)(row0 + ai * HALF + m * 16) * 256 + col0;
#pragma unroll
                for (int bj = 0; bj < 2; ++bj)
#pragma unroll
                    for (int n = 0; n < 2; ++n) gqv[m][bj][n] = *(const uint2*)(Gm + ro + bj * HALF + n * 16); }
            __builtin_amdgcn_sched_barrier(0);
#pragma unroll
            for (int m = 0; m < 4; ++m) { float p = 0.f;
#pragma unroll
                for (int bj = 0; bj < 2; ++bj)
#pragma unroll
                    for (int n = 0; n < 2; ++n) { const f32x4 z = acc[ai][bj][m][n] + bv[bj][n]; const uint2 gq = gqv[m][bj][n];
                        const f32x4 g = (f32x4){__uint_as_float(gq.x << 16), __uint_as_float(gq.x & 0xffff0000u), __uint_as_float(gq.y << 16), __uint_as_float(gq.y & 0xffff0000u)}; f32x4 o;
#pragma unroll
                        for (int i = 0; i < 4; ++i) { o[i] = g[i] * __builtin_amdgcn_rcpf(1.f + __builtin_amdgcn_exp2f(-1.44269504f * z[i])); p += o[i] * o[i]; }
                        acc[ai][bj][m][n] = o; }
                p += shx_(p, 16, lane); p += shx_(p, 32, lane);
                if (fq == 0) ps[(ai * HALF + wr * 64 + m * 16 + fr) * 4 + wc] = p; } }
        __syncthreads();
        f32x4 wv[2][2];
#pragma unroll
        for (int bj = 0; bj < 2; ++bj)
#pragma unroll
            for (int n = 0; n < 2; ++n) wv[bj][n] = *(const f32x4*)(onw + col0 + bj * HALF + n * 16);
#pragma unroll
        for (int ai = 0; ai < 2; ++ai)
#pragma unroll
            for (int m = 0; m < 4; ++m) { const int rl = ai * HALF + wr * 64 + m * 16 + fr;
                const f32x4 q = *(const LAS f32x4*)(ps + rl * 4);
                const float rs = rsqrtf((q[0] + q[1] + q[2] + q[3]) * (1.f / 256.f) + EPS);
                unsigned short* rowp = Out + (size_t)(u.pm * BM + rl) * D + 512 + col0;
#pragma unroll
                for (int bj = 0; bj < 2; ++bj)
#pragma unroll
                    for (int n = 0; n < 2; ++n) { const f32x4 o = acc[ai][bj][m][n], w = wv[bj][n];
                        *(uint2*)(rowp + bj * HALF + n * 16) = make_uint2(pk_bf16(o[0] * rs * w[0], o[1] * rs * w[1]), pk_bf16(o[2] * rs * w[2], o[3] * rs * w[3])); } }
    }
};
struct EpiSwiglu {
    static constexpr bool PERM = true, AFTER = false;
    unsigned char* act; const LAS float* btab;
    __device__ __forceinline__ void operator()(const f32x4 (&acc)[2][2][4][2], const Unit& u, int wr, int wc, int fr, int fq) const {
        const int j = u.pn * 128 + wc * 32 + 8 * fq;
        const LAS float* bg = btab + u.idx * 256 + wc * 32 + 8 * fq;
        const f32x4 g0 = *(const LAS f32x4*)(bg), g1 = *(const LAS f32x4*)(bg + 4), u0 = *(const LAS f32x4*)(bg + 128), u1 = *(const LAS f32x4*)(bg + 132);
#pragma unroll
        for (int ai = 0; ai < 2; ++ai)
#pragma unroll
            for (int m = 0; m < 4; ++m) {
                const int rl = ai * 128 + wr * 64 + m * 16 + fr;
                float o[8];
#pragma unroll
                for (int n = 0; n < 2; ++n)
#pragma unroll
                    for (int i = 0; i < 4; ++i) {
                        float gt = acc[ai][0][m][n][i] + (n ? g1[i] : g0[i]), up = acc[ai][1][m][n][i] + (n ? u1[i] : u0[i]);
                        gt = fminf(gt, 7.f); up = fminf(fmaxf(up, -7.f), 7.f);
                        o[n * 4 + i] = (up + 1.f) * (gt * __builtin_amdgcn_rcpf(1.f + __builtin_amdgcn_exp2f(-2.45546696f * gt)));
                    }
                int p0 = __builtin_amdgcn_cvt_pk_fp8_f32(o[0], o[1], 0, false); p0 = __builtin_amdgcn_cvt_pk_fp8_f32(o[2], o[3], p0, true);
                int p1 = __builtin_amdgcn_cvt_pk_fp8_f32(o[4], o[5], 0, false); p1 = __builtin_amdgcn_cvt_pk_fp8_f32(o[6], o[7], p1, true);
                *(uint2*)(act + ((size_t)u.pm * 256 + rl) * D + j) = make_uint2((unsigned)p0, (unsigned)p1);
            }
    }
};
struct EpiDown {
    static constexpr bool PERM = true, AFTER = false;
    bf16_t* yb; const LAS float* btab; const LAS int* ent;
    __device__ __forceinline__ void operator()(const f32x4 (&acc)[2][2][4][2], const Unit& u, int wr, int wc, int fr, int fq) const {
        const int c0 = u.pn * 256 + wc * 32 + 8 * fq;
        const LAS float* bd = btab + u.idx * 256 + wc * 32 + 8 * fq;
        f32x4 bv[2][2];
#pragma unroll
        for (int bj = 0; bj < 2; ++bj)
#pragma unroll
            for (int n = 0; n < 2; ++n) bv[bj][n] = *(const LAS f32x4*)(bd + bj * 128 + 4 * n);
        const LAS int* et = ent + u.idx * 256;
#pragma unroll
        for (int ai = 0; ai < 2; ++ai)
#pragma unroll
            for (int m = 0; m < 4; ++m) {
                const int rl = ai * 128 + wr * 64 + m * 16 + fr;
                if (u.p0 + rl < u.cnt) {
                    unsigned char* rowp = (unsigned char*)yb + (size_t)et[rl] * D + c0;
#pragma unroll
                    for (int bj = 0; bj < 2; ++bj) {
                        const f32x4 v0 = acc[ai][bj][m][0] + bv[bj][0], v1 = acc[ai][bj][m][1] + bv[bj][1];
                        int p0 = __builtin_amdgcn_cvt_pk_fp8_f32(clamp448(v0[0]), clamp448(v0[1]), 0, false); p0 = __builtin_amdgcn_cvt_pk_fp8_f32(clamp448(v0[2]), clamp448(v0[3]), p0, true);
                        int p1 = __builtin_amdgcn_cvt_pk_fp8_f32(clamp448(v1[0]), clamp448(v1[1]), 0, false); p1 = __builtin_amdgcn_cvt_pk_fp8_f32(clamp448(v1[2]), clamp448(v1[3]), p1, true);
                        *(uint2*)(rowp + bj * 128) = make_uint2((unsigned)p0, (unsigned)p1);
                    }
                }
            }
    }
};
}

template <class RF>
__device__ __forceinline__ void transpose_cvt_tile(float* sm, const int tid, const float* src, int ldn, int k0, int n0, unsigned short* dst, int ldk, RF dst_row) {
    float (*T)[129] = (float (*)[129])sm;
    __syncthreads();
#pragma unroll
    for (int i = 0; i < 4; ++i) {
        const int kk = (tid >> 4) + 32 * i, cc = (tid & 15) * 4;
        const float4 v = *(const float4*)(src + (size_t)(k0 + kk) * ldn + n0 + cc);
        T[cc][kk] = v.x; T[cc + 1][kk] = v.y; T[cc + 2][kk] = v.z; T[cc + 3][kk] = v.w;
    }
    __syncthreads();
#pragma unroll
    for (int i = 0; i < 2; ++i) {
        const int n = (tid >> 4) + 32 * i, kk = (tid & 15) * 8;
        mg::u32x4 w;
        w.x = mg::cvt_pk_bf16(T[n][kk], T[n][kk + 1]); w.y = mg::cvt_pk_bf16(T[n][kk + 2], T[n][kk + 3]);
        w.z = mg::cvt_pk_bf16(T[n][kk + 4], T[n][kk + 5]); w.w = mg::cvt_pk_bf16(T[n][kk + 6], T[n][kk + 7]);
        *(mg::u32x4*)(dst + (size_t)dst_row(n0 + n) * ldk + k0 + kk) = w;
    }
}
__device__ __forceinline__ mg::f32x4 bf4_f32(uint2 p) { return (mg::f32x4){__uint_as_float(p.x << 16), __uint_as_float(p.x & 0xffff0000u), __uint_as_float(p.y << 16), __uint_as_float(p.y & 0xffff0000u)}; }
__device__ __forceinline__ float bf2f(unsigned short b) { return __uint_as_float(((unsigned)b) << 16); }


struct SsmFrags { mg::bf16x8 bfr[2][2][2]; mg::bf16x8 cf[2][4]; float a0r, a0i, a1r, a1i, dch; };
template <bool READOUT>
__device__ __forceinline__ void ssm_load_frags(SsmFrags& F, const int lane, const int g, const float* DISCp, const float* cre, const float* cim, const float* ssmd) {
    const int j = lane & 31, h = lane >> 5;
    float4 rlo[2][2][2], rhi[2][2][2];
#pragma unroll
    for (int part = 0; part < 2; ++part)
#pragma unroll
        for (int nh = 0; nh < 2; ++nh)
#pragma unroll
            for (int sx = 0; sx < 2; ++sx) {
                const float* p = DISCp + 4096 + part * 32768 + (size_t)(((sx * 16 + g) * 64 + nh * 32 + j) * 16) + 8 * h;
                rlo[part][nh][sx] = ((const float4*)p)[0]; rhi[part][nh][sx] = ((const float4*)p)[1];
            }
    __builtin_amdgcn_sched_barrier(0);
#pragma unroll
    for (int part = 0; part < 2; ++part)
#pragma unroll
        for (int nh = 0; nh < 2; ++nh)
#pragma unroll
            for (int sx = 0; sx < 2; ++sx) {
                const float4 lo = rlo[part][nh][sx], hi = rhi[part][nh][sx];
                mg::u32x4 w; w.x = pk_bf16(lo.x, lo.y); w.y = pk_bf16(lo.z, lo.w); w.z = pk_bf16(hi.x, hi.y); w.w = pk_bf16(hi.z, hi.w);
                F.bfr[part][nh][sx] = __builtin_bit_cast(mg::bf16x8, w);
            }
    const int di0 = (h * 16 + g) * 64 + j;
    F.a0r = DISCp[di0]; F.a0i = DISCp[2048 + di0]; F.a1r = DISCp[di0 + 32]; F.a1i = DISCp[2048 + di0 + 32];
    F.dch = 0.f;
#pragma unroll
    for (int d = 0; d < 2; ++d)
#pragma unroll
        for (int kk = 0; kk < 4; ++kk) F.cf[d][kk] = (mg::bf16x8){0, 0, 0, 0, 0, 0, 0, 0};
    if (READOUT) {
        const int pcol = lane & 15, quad = lane >> 4;
        float4 c4v[2][4], d4v[2][4];
#pragma unroll
        for (int d = 0; d < 2; ++d)
#pragma unroll
            for (int kk = 0; kk < 4; ++kk) {
                c4v[d][kk] = *(const float4*)(cre + ((size_t)(d * 16 + g) * 16 + pcol) * 64 + kk * 16 + quad * 4);
                d4v[d][kk] = *(const float4*)(cim + ((size_t)(d * 16 + g) * 16 + pcol) * 64 + kk * 16 + quad * 4);
            }
        F.dch = ssmd[g * 16 + pcol];
        __builtin_amdgcn_sched_barrier(0);
#pragma unroll
        for (int d = 0; d < 2; ++d)
#pragma unroll
            for (int kk = 0; kk < 4; ++kk) {
                const float4 c4 = c4v[d][kk], d4 = d4v[d][kk];
                mg::u32x4 w; w.x = pk_bf16(c4.x, -d4.x); w.y = pk_bf16(c4.y, -d4.y); w.z = pk_bf16(c4.z, -d4.z); w.w = pk_bf16(c4.w, -d4.w);
                F.cf[d][kk] = __builtin_bit_cast(mg::bf16x8, w);
            }
    }
}
template <bool READOUT>
__device__ __forceinline__ void ssm_chunk(LAS unsigned char* wl, const int lane, const int b, const int ck, const int g, const unsigned short* PXp, const SsmFrags& F, float2* EBp,
                                          float* Gp, unsigned short* GBp) {
    typedef short s16x2 __attribute__((ext_vector_type(2)));
    const int j = lane & 31, h = lane >> 5;
    LAS float* Uc = (LAS float*)wl; LAS unsigned char* Sl = wl + 4096;
    const int row0 = ck < 4 ? TL + b * CTXL + ck * 64 : b * SEQ + (ck - 4) * 64;
    {   const uint4* up = (const uint4*)(PXp + (size_t)(row0 + lane) * INW + 768 + g * 16); const uint4 q0 = up[0], q1 = up[1];
        LAS mg::f32x4* ud = (LAS mg::f32x4*)(Uc + lane * 16);
        ud[0] = bf4_f32(make_uint2(q0.x, q0.y)); ud[1] = bf4_f32(make_uint2(q0.z, q0.w)); ud[2] = bf4_f32(make_uint2(q1.x, q1.y)); ud[3] = bf4_f32(make_uint2(q1.z, q1.w)); }
    const float a0r = F.a0r, a0i = F.a0i, a1r = F.a1r, a1i = F.a1i;
    const int kh = h ? (ck < 4 ? 3 - ck : 39 - ck) : ck;
    float s0r = 0.f, s0i = 0.f, s1r = 0.f, s1i = 0.f;
    mg::f32x4 yacc[4];
    if (READOUT) {
        float p0r = a0r, p0i = a0i, p1r = a1r, p1i = a1i;
#pragma unroll
        for (int q = 0; q < 6; ++q) { const float t0 = p0r * p0r - p0i * p0i, u0 = 2.f * p0r * p0i, t1 = p1r * p1r - p1i * p1i, u1 = 2.f * p1r * p1i; p0r = t0; p0i = u0; p1r = t1; p1i = u1; }
        const float2* ep = EBp + ((size_t)((b * 2 + h) * 16 + g) * 36) * 64 + j;
        const int kf = ck, kb = ck < 4 ? 3 - ck : 39 - ck, kmax = kf > kb ? kf : kb;
        for (int kp0 = 0; kp0 < kmax; kp0 += 4) {
            float2 e0[4], e1[4];
#pragma unroll
            for (int q = 0; q < 4; ++q) { const int kq = max(min(kp0 + q, kh - 1), 0); e0[q] = ep[(size_t)kq * 64]; e1[q] = ep[(size_t)kq * 64 + 32]; }
#pragma unroll
            for (int q = 0; q < 4; ++q) if (kp0 + q < kh) {
                const float n0r = p0r * s0r - p0i * s0i + e0[q].x, n0i = p0r * s0i + p0i * s0r + e0[q].y; s0r = n0r; s0i = n0i;
                const float n1r = p1r * s1r - p1i * s1i + e1[q].x, n1i = p1r * s1i + p1i * s1r + e1[q].y; s1r = n1r; s1i = n1i; }
        }
#pragma unroll
        for (int t = 0; t < 4; ++t) yacc[t] = (mg::f32x4){0.f, 0.f, 0.f, 0.f};
    }
    const int dir_i = (j >> 2) & 1, r_i = (j & 3) + 4 * (j >> 3);
    f32x16 zero16;
#pragma unroll
    for (int i = 0; i < 16; ++i) zero16[i] = 0.f;
#pragma unroll
    for (int blk = 0; blk < 4; ++blk) {
        __builtin_amdgcn_sched_barrier(0);
        const int tok = dir_i ? (3 - blk) * 16 + 15 - r_i : blk * 16 + r_i;
        const LAS mg::f32x4* up = (const LAS mg::f32x4*)(Uc + tok * 16 + 8 * h);
        asm volatile("" : "+v"(up) : "v"(s0r), "v"(s1r));
        const mg::f32x4 u0 = up[0], u1 = up[1];
        mg::u32x4 uw; uw.x = pk_bf16(u0[0], u0[1]); uw.y = pk_bf16(u0[2], u0[3]); uw.z = pk_bf16(u1[0], u1[1]); uw.w = pk_bf16(u1[2], u1[3]);
        const mg::u32x4 zw = (mg::u32x4){0u, 0u, 0u, 0u};
        const mg::bf16x8 af0 = __builtin_bit_cast(mg::bf16x8, dir_i == 0 ? uw : zw), af1 = __builtin_bit_cast(mg::bf16x8, dir_i == 1 ? uw : zw);
        if constexpr (!READOUT) {
            f32x16 Xr0 = __builtin_amdgcn_mfma_f32_32x32x16_bf16(af0, F.bfr[0][0][0], zero16, 0, 0, 0), Xi0 = __builtin_amdgcn_mfma_f32_32x32x16_bf16(af0, F.bfr[1][0][0], zero16, 0, 0, 0);
            f32x16 Xr1 = __builtin_amdgcn_mfma_f32_32x32x16_bf16(af0, F.bfr[0][1][0], zero16, 0, 0, 0), Xi1 = __builtin_amdgcn_mfma_f32_32x32x16_bf16(af0, F.bfr[1][1][0], zero16, 0, 0, 0);
            Xr0 = __builtin_amdgcn_mfma_f32_32x32x16_bf16(af1, F.bfr[0][0][1], Xr0, 0, 0, 0); Xi0 = __builtin_amdgcn_mfma_f32_32x32x16_bf16(af1, F.bfr[1][0][1], Xi0, 0, 0, 0);
            Xr1 = __builtin_amdgcn_mfma_f32_32x32x16_bf16(af1, F.bfr[0][1][1], Xr1, 0, 0, 0); Xi1 = __builtin_amdgcn_mfma_f32_32x32x16_bf16(af1, F.bfr[1][1][1], Xi1, 0, 0, 0);
#pragma unroll
            for (int r = 0; r < 16; ++r) {
                float t0r = __builtin_fmaf(a0r, s0r, Xr0[r]), t0i = __builtin_fmaf(a0r, s0i, Xi0[r]), t1r = __builtin_fmaf(a1r, s1r, Xr1[r]), t1i = __builtin_fmaf(a1r, s1i, Xi1[r]);
                asm volatile("" : "+v"(t0r), "+v"(t0i), "+v"(t1r), "+v"(t1i));
                const float n0r = __builtin_fmaf(-a0i, s0i, t0r), n0i = __builtin_fmaf(a0i, s0r, t0i), n1r = __builtin_fmaf(-a1i, s1i, t1r), n1i = __builtin_fmaf(a1i, s1r, t1i);
                s0r = n0r; s0i = n0i; s1r = n1r; s1i = n1i;
            }
        } else
#pragma unroll
        for (int nh = 0; nh < 2; ++nh) {
            f32x16 Xr = __builtin_amdgcn_mfma_f32_32x32x16_bf16(af0, F.bfr[0][nh][0], zero16, 0, 0, 0);
            Xr = __builtin_amdgcn_mfma_f32_32x32x16_bf16(af1, F.bfr[0][nh][1], Xr, 0, 0, 0);
            f32x16 Xi = __builtin_amdgcn_mfma_f32_32x32x16_bf16(af0, F.bfr[1][nh][0], zero16, 0, 0, 0);
            Xi = __builtin_amdgcn_mfma_f32_32x32x16_bf16(af1, F.bfr[1][nh][1], Xi, 0, 0, 0);
            float sr = nh ? s1r : s0r, si = nh ? s1i : s0i;
            const float ar = nh ? a1r : a0r, ai = nh ? a1i : a0i;
            LAS unsigned char* sp = Sl + h * 4352 + (h ? 15 * 272 : 0) + (nh * 32 + j) * 4;
            asm volatile("" : "+v"(sp));
            const int sstep = h ? -272 : 272;
#pragma unroll
            for (int r = 0; r < 16; ++r) {
                float tr = __builtin_fmaf(ar, sr, Xr[r]), ti = __builtin_fmaf(ar, si, Xi[r]);
                asm volatile("" : "+v"(tr), "+v"(ti));
                const float nr = __builtin_fmaf(-ai, si, tr), ni = __builtin_fmaf(ai, sr, ti);
                sr = nr; si = ni;
                if (READOUT) { *(LAS s16x2*)sp = __builtin_bit_cast(s16x2, pk_bf16(sr, si)); sp += sstep; }
            }
            if (nh) { s1r = sr; s1i = si; } else { s0r = sr; s0i = si; }
        }
        if (READOUT) {
            const int pcol = lane & 15, quad = lane >> 4;
#pragma unroll
            for (int kk = 0; kk < 4; ++kk) {
                const mg::bf16x8 afw = *(const LAS mg::bf16x8*)(Sl + pcol * 272 + kk * 64 + quad * 16);
                const mg::bf16x8 abw = *(const LAS mg::bf16x8*)(Sl + 4352 + pcol * 272 + kk * 64 + quad * 16);
                yacc[blk] = __builtin_amdgcn_mfma_f32_16x16x32_bf16(afw, F.cf[0][kk], yacc[blk], 0, 0, 0);
                yacc[3 - blk] = __builtin_amdgcn_mfma_f32_16x16x32_bf16(abw, F.cf[1][kk], yacc[3 - blk], 0, 0, 0);
            }
        }
    }
    if (READOUT) {
        const int pcol = lane & 15, quad = lane >> 4, c = g * 16 + pcol;
        const float dch = F.dch;
#pragma unroll
        for (int tb = 0; tb < 4; ++tb)
#pragma unroll
            for (int jj = 0; jj < 4; ++jj) {
                const int tt = tb * 16 + quad * 4 + jj;
                const float y = yacc[tb][jj] + dch * Uc[tt * 16 + pcol];
                const float gy = gelu_tanh_f(y);
                const size_t idx = (size_t)(row0 + tt) * 256 + c;
                GBp[idx] = bf16_1(gy);
            }
    } else {
        float2* eo = EBp + ((size_t)((b * 2 + h) * 16 + g) * 36 + kh) * 64 + j;
        eo[0] = make_float2(s0r, s0i); eo[32] = make_float2(s1r, s1i);
    }
}

__global__ void __launch_bounds__(NT, 2) fwd(Args args) {
    extern __shared__ __attribute__((aligned(16))) unsigned char lds[];
    float* smem = (float*)lds;
    LAS unsigned char* ldsl = (LAS unsigned char*)lds;
    LAS unsigned* misc = (LAS unsigned*)(ldsl + MISC_OFF);
    const int bid = blockIdx.x, nb = gridDim.x;
    const int nwaves = nb * (NT / 64), gthreads = nb * NT;
#define PH_IDS int tid = threadIdx.x; asm volatile("" : "+v"(tid)); const int lane = tid & 63, wave = tid >> 6, gw = wave * nb + bid, gtid = bid * NT + tid; (void)lane; (void)wave; (void)gw; (void)gtid; \
    kaptr_t ka = (kaptr_t)__builtin_amdgcn_kernarg_segment_ptr(); asm volatile("" : "+s"(ka)); unsigned char* const ws = KA_LOAD(unsigned char*, 264); (void)ws
    unsigned* ctl = (unsigned*)(args.ws + WS_CTL);
    typedef const unsigned char __attribute__((address_space(4)))* kaptr_t;
#define KA_LOAD(T, off) (*(T const __attribute__((address_space(4)))*)(ka + (off)))
#define INP(i) KA_LOAD(const float*, 8 * (i))
#define OUTP KA_LOAD(float*, 256)
#define MOD ((float*)(ws + WS_MOD))
#define ROPEC ((float*)(ws + WS_ROPE))
#define ROPES (ROPEC + 2048 * 64)
#define DISC ((float*)(ws + WS_DISC))
#define XS ((float*)(ws + WS_XS))
#define H ((float*)(ws + WS_H))
#define PX ((unsigned short*)(ws + WS_PX))
#define QN ((float*)(ws + WS_QN))
#define KN ((float*)(ws + WS_KN))
#define ATT ((float*)(ws + WS_ATT))
#define DLT ((float*)(ws + WS_DLT))
#define G ((float*)(ws + WS_G))
#define SO ((float*)(ws + WS_SO))
#define MRG ((float*)(ws + WS_MRG))
#define ST ((float2*)(ws + WS_ST))
#define TOPI ((int*)(ws + WS_TOPI))
#define GATE ((float*)(ws + WS_GATE))
#define LIST ((int*)(ws + WS_LIST))
#define WGUT ((unsigned short*)(ws + WS_WGUT))
#define WDNT ((unsigned short*)(ws + WS_WDNT))
#define H2B ((unsigned short*)(ws + WS_H2B))
#define ACTB ((unsigned short*)(ws + WS_ACTB))
#define YBB ((unsigned short*)(ws + WS_YBB))
#define WINT ((unsigned short*)(ws + WS_WINT))
#define WOUTT ((unsigned short*)(ws + WS_WOUTT))
#define GLUT ((unsigned short*)(ws + WS_GLUT))
#define HB ((unsigned short*)(ws + WS_HB))
#define EB ((float2*)(ws + WS_EB))
#define QNB ((unsigned short*)(ws + WS_QNB))
#define KNB ((unsigned short*)(ws + WS_KNB))
#define VTB ((unsigned short*)(ws + WS_VTB))
#define VTCB ((unsigned short*)(ws + WS_VTCB))
#define MRGB ((unsigned short*)(ws + WS_MRGB))
#define GB ((unsigned short*)(ws + WS_GB))
#define PWT ((unsigned short*)(ws + WS_PWT))
#define modl (MOD + (size_t)l * 9 * 6144)
#define counts (((unsigned*)(ws + WS_CTL)) + CW_CNT + l * NE * 32)
    if (threadIdx.x < 4) misc[threadIdx.x] = 0u;
    __syncthreads();
    XcdBarrier bar = xcd_barrier_post(ctl + CW_BAR, (volatile LAS unsigned*)misc);
    const int lo = args.ph_lo, hi = args.ph_hi;
    int ph = 0;
#if defined(TPROBE)
    unsigned long long tp_acc = 0ull, tp_t0 = 0ull; const unsigned long long tp_beg = __builtin_amdgcn_s_memrealtime();
#define TP0 tp_t0 = __builtin_amdgcn_s_memrealtime();
#define TP1 tp_acc += __builtin_amdgcn_s_memrealtime() - tp_t0;
#else
#define TP0
#define TP1
#endif
#define IN_PH() (lo <= ph && ph < hi)
#ifndef REPMASK
#define REPMASK 0
#endif
#define RUN_PH(idx) for (int _rep = 0; _rep < 1 + ((REPMASK >> (idx)) & 1); ++_rep)
#define SEAM() do { if (lo <= ph && ph + 1 < hi) xcd_barrier(bar); ++ph; } while (0)

#define CVT_GROUP(IT0) do { const int it0 = (IT0); \
            const float* srcp[3]; unsigned char* dstp[3]; int ldn_[3], k0_[3], n0_[3], gu_[3]; \
            float4 tv[3][4]; \
            _Pragma("unroll") \
            for (int j = 0; j < 3; ++j) { \
                const int it = min(it0 + j, DEPTH * NE * 384 - 1), le = it / 384, r = it % 384; \
                if (r < 256) { srcp[j] = INP(I_WGU) + (size_t)le * D * 2048; dstp[j] = (unsigned char*)WGUT + (size_t)le * 2048 * D; ldn_[j] = 2048; k0_[j] = (r >> 5) * 128; n0_[j] = (r & 31) * 64; gu_[j] = 1; } \
                else { const int r2 = r - 256; srcp[j] = INP(I_WDN) + (size_t)le * D * D; dstp[j] = (unsigned char*)WDNT + (size_t)le * D * D; ldn_[j] = D; k0_[j] = (r2 >> 4) * 128; n0_[j] = (r2 & 15) * 64; gu_[j] = 0; } \
            _Pragma("unroll") \
                for (int i = 0; i < 4; ++i) tv[j][i] = *(const float4*)(srcp[j] + (size_t)(k0_[j] + (tid >> 4) + 32 * i) * ldn_[j] + n0_[j] + (tid & 15) * 4); \
            } \
            __syncthreads(); \
            _Pragma("unroll") \
            for (int j = 0; j < 3; ++j) { float (*T)[129] = (float (*)[129])(smem + j * 64 * 129); \
            _Pragma("unroll") \
                for (int i = 0; i < 4; ++i) { const int kk = (tid >> 4) + 32 * i, cc = (tid & 15) * 4; T[cc][kk] = tv[j][i].x; T[cc + 1][kk] = tv[j][i].y; T[cc + 2][kk] = tv[j][i].z; T[cc + 3][kk] = tv[j][i].w; } } \
            __syncthreads(); \
            _Pragma("unroll") \
            for (int j = 0; j < 3; ++j) { if (it0 + j < DEPTH * NE * 384) { float (*T)[129] = (float (*)[129])(smem + j * 64 * 129); \
            _Pragma("unroll") \
                for (int i = 0; i < 2; ++i) { \
                    const int n = (tid >> 4) + 32 * i, kk = (tid & 15) * 8, ng = n0_[j] + n; \
                    const int drow = gu_[j] ? (((ng & 1023) >> 7) * 256 + (ng >> 10) * 128 + (ng & 127)) : ng; \
                    int q0 = __builtin_amdgcn_cvt_pk_fp8_f32(clamp448(T[n][kk] * 64.f), clamp448(T[n][kk + 1] * 64.f), 0, false); q0 = __builtin_amdgcn_cvt_pk_fp8_f32(clamp448(T[n][kk + 2] * 64.f), clamp448(T[n][kk + 3] * 64.f), q0, true); \
                    int q1 = __builtin_amdgcn_cvt_pk_fp8_f32(clamp448(T[n][kk + 4] * 64.f), clamp448(T[n][kk + 5] * 64.f), 0, false); q1 = __builtin_amdgcn_cvt_pk_fp8_f32(clamp448(T[n][kk + 6] * 64.f), clamp448(T[n][kk + 7] * 64.f), q1, true); \
                    *(uint2*)(dstp[j] + (size_t)drow * D + k0_[j] + kk) = make_uint2((unsigned)q0, (unsigned)q1); \
                } } } \
        } while (0)
#define CVT_JOBS(LYR, MAXJOBS) do { for (int nj_ = 0; nj_ < (MAXJOBS); ++nj_) { __syncthreads(); \
            if (tid == 0) misc[200] = atomicAdd(((unsigned*)(ws + WS_CTL)) + CW_CVT + 32 * (LYR), 1u); __syncthreads(); \
            const unsigned job_ = misc[200]; if (job_ >= (unsigned)(NE * 128)) break; CVT_GROUP((LYR) * NE * 384 + (int)job_ * 3); } __syncthreads(); } while (0)

    RUN_PH(0) if (IN_PH()) { PH_IDS;
        for (int i = gtid; i < 2048 * 64; i += gthreads) {
            const int t = i >> 6, d = i & 63, f = d & 15, axis = d >> 5;
            const float pos = axis == 0 ? (float)(t >> 6) : (float)(t & 63);
            const float inv = powf(10000.f, -(float)(2 * f) / 32.f);
            const float ang = pos * inv;
            ROPEC[i] = cosf(ang); ROPES[i] = sinf(ang);
        }
        for (int i = gtid; i < DEPTH * 4 * 64 * 64; i += gthreads) { const int cc = i & 63, dd = (i >> 6) & 63, lg4 = i >> 12; PWT[i] = bf16_1(INP(I_POOLW)[((size_t)lg4 * 64 + cc) * 64 + dd]); }
        CVT_JOBS(0, 6);
        for (int it = bid; it < DEPTH * (160 + 128 + 8); it += nb) {
            const int l = it / 296, r = it % 296;
            if (r < 160) { const int kt = r / 20, ntl = r % 20;
                transpose_cvt_tile(smem, tid, INP(I_WIN) + (size_t)l * D * INW, INW, kt * 128, ntl * 64, WINT + (size_t)l * INW * D, D, [](int n) { return n; });
            } else if (r < 288) { const int r2 = r - 160, kt = r2 >> 4, ntl = r2 & 15;
                transpose_cvt_tile(smem, tid, INP(I_WOUT) + (size_t)l * D * D, D, kt * 128, ntl * 64, WOUTT + (size_t)l * D * D, D, [](int n) { return n; });
            } else { const int r2 = r - 288, kt = r2 >> 2, ntl = r2 & 3;
                transpose_cvt_tile(smem, tid, INP(I_GLUW) + (size_t)l * 256 * 256, 256, kt * 128, ntl * 64, GLUT + (size_t)l * 256 * 256, 256, [](int n) { return n; }); }
        }
        __syncthreads();
        for (int i = tid; i < 9 * 1024; i += NT) { const float v = i < 8192 ? INP(I_C)[i] : INP(I_CCTX)[i - 8192]; smem[i] = silu_f(v); }
        __syncthreads();
        for (int it = bid; it < DEPTH * 96; it += nb) {
            const int l = it / 96, j = (it % 96) * 64 + lane;
            const float* w = INP(I_WMOD) + (size_t)l * D * 6144 + j;
            float acc[9];
#pragma unroll
            for (int m = 0; m < 9; ++m) acc[m] = 0.f;
            for (int k = wave * 128; k < wave * 128 + 128; ++k) {
                const float wv = w[(size_t)k * 6144];
#pragma unroll
                for (int m = 0; m < 9; ++m) acc[m] += smem[m * 1024 + k] * wv;
            }
            float* pb = smem + 9 * 1024;
#pragma unroll
            for (int m = 0; m < 9; ++m) pb[(wave * 9 + m) * 64 + lane] = acc[m];
            __syncthreads();
            if (wave == 0) {
                const float bias = INP(I_BMOD)[(size_t)l * 6144 + j];
#pragma unroll
                for (int m = 0; m < 9; ++m) { float s = 0.f;
#pragma unroll
                    for (int w8 = 0; w8 < 8; ++w8) s += pb[(w8 * 9 + m) * 64 + lane];
                    MOD[((size_t)l * 9 + m) * 6144 + j] = s + bias; }
            }
            __syncthreads();
        }
    }
    SEAM();

    for (int l = 0; l < DEPTH; ++l) {
        const int nrows_moe = (l == DEPTH - 1) ? TL : TA;
        const int nrows_mix = (l == DEPTH - 1) ? TL : TA;

        RUN_PH(1) if (IN_PH()) { PH_IDS;
            const float* n1w = INP(I_N1W) + l * D;
            const int r0 = (bid * (NT / 64) + wave) * 9;
            float4 cw[4], shv[4], g2v[4], xn[4]; unsigned yn[4][4]; float gkn[4];
#pragma unroll
            for (int i = 0; i < 4; ++i) { cw[i] = make_float4(0.f, 0.f, 0.f, 0.f); shv[i] = cw[i]; g2v[i] = cw[i]; gkn[i] = 0.f;
#pragma unroll
                for (int k = 0; k < 4; ++k) yn[k][i] = 0u; }
#define A_LOAD(ROW) do { const float4* xr_ = (const float4*)(l > 0 ? XS + (size_t)(ROW) * D : ((ROW) < TL ? INP(I_X) + (size_t)(ROW) * D : INP(I_CTX) + (size_t)((ROW) - TL) * D)); \
                _Pragma("unroll") for (int i = 0; i < 4; ++i) xn[i] = xr_[lane + i * 64]; \
                if (l > 0) { _Pragma("unroll") for (int k = 0; k < 4; ++k) { gkn[k] = GATE[(ROW) * 4 + k]; \
                    _Pragma("unroll") for (int i = 0; i < 4; ++i) yn[k][i] = ((const unsigned*)((const unsigned char*)YBB + ((size_t)(ROW) * 4 + k) * D))[lane + i * 64]; } } } while (0)
            A_LOAD(r0);
            int cur_mr = -1;
            for (int kr = 0; kr < 9; ++kr) {
                const int row = r0 + kr, mr = mrow_of(row);
                float4 v[4]; unsigned y[4][4]; float gk[4];
#pragma unroll
                for (int i = 0; i < 4; ++i) v[i] = xn[i];
#pragma unroll
                for (int k = 0; k < 4; ++k) { gk[k] = gkn[k];
#pragma unroll
                    for (int i = 0; i < 4; ++i) y[k][i] = yn[k][i]; }
                { const int rn = kr + 1 < 9 ? row + 1 : row; A_LOAD(rn); }
                if (mr != cur_mr) {
                    const float4* sh = (const float4*)(modl + (size_t)mr * 6144), *sc = (const float4*)(modl + (size_t)mr * 6144 + D);
                    const float4* g2 = (const float4*)(MOD + ((size_t)(l > 0 ? l - 1 : 0) * 9 + mr) * 6144 + 5 * D);
#pragma unroll
                    for (int i = 0; i < 4; ++i) { const float4 w4 = ((const float4*)n1w)[lane + i * 64], c4 = sc[lane + i * 64];
                        cw[i] = make_float4(w4.x * (1.f + c4.x), w4.y * (1.f + c4.y), w4.z * (1.f + c4.z), w4.w * (1.f + c4.w)); shv[i] = sh[lane + i * 64]; g2v[i] = g2[lane + i * 64]; }
                    cur_mr = mr;
                }
                __builtin_amdgcn_sched_barrier(0);
                if (l > 0) {
                    const float cs = _rep ? 0.f : 1.f;
                    float4* xr = (float4*)(XS + (size_t)row * D);
#pragma unroll
                    for (int i = 0; i < 4; ++i) {
                        float4 sacc = make_float4(0.f, 0.f, 0.f, 0.f);
#pragma unroll
                        for (int k = 0; k < 4; ++k) { const f32x2_t ylo = __builtin_amdgcn_cvt_pk_f32_fp8((int)y[k][i], false), yhi = __builtin_amdgcn_cvt_pk_f32_fp8((int)y[k][i], true);
                            sacc.x += gk[k] * ylo[0]; sacc.y += gk[k] * ylo[1]; sacc.z += gk[k] * yhi[0]; sacc.w += gk[k] * yhi[1]; }
                        v[i].x += cs * g2v[i].x * sacc.x; v[i].y += cs * g2v[i].y * sacc.y; v[i].z += cs * g2v[i].z * sacc.z; v[i].w += cs * g2v[i].w * sacc.w;
                        xr[lane + i * 64] = v[i];
                    }
                }
                float ss = 0.f;
#pragma unroll
                for (int i = 0; i < 4; ++i) ss += v[i].x * v[i].x + v[i].y * v[i].y + v[i].z * v[i].z + v[i].w * v[i].w;
                ss = wave_sum(ss);
                const float rstd = rsqrtf(ss * (1.f / D) + EPS);
                uint2* hr = (uint2*)(HB + (size_t)row * D);
#pragma unroll
                for (int i = 0; i < 4; ++i)
                    hr[lane + i * 64] = make_uint2(pk_bf16(v[i].x * rstd * cw[i].x + shv[i].x, v[i].y * rstd * cw[i].y + shv[i].y), pk_bf16(v[i].z * rstd * cw[i].z + shv[i].z, v[i].w * rstd * cw[i].w + shv[i].w));
            }
#undef A_LOAD
            for (int i = gtid; i < 2048; i += gthreads) {
                const int dg = i >> 6;
                const size_t pbase = (size_t)l * 2048 + i;
                const float are = INP(I_ARE)[pbase], aim = INP(I_AIM)[pbase];
                const float dt = expf(INP(I_LOGDT)[l * 32 + dg]);
                const float mag = expf(are * dt), ar = mag * cosf(aim * dt), ai = mag * sinf(aim * dt);
                const float den = are * are + aim * aim;
                const float qr = ((ar - 1.0f) * are + ai * aim) / den, qi = (ai * are - (ar - 1.0f) * aim) / den;
                DISC[i] = ar; DISC[2048 + i] = ai;
                const float* br = INP(I_BRE) + pbase * 16; const float* bi = INP(I_BIM) + pbase * 16;
                float4 brv[4], biv[4];
#pragma unroll
                for (int p4 = 0; p4 < 4; ++p4) { brv[p4] = ((const float4*)br)[p4]; biv[p4] = ((const float4*)bi)[p4]; }
#pragma unroll
                for (int p4 = 0; p4 < 4; ++p4) {
                    ((float4*)(DISC + 4096 + i * 16))[p4] = make_float4(qr * brv[p4].x - qi * biv[p4].x, qr * brv[p4].y - qi * biv[p4].y, qr * brv[p4].z - qi * biv[p4].z, qr * brv[p4].w - qi * biv[p4].w);
                    ((float4*)(DISC + 4096 + 32768 + i * 16))[p4] = make_float4(qr * biv[p4].x + qi * brv[p4].x, qr * biv[p4].y + qi * brv[p4].y, qr * biv[p4].z + qi * brv[p4].z, qr * biv[p4].w + qi * brv[p4].w);
                }
            }
        }
        SEAM();

        RUN_PH(2) if (IN_PH()) { PH_IDS;
            mg::DenseSched S{(const char*)HB, (const char*)(WINT + (size_t)l * INW * D), TA / 256, INW / 256, nb, bid, 2 * D};
            mg::EpiBf16 E{PX, INW};
            mg::gemm_phase(ldsl, 2 * D, S, E);
            if (_rep == 0 && bid >= 2 * ((TA / 256) * (INW / 256) - nb)) CVT_JOBS(l, 3);
        }
        SEAM();

        RUN_PH(3) if (IN_PH()) { PH_IDS;
            {
                SsmFrags SF; const int g = gw & 15;
                ssm_load_frags<false>(SF, lane, g, DISC, nullptr, nullptr, nullptr);
                for (int p = gw >> 4; p < NBATCH * 36; p += nwaves >> 4) ssm_chunk<false>(ldsl + wave * 12800, lane, p / 36, p % 36, g, PX, SF, EB, nullptr, nullptr);
            }
            {   const int li = lane & 15, hsub = lane >> 4;
                const float4 nwq = *(const float4*)(INP(I_QNW) + l * 64 + li * 4), nwk = *(const float4*)(INP(I_KNW) + l * 64 + li * 4);
                for (int row = gw; row < TA; row += nwaves) {
                    uint2 pv[3];
#pragma unroll
                    for (int pass = 0; pass < 3; ++pass) pv[pass] = *(const uint2*)(PX + (size_t)row * INW + min(pass * 4 + hsub, 9) * 64 + li * 4);
                    const int tpos = row < TL ? (row & (SEQ - 1)) : 0;
                    const float4 c = *(const float4*)(ROPEC + tpos * 64 + li * 4), sn = *(const float4*)(ROPES + tpos * 64 + li * 4);
                    __builtin_amdgcn_sched_barrier(0);
#pragma unroll
                    for (int pass = 0; pass < 3; ++pass) {
                        const int hh = pass * 4 + hsub;
                        if (hh < 10) {
                            const mg::f32x4 v = bf4_f32(pv[pass]);
                            float ss = v[0] * v[0] + v[1] * v[1] + v[2] * v[2] + v[3] * v[3];
                            ss += DPPF(ss, 0xB1); ss += DPPF(ss, 0x4E); ss += DPPF(ss, 0x141); ss += DPPF(ss, 0x140);
                            const float rs = rsqrtf(ss * (1.f / 64.f) + EPS);
                            const float4 nw = hh < 8 ? nwq : nwk;
                            float y0 = v[0] * rs * nw.x, y1 = v[1] * rs * nw.y, y2 = v[2] * rs * nw.z, y3 = v[3] * rs * nw.w;
                            if (row < TL) {
                                const float p0 = SHX(y0, 4), p1 = SHX(y1, 4), p2 = SHX(y2, 4), p3 = SHX(y3, 4);
                                const float sg = ((li >> 2) & 1) ? 1.f : -1.f;
                                y0 = y0 * c.x + sg * p0 * sn.x; y1 = y1 * c.y + sg * p1 * sn.y; y2 = y2 * c.z + sg * p2 * sn.z; y3 = y3 * c.w + sg * p3 * sn.w;
                            }
                            if (hh < 8) *(uint2*)(QNB + (size_t)row * 512 + hh * 64 + li * 4) = make_uint2(pk_bf16(y0 * 0.18033688f, y1 * 0.18033688f), pk_bf16(y2 * 0.18033688f, y3 * 0.18033688f));
                            else {
                                const int kvh = hh - 8, ks = li >> 2, hfk = (li >> 1) & 1, j0 = (li & 1) * 4;
                                unsigned short* kb;
                                if (row < TL) { const int b = row >> 11, t = row & (SEQ - 1); kb = KNB + ((size_t)((b * 2 + kvh) * (SEQ / 32) + (t >> 5))) * 2048 + (size_t)(((ks * 2 + hfk) * 32 + (t & 31)) * 8 + j0); }
                                else { const int q = row - TL, b = q >> 8, cc = q & (CTXL - 1); kb = KNB + (size_t)TL * 128 + ((size_t)((b * 2 + kvh) * (CTXL / 32) + (cc >> 5))) * 2048 + (size_t)(((ks * 2 + hfk) * 32 + (cc & 31)) * 8 + j0); }
                                *(uint2*)kb = make_uint2(pk_bf16(y0, y1), pk_bf16(y2, y3));
                            }
                        }
                    }
                }
            }
            for (int it = gw; it < (TA / 64) * 2; it += nwaves) {
                const int rb = it >> 1, kvh = it & 1, row = rb * 64 + lane;
                const uint4* vp = (const uint4*)(PX + (size_t)row * INW + 640 + kvh * 64);
                unsigned short* dst; int kk;
                if (rb < TL / 64) { const int b = rb >> 5, t = (rb & 31) * 64 + lane; dst = VTB + ((size_t)((b * 2 + kvh) * (SEQ / 32) + (t >> 5))) * 2048; kk = t & 31; }
                else { const int q = rb - TL / 64, b = q >> 2, c = (q & 3) * 64 + lane; dst = VTCB + ((size_t)((b * 2 + kvh) * (CTXL / 32) + (c >> 5))) * 2048; kk = c & 31; }
                const int sxv = kk >> 4, hfv = (kk >> 2) & 1, jv = ((kk >> 3) & 1) * 4 + (kk & 3);
                dst += (size_t)(sxv * 512 + hfv * 8 + jv);
                uint4 vrow[8];
#pragma unroll
                for (int i = 0; i < 8; ++i) vrow[i] = vp[i];
                __builtin_amdgcn_sched_barrier(0);
#pragma unroll
                for (int i = 0; i < 8; ++i) { const uint4 x = vrow[i];
#pragma unroll
                    for (int c = 0; c < 8; ++c) { const int d = 8 * i + c, dt = d >> 5, rr = d & 31; const unsigned wv = (c >> 1) == 0 ? x.x : (c >> 1) == 1 ? x.y : (c >> 1) == 2 ? x.z : x.w;
                        dst[(dt * 64 + rr) * 16] = (unsigned short)((c & 1) ? (wv >> 16) : (wv & 0xffffu)); } }
            }
        }
        SEAM();

        RUN_PH(4) if (IN_PH()) { PH_IDS;
            for (int it = bid * (NT / 64) + wave, arnd = 0; it < (nrows_mix / 32) * 8; it += nwaves, ++arnd) {
                const int h = it & 7, qb = it >> 3, kvh = h >> 2;
                const bool lat = qb < TL / 32;
                const int b = lat ? (qb >> 6) : ((qb - TL / 32) >> 3);
                const int t0 = lat ? ((qb & 63) * 32) : 0;
                const int r = lane & 31, hf = lane >> 5;
                const int qrow = qb * 32 + r;
                mg::bf16x8 qf[4];
#pragma unroll
                for (int ks = 0; ks < 4; ++ks) qf[ks] = *(const mg::bf16x8*)(QNB + (size_t)qrow * 512 + h * 64 + ks * 16 + hf * 8);
                f32x16 o0, o1;
#pragma unroll
                for (int i = 0; i < 16; ++i) { o0[i] = 0.f; o1[i] = 0.f; }
                float lsum = hf == 0 ? __expf(INP(I_SINK)[l * 8 + h] - 8.f) : 0.f;
                const int kt_lo = lat ? max(0, (128 - t0) >> 5) : 9, kt_hi = lat ? min(8, (SEQ + 96 - t0) >> 5) : 8;
#define ATT_LOAD(KT, KF, VLO, VHI) do { const unsigned short* kbase_; const unsigned short* vbase_; \
                    if ((KT) < 9) { const int kti = (t0 - 128 + (KT) * 32) >> 5; kbase_ = KNB + ((size_t)((b * 2 + kvh) * (SEQ / 32) + kti)) * 2048; vbase_ = VTB + ((size_t)((b * 2 + kvh) * (SEQ / 32) + kti)) * 2048; } \
                    else { kbase_ = KNB + (size_t)TL * 128 + ((size_t)((b * 2 + kvh) * (CTXL / 32) + (KT) - 9)) * 2048; vbase_ = VTCB + ((size_t)((b * 2 + kvh) * (CTXL / 32) + (KT) - 9)) * 2048; } \
                    _Pragma("unroll") for (int ks = 0; ks < 4; ++ks) KF[ks] = *(const mg::bf16x8*)(kbase_ + ((ks * 2 + hf) * 32 + r) * 8); \
                    _Pragma("unroll") for (int dt = 0; dt < 2; ++dt) _Pragma("unroll") for (int sx = 0; sx < 2; ++sx) { const uint4 vv = *(const uint4*)(vbase_ + (((dt * 2 + sx) * 32 + r) * 2 + hf) * 8); \
                        VLO[dt][sx] = make_uint2(vv.x, vv.y); VHI[dt][sx] = make_uint2(vv.z, vv.w); } } while (0)
#define ATT_COMPUTE(KT, KF, VLO, VHI) do { \
                    f32x16 x; \
                    _Pragma("unroll") for (int i = 0; i < 16; ++i) x[i] = -11.5415603f; \
                    _Pragma("unroll") for (int ks = 0; ks < 4; ++ks) x = __builtin_amdgcn_mfma_f32_32x32x16_bf16(KF[ks], qf[ks], x, 0, 0, 0); \
                    if ((KT) == 0 || (KT) == 8) { \
                        _Pragma("unroll") for (int i = 0; i < 16; ++i) { const int key = (i & 3) + 8 * (i >> 2) + 4 * hf; const bool ok = (KT) == 0 ? key >= r : key <= r; x[i] = ok ? x[i] : -INFINITY; } } \
                    float ps = 0.f; \
                    _Pragma("unroll") for (int i = 0; i < 16; ++i) { x[i] = __builtin_amdgcn_exp2f(x[i]); ps += x[i]; } \
                    lsum += ps; \
                    mg::bf16x8 pf[2]; \
                    _Pragma("unroll") for (int sx = 0; sx < 2; ++sx) { mg::u32x4 w; w.x = pk_bf16(x[8 * sx], x[8 * sx + 1]); w.y = pk_bf16(x[8 * sx + 2], x[8 * sx + 3]); w.z = pk_bf16(x[8 * sx + 4], x[8 * sx + 5]); w.w = pk_bf16(x[8 * sx + 6], x[8 * sx + 7]); pf[sx] = __builtin_bit_cast(mg::bf16x8, w); } \
                    _Pragma("unroll") for (int sx = 0; sx < 2; ++sx) { \
                        mg::u32x4 w0; w0.x = VLO[0][sx].x; w0.y = VLO[0][sx].y; w0.z = VHI[0][sx].x; w0.w = VHI[0][sx].y; \
                        mg::u32x4 w1; w1.x = VLO[1][sx].x; w1.y = VLO[1][sx].y; w1.z = VHI[1][sx].x; w1.w = VHI[1][sx].y; \
                        o0 = __builtin_amdgcn_mfma_f32_32x32x16_bf16(__builtin_bit_cast(mg::bf16x8, w0), pf[sx], o0, 0, 0, 0); \
                        o1 = __builtin_amdgcn_mfma_f32_32x32x16_bf16(__builtin_bit_cast(mg::bf16x8, w1), pf[sx], o1, 0, 0, 0); } } while (0)
                const int nloc = lat ? kt_hi - kt_lo + 1 : 0, ntot = nloc + 8;
#define ATT_KT(J) ((J) < nloc ? kt_lo + (J) : 9 + (J) - nloc)
                mg::bf16x8 kfA[4], kfB[4]; uint2 vloA[2][2], vhiA[2][2], vloB[2][2], vhiB[2][2];
                { const int kt0 = ATT_KT(0); ATT_LOAD(kt0, kfA, vloA, vhiA); }
                for (int jt = 0; jt + 1 < ntot; jt += 2) {
                    const int ktA = ATT_KT(jt), ktB = ATT_KT(jt + 1), ktN = ATT_KT(min(jt + 2, ntot - 1));
                    ATT_LOAD(ktB, kfB, vloB, vhiB);
                    ATT_COMPUTE(ktA, kfA, vloA, vhiA);
                    ATT_LOAD(ktN, kfA, vloA, vhiA);
                    ATT_COMPUTE(ktB, kfB, vloB, vhiB);
                }
                if (ntot & 1) { const int ktL = ATT_KT(ntot - 1); ATT_COMPUTE(ktL, kfA, vloA, vhiA); }
#undef ATT_KT
#undef ATT_COMPUTE
#undef ATT_LOAD
                lsum += SHX(lsum, 32);
                const float inv = 1.f / lsum;
                float ssq = 0.f;
#pragma unroll
                for (int i = 0; i < 16; ++i) ssq += o0[i] * o0[i] + o1[i] * o1[i];
                ssq *= inv * inv; ssq += SHX(ssq, 32);
                LAS float* xs = (LAS float*)(misc + 256) + (arnd & 1) * 256;
                if (hf == 0) xs[h * 32 + r] = ssq;
                __syncthreads();
                float tot = 0.f;
#pragma unroll
                for (int hh = 0; hh < 8; ++hh) tot += xs[hh * 32 + r];
                const float sc = rsqrtf(tot * (1.f / 512.f) + EPS) * inv;
                const float* onw = INP(I_ONW) + l * 768 + h * 64 + 4 * hf;
                unsigned short* mp = MRGB + (size_t)qrow * D + h * 64 + 4 * hf;
                float4 w0v[4], w1v[4];
#pragma unroll
                for (int gi = 0; gi < 4; ++gi) { w0v[gi] = *(const float4*)(onw + 8 * gi); w1v[gi] = *(const float4*)(onw + 32 + 8 * gi); }
                __builtin_amdgcn_sched_barrier(0);
#pragma unroll
                for (int gi = 0; gi < 4; ++gi) {
                    const float4 w0 = w0v[gi], w1 = w1v[gi];
                    *(uint2*)(mp + 8 * gi) = make_uint2(pk_bf16(o0[4 * gi] * sc * w0.x, o0[4 * gi + 1] * sc * w0.y), pk_bf16(o0[4 * gi + 2] * sc * w0.z, o0[4 * gi + 3] * sc * w0.w));
                    *(uint2*)(mp + 32 + 8 * gi) = make_uint2(pk_bf16(o1[4 * gi] * sc * w1.x, o1[4 * gi + 1] * sc * w1.y), pk_bf16(o1[4 * gi + 2] * sc * w1.z, o1[4 * gi + 3] * sc * w1.w));
                }
            }
            {   SsmFrags SF; const int g = gw & 15;
                ssm_load_frags<true>(SF, lane, g, DISC, INP(I_CRE) + (size_t)l * 2 * 16 * 16 * 64, INP(I_CIM) + (size_t)l * 2 * 16 * 16 * 64, INP(I_SSMD) + l * 256);
                for (int p = gw >> 4; p < NBATCH * 36; p += nwaves >> 4) { if (l == DEPTH - 1 && (p % 36) < 4) continue; ssm_chunk<true>(ldsl + wave * 12800, lane, p / 36, p % 36, g, PX, SF, EB, G, GB); }
            }
            for (int it = gw; it < (nrows_mix / 16) * 4; it += nwaves) {
                const int g4 = it & 3, rb = it >> 2, rl = lane & 15, quad = lane >> 4, hw = 1 << g4;
                const int row = rb * 16 + rl;
                int base, t, L;
                if (row < TL) { base = row & ~(SEQ - 1); t = row & (SEQ - 1); L = SEQ; } else { const int q = row - TL; base = TL + (q & ~(CTXL - 1)); t = q & (CTXL - 1); L = CTXL; }
                const int tb0 = (t - rl) - hw;
                LAS float* Pw = (LAS float*)(ldsl + wave * 12800);
                {
                    mg::f32x4 tmp[8];
#pragma unroll
                    for (int i = 0; i < 8; ++i) { const int lr = (lane >> 4) + 4 * i, c4 = lane & 15; const int tp = min(max(tb0 + lr, 0), L - 1);
                        tmp[i] = bf4_f32(*(const uint2*)(PX + (size_t)(base + tp) * INW + 1024 + g4 * 64 + c4 * 4)); }
#pragma unroll
                    for (int i = 0; i < 8; ++i) { const int lr = (lane >> 4) + 4 * i, c4 = lane & 15; *(LAS mg::f32x4*)(Pw + lr * 64 + c4 * 4) = tmp[i]; }
                }
                const int tlo = max(t - hw, 0), thi = min(t + hw, L);
                const float inv = 1.f / (float)(thi - tlo);
                mg::bf16x8 df[2];
#pragma unroll
                for (int kk = 0; kk < 2; ++kk) {
                    const int ch = kk * 32 + quad * 8;
                    mg::f32x4 s0 = (mg::f32x4){0.f, 0.f, 0.f, 0.f}, s1 = s0;
                    for (int tt = tlo; tt < thi; ++tt) { const LAS mg::f32x4* pp = (const LAS mg::f32x4*)(Pw + (tt - tb0) * 64 + ch); s0 += pp[0]; s1 += pp[1]; }
                    const LAS mg::f32x4* po = (const LAS mg::f32x4*)(Pw + (t - tb0) * 64 + ch); const mg::f32x4 o0 = po[0], o1 = po[1];
                    mg::u32x4 w; w.x = pk_bf16(s0[0] * inv - o0[0], s0[1] * inv - o0[1]); w.y = pk_bf16(s0[2] * inv - o0[2], s0[3] * inv - o0[3]);
                    w.z = pk_bf16(s1[0] * inv - o1[0], s1[1] * inv - o1[1]); w.w = pk_bf16(s1[2] * inv - o1[2], s1[3] * inv - o1[3]);
                    df[kk] = __builtin_bit_cast(mg::bf16x8, w);
                }
                const unsigned short* pwt = PWT + ((size_t)l * 4 + g4) * 64 * 64;
                const float* psc = INP(I_POOLS) + l * 256 + g4 * 64;
                mg::bf16x8 afv[4][2]; float4 scv4[4];
#pragma unroll
                for (int nt = 0; nt < 4; ++nt) { scv4[nt] = *(const float4*)(psc + nt * 16 + quad * 4);
#pragma unroll
                    for (int kk = 0; kk < 2; ++kk) afv[nt][kk] = *(const mg::bf16x8*)(pwt + (size_t)(nt * 16 + rl) * 64 + kk * 32 + quad * 8); }
                __builtin_amdgcn_sched_barrier(0);
#pragma unroll
                for (int nt = 0; nt < 4; ++nt) {
                    mg::f32x4 acc = (mg::f32x4){0.f, 0.f, 0.f, 0.f};
#pragma unroll
                    for (int kk = 0; kk < 2; ++kk) acc = __builtin_amdgcn_mfma_f32_16x16x32_bf16(afv[nt][kk], df[kk], acc, 0, 0, 0);
                    const int dd = nt * 16 + quad * 4;
                    const float4 sc4 = scv4[nt];
                    *(uint2*)(MRGB + (size_t)row * D + 768 + g4 * 64 + dd) = make_uint2(pk_bf16(acc[0] * sc4.x, acc[1] * sc4.y), pk_bf16(acc[2] * sc4.z, acc[3] * sc4.w));
                }
            }
        }
        SEAM();

        RUN_PH(5) if (IN_PH()) { PH_IDS;
            mg::DenseSched S{(const char*)GB, (const char*)(GLUT + (size_t)l * 256 * 256), nrows_mix / 256, 1, nb, bid, 512};
            mg::EpiGluNorm E{MRGB, GB, INP(I_GLUB) + l * 256, INP(I_ONW) + l * 768 + 512};
            mg::gemm_phase(ldsl, 512, S, E);
            if (_rep == 0 && bid >= nrows_mix / 256) CVT_JOBS(l, 4);
        }
        SEAM();

        RUN_PH(6) if (IN_PH()) { PH_IDS;
            mg::DenseSched S{(const char*)MRGB, (const char*)(WOUTT + (size_t)l * D * D), nrows_mix / 256, D / 256, nb, bid, 2 * D};
            mg::EpiResid E{XS, modl + 2 * D, _rep ? 0.f : 1.f, l == 0 ? INP(I_X) : nullptr, l == 0 ? INP(I_CTX) : nullptr};
            mg::gemm_phase(ldsl, 2 * D, S, E);
            if (_rep == 0 && bid >= 2 * ((nrows_mix / 256) * (D / 256) - nb)) CVT_JOBS(l, 1 << 20);
        }
        SEAM();

        RUN_PH(7) if (IN_PH()) { PH_IDS;
            const float* n2w = INP(I_N2W) + l * D; const float* rw = INP(I_RW) + (size_t)l * D * NE; const float* rb = INP(I_RB) + l * NE;
            LAS float* Wl = (LAS float*)ldsl;
            __syncthreads();
            {   mg::f32x4 wtmp[16];
#pragma unroll
                for (int q = 0; q < 16; ++q) wtmp[q] = ((const mg::f32x4*)rw)[tid + q * NT];
#pragma unroll
                for (int q = 0; q < 16; ++q) { const int i = tid + q * NT, c = i >> 3, e4 = i & 7; *(LAS mg::f32x4*)(Wl + c * 32 + ((e4 ^ ((c >> 1) & 7)) << 2)) = wtmp[q]; } }
            __syncthreads();
            const int swz = (lane >> 1) & 7;
            const int RPW = nrows_moe >> 11;
            const int r0 = (bid * (NT / 64) + wave) * RPW;
            float cw[16], shv[16];
#pragma unroll
            for (int m = 0; m < 16; ++m) { cw[m] = 0.f; shv[m] = 0.f; }
            int cur_mr = -1, my_e = 0, my_row = 0; float my_g = 0.f;
#define OPQ2(A, B) asm volatile("" : "+v"(A), "+v"(B))
#define H_FINISH(LG, ROW, KIDX) do { \
                float a16[16], a8[8], a4[4], a2[2]; \
                {   const bool hi = lane & 32; float snd[16], kp[16], rcv[16]; \
                    _Pragma("unroll") for (int j = 0; j < 16; ++j) { float A = LG[j], B = LG[16 + j]; OPQ2(A, B); snd[j] = hi ? A : B; kp[j] = hi ? B : A; } \
                    __builtin_amdgcn_sched_barrier(0); \
                    _Pragma("unroll") for (int j = 0; j < 16; ++j) rcv[j] = SHX(snd[j], 32); \
                    __builtin_amdgcn_sched_barrier(0); \
                    _Pragma("unroll") for (int j = 0; j < 16; ++j) a16[j] = kp[j] + rcv[j]; } \
                {   const bool hi = lane & 16; float snd[8], kp[8], rcv[8]; \
                    _Pragma("unroll") for (int j = 0; j < 8; ++j) { float A = a16[j], B = a16[8 + j]; OPQ2(A, B); snd[j] = hi ? A : B; kp[j] = hi ? B : A; } \
                    __builtin_amdgcn_sched_barrier(0); \
                    _Pragma("unroll") for (int j = 0; j < 8; ++j) rcv[j] = SHX(snd[j], 16); \
                    __builtin_amdgcn_sched_barrier(0); \
                    _Pragma("unroll") for (int j = 0; j < 8; ++j) a8[j] = kp[j] + rcv[j]; } \
                {   const bool hi = lane & 8; \
                    _Pragma("unroll") for (int j = 0; j < 4; ++j) { float A = a8[j], B = a8[4 + j]; OPQ2(A, B); const float send = hi ? A : B, keep = hi ? B : A; a4[j] = keep + DPPF(send, 0x128); } } \
                {   const bool hi = lane & 4; \
                    _Pragma("unroll") for (int j = 0; j < 2; ++j) { float A = a4[j], B = a4[2 + j]; OPQ2(A, B); const float send = hi ? A : B, keep = hi ? B : A; a2[j] = keep + DPPF(send, 0x141); } } \
                float lgt; \
                { const bool hi = lane & 2; float A = a2[0], B = a2[1]; OPQ2(A, B); const float send = hi ? A : B, keep = hi ? B : A; lgt = keep + DPPF(send, 0x4E); } \
                lgt += DPPF(lgt, 0xB1); \
                const int myexp = lane >> 1; \
                lgt += rb[myexp]; \
                float tv[4]; int ti[4]; \
                _Pragma("unroll") for (int q = 0; q < 4; ++q) { \
                    const float mx = wave_max_dpp(lgt); \
                    const unsigned long long bal = __ballot(lgt == mx); \
                    const int wl = __builtin_ctzll(bal); \
                    tv[q] = mx; ti[q] = wl >> 1; \
                    if (myexp == (wl >> 1)) lgt = -INFINITY; } \
                const float e1 = __expf(tv[1] - tv[0]), e2 = __expf(tv[2] - tv[0]), e3 = __expf(tv[3] - tv[0]); \
                const float inv = 1.f / (1.f + e1 + e2 + e3); \
                const float gk[4] = {inv, e1 * inv, e2 * inv, e3 * inv}; \
                _Pragma("unroll") for (int j = 0; j < 4; ++j) if (lane == 4 * (KIDX) + j) { my_e = ti[j]; my_g = gk[j]; my_row = (ROW); } } while (0)
            for (int k = 0; k < RPW;) {
                const bool two = (((r0 + k) & 1) == 0) && (k + 1 < RPW);
                const int rowA = r0 + k, rowB = two ? rowA + 1 : rowA;
                const int mr = mrow_of(rowA);
                float vA[16], vB[16];
#pragma unroll
                for (int m = 0; m < 16; ++m) { vA[m] = XS[(size_t)rowA * D + lane + 64 * m]; vB[m] = XS[(size_t)rowB * D + lane + 64 * m]; }
                if (mr != cur_mr) {
                    const float* sh = modl + (size_t)mr * 6144 + 3 * D; const float* sc = sh + D;
#pragma unroll
                    for (int m = 0; m < 16; ++m) { const int c = lane + 64 * m; cw[m] = n2w[c]; shv[m] = sc[c]; }
                    float sht[16];
#pragma unroll
                    for (int m = 0; m < 16; ++m) sht[m] = sh[lane + 64 * m];
                    __builtin_amdgcn_sched_barrier(0);
#pragma unroll
                    for (int m = 0; m < 16; ++m) { cw[m] = cw[m] * (1.f + shv[m]); shv[m] = sht[m]; }
                    cur_mr = mr;
                }
                __builtin_amdgcn_sched_barrier(0);
                float ssA = 0.f, ssB = 0.f;
#pragma unroll
                for (int m = 0; m < 16; ++m) { ssA += vA[m] * vA[m]; ssB += vB[m] * vB[m]; }
                ssA = wave_sum(ssA); ssB = wave_sum(ssB);
                const float rsA = rsqrtf(ssA * (1.f / D) + EPS), rsB = rsqrtf(ssB * (1.f / D) + EPS);
                unsigned char* hrA = (unsigned char*)H2B + (size_t)rowA * D; unsigned char* hrB = (unsigned char*)H2B + (size_t)rowB * D;
#pragma unroll
                for (int m = 0; m < 16; ++m) {
                    vA[m] = vA[m] * rsA * cw[m] + shv[m]; vB[m] = vB[m] * rsB * cw[m] + shv[m];
                    { const float ca = clamp448(vA[m]); hrA[lane + 64 * m] = (unsigned char)(__builtin_amdgcn_cvt_pk_fp8_f32(ca, ca, 0, false) & 0xff); }
                    { const float cb = clamp448(vB[m]); hrB[lane + 64 * m] = (unsigned char)(__builtin_amdgcn_cvt_pk_fp8_f32(cb, cb, 0, false) & 0xff); }
                }
                float lgA[32], lgB[32];
#pragma unroll
                for (int e = 0; e < 32; ++e) { lgA[e] = 0.f; lgB[e] = 0.f; }
#pragma unroll
                for (int m = 0; m < 16; ++m) {
                    mg::f32x4 wq[8];
#pragma unroll
                    for (int e4 = 0; e4 < 8; ++e4) wq[e4] = *(const LAS mg::f32x4*)(Wl + (lane + 64 * m) * 32 + ((e4 ^ swz) << 2));
                    __builtin_amdgcn_sched_barrier(0);
                    const float oa = vA[m], ob = vB[m];
#pragma unroll
                    for (int e4 = 0; e4 < 8; ++e4) { const mg::f32x4 w = wq[e4];
                        lgA[4 * e4] += oa * w[0]; lgA[4 * e4 + 1] += oa * w[1]; lgA[4 * e4 + 2] += oa * w[2]; lgA[4 * e4 + 3] += oa * w[3];
                        lgB[4 * e4] += ob * w[0]; lgB[4 * e4 + 1] += ob * w[1]; lgB[4 * e4 + 2] += ob * w[2]; lgB[4 * e4 + 3] += ob * w[3]; }
                    __builtin_amdgcn_sched_barrier(0);
                }
                H_FINISH(lgA, rowA, k);
                { const int kb = two ? k + 1 : k; H_FINISH(lgB, rowB, kb); }
                k += two ? 2 : 1;
            }
#undef H_FINISH
            LAS unsigned* lcnt = misc + 128;
            if (tid < 64) lcnt[tid] = 0u;
            __syncthreads();
            const bool has = lane < 4 * RPW && _rep == 0;
            unsigned lpos = 0u;
            if (has) lpos = __hip_atomic_fetch_add(lcnt + my_e, 1u, __ATOMIC_RELAXED, __HIP_MEMORY_SCOPE_WORKGROUP);
            __syncthreads();
            if (tid < NE) { const unsigned n = lcnt[tid]; lcnt[32 + tid] = n ? atomicAdd(&counts[32 * tid], n) : 0u; }
            __syncthreads();
            if (has) {
                const int slot = my_row * 4 + (lane & 3);
                TOPI[slot] = my_e; GATE[slot] = my_g;
                LIST[(size_t)my_e * LISTCAP + lcnt[32 + my_e] + lpos] = slot;
            }
            __syncthreads();
        }
        SEAM();

        RUN_PH(8) if (IN_PH()) { PH_IDS;
            LAS int* tstart = (LAS int*)(misc + 16);
            __syncthreads();
            if (tid == 0) { int acc = 0; for (int e = 0; e < NE; ++e) { const int cn = (int)counts[32 * e]; tstart[e] = acc; tstart[40 + e] = cn; acc += (cn + 255) >> 8; } tstart[NE] = acc; tstart[40 + NE] = 0; }
            __syncthreads();
            const int tsv = tstart[min(lane, NE)], cntv = tstart[40 + min(lane, NE)];
            LAS int* utE = (LAS int*)(ldsl + UT_OFF); LAS float* utB = (LAS float*)(ldsl + UT_OFF + UT_MAX * 1024);
            mg::MoeSched S{tsv, cntv, LIST, utE, (const char*)H2B, (const char*)WGUT + (size_t)l * NE * 2048 * D, 8, nb, bid, D};
            {
                mg::Unit uu; int tv_[UT_MAX];
#pragma unroll
                for (int i = 0; i < UT_MAX; ++i) {
                    const bool ok = S.next(i, uu);
                    const int e_ = ok ? uu.e : 0, p0_ = ok ? uu.p0 : 0, cn_ = ok ? uu.cnt : 1, pn_ = ok ? uu.pn : 0;
                    if (tid < 256) tv_[i] = LIST[(size_t)e_ * LISTCAP + max(min(p0_ + tid, cn_ - 1), 0)];
                    else { const int c = tid - 256; tv_[i] = __float_as_int(INP(I_BGU)[((size_t)l * NE + e_) * 2048 + (c >> 7) * 1024 + pn_ * 128 + (c & 127)]); }
                }
                __builtin_amdgcn_sched_barrier(0);
#pragma unroll
                for (int i = 0; i < UT_MAX; ++i) { if (tid < 256) utE[i * 256 + tid] = tv_[i]; else utB[i * 256 + tid - 256] = __int_as_float(tv_[i]); }
                __syncthreads();
            }
            mg::EpiSwiglu E{(unsigned char*)ACTB, utB};
            mg::gemm_phase<mg::EpiSwiglu, mg::MoeSched, true>(ldsl, D, S, E);
            { const int ntot = tstart[NE] * 8; if (l + 1 < DEPTH && _rep == 0 && (ntot % nb) != 0 && bid >= ntot % nb) CVT_JOBS(l + 1, 3); }
        }
        SEAM();

        RUN_PH(9) if (IN_PH()) { PH_IDS;
            LAS int* tstart = (LAS int*)(misc + 16);
            __syncthreads();
            if (tid == 0) { int acc = 0; for (int e = 0; e < NE; ++e) { const int cn = (int)counts[32 * e]; tstart[e] = acc; tstart[40 + e] = cn; acc += (cn + 255) >> 8; } tstart[NE] = acc; tstart[40 + NE] = 0; }
            __syncthreads();
            const int tsv = tstart[min(lane, NE)], cntv = tstart[40 + min(lane, NE)];
            LAS int* utE = (LAS int*)(ldsl + UT_OFF); LAS float* utB = (LAS float*)(ldsl + UT_OFF + UT_MAX * 1024);
            mg::MoeSched S{tsv, cntv, nullptr, utE, (const char*)ACTB, (const char*)WDNT + (size_t)l * NE * D * D, 4, nb, bid, D};
            {   mg::Unit uu; int tv_[UT_MAX];
#pragma unroll
                for (int i = 0; i < UT_MAX; ++i) {
                    const bool ok = S.next(i, uu);
                    const int e_ = ok ? uu.e : 0, p0_ = ok ? uu.p0 : 0, cn_ = ok ? uu.cnt : 1, pn_ = ok ? uu.pn : 0;
                    if (tid < 256) tv_[i] = LIST[(size_t)e_ * LISTCAP + max(min(p0_ + tid, cn_ - 1), 0)];
                    else { const int c = tid - 256; tv_[i] = __float_as_int(INP(I_BDN)[((size_t)l * NE + e_) * D + pn_ * 256 + c]); }
                }
                __builtin_amdgcn_sched_barrier(0);
#pragma unroll
                for (int i = 0; i < UT_MAX; ++i) { if (tid < 256) utE[i * 256 + tid] = tv_[i]; else utB[i * 256 + tid - 256] = __int_as_float(tv_[i]); }
                __syncthreads();
            }
            mg::EpiDown E{YBB, utB, utE};
            mg::gemm_phase<mg::EpiDown, mg::MoeSched, true>(ldsl, D, S, E);
            { const int ntot = tstart[NE] * 4; if (l + 1 < DEPTH && _rep == 0 && (ntot % nb) != 0 && bid >= ntot % nb) CVT_JOBS(l + 1, 3); }
        }
        SEAM();
    }

    RUN_PH(10) if (IN_PH()) { PH_IDS;
        for (int row = gw; row < TL; row += nwaves) {
            const float* g2 = MOD + ((size_t)(DEPTH - 1) * 9 + mrow_of(row)) * 6144 + 5 * D;
            float gk[4]; float4 xv[4], ggv[4]; unsigned yv[4][4];
#pragma unroll
            for (int k = 0; k < 4; ++k) gk[k] = GATE[row * 4 + k];
#pragma unroll
            for (int i = 0; i < 4; ++i) { xv[i] = ((const float4*)(XS + (size_t)row * D))[lane + i * 64]; ggv[i] = ((const float4*)g2)[lane + i * 64];
#pragma unroll
                for (int k = 0; k < 4; ++k) yv[k][i] = ((const unsigned*)((const unsigned char*)YBB + ((size_t)row * 4 + k) * D))[lane + i * 64]; }
            __builtin_amdgcn_sched_barrier(0);
#pragma unroll
            for (int i = 0; i < 4; ++i) {
                float4 v = xv[i];
                float4 sacc = make_float4(0.f, 0.f, 0.f, 0.f);
#pragma unroll
                for (int k = 0; k < 4; ++k) { const f32x2_t ylo = __builtin_amdgcn_cvt_pk_f32_fp8((int)yv[k][i], false), yhi = __builtin_amdgcn_cvt_pk_f32_fp8((int)yv[k][i], true);
                    sacc.x += gk[k] * ylo[0]; sacc.y += gk[k] * ylo[1]; sacc.z += gk[k] * yhi[0]; sacc.w += gk[k] * yhi[1]; }
                v.x += ggv[i].x * sacc.x; v.y += ggv[i].y * sacc.y; v.z += ggv[i].z * sacc.z; v.w += ggv[i].w * sacc.w;
                ((float4*)(OUTP + (size_t)row * D))[lane + i * 64] = v;
            }
        }
    }
}

extern "C" void kernel_launch(void* const* d_in, const int* in_sizes, int n_in, void* d_out, int out_size, void* d_ws, size_t ws_size, hipStream_t stream) {
    static int grid = 0;
    if (grid == 0) {
        if (n_in != 32 || out_size != TL * D || ws_size < WS_END) { fprintf(stderr, "kernel_launch: unexpected shapes (n_in %d out %d ws %zu need %zu)\n", n_in, out_size, ws_size, (size_t)WS_END); grid = -1; return; }
        int dev = 0, cus = 0, per_cu = 0;
        if (hipGetDevice(&dev) != hipSuccess || hipDeviceGetAttribute(&cus, hipDeviceAttributeMultiprocessorCount, dev) != hipSuccess) { grid = -1; return; }
        if (hipFuncSetAttribute((const void*)fwd, hipFuncAttributeMaxDynamicSharedMemorySize, LDS_BYTES) != hipSuccess) { fprintf(stderr, "kernel_launch: hipFuncSetAttribute failed\n"); grid = -1; return; }
        if (hipOccupancyMaxActiveBlocksPerMultiprocessor(&per_cu, (const void*)fwd, NT, LDS_BYTES) != hipSuccess || per_cu < 1) { fprintf(stderr, "kernel_launch: occupancy query says %d\n", per_cu); }
        (void)hipGetLastError();
        grid = cus;
    }
    if (grid < 0) return;
    (void)hipMemsetAsync((char*)d_ws + WS_CTL, 0, CTL_BYTES, stream);
    Args a{};
    for (int i = 0; i < 32; ++i) a.in[i] = (const float*)d_in[i];
    a.out = (float*)d_out; a.ws = (unsigned char*)d_ws;
#if defined(MK_PER_PHASE)
    const int nph = 2 + DEPTH * 9;
    for (int p = 0; p < nph; ++p) { a.ph_lo = p; a.ph_hi = p + 1; hipLaunchKernelGGL(fwd, dim3(grid), dim3(NT), LDS_BYTES, stream, a); }
#else
    a.ph_lo = 0; a.ph_hi = 1 << 20;
    hipLaunchKernelGGL(fwd, dim3(grid), dim3(NT), LDS_BYTES, stream, a);
#endif
}
```
